# Optimizing an MI355X kernel written in HIP

```python
import jax, jax.numpy as jnp
from jax import lax
import numpy as np

D_MODEL = 1024
BATCH = 16
SEQ = 2048
DEPTH = 1

NORM_EPS = 1e-6
HG_HEADS = 4
HG_KDIM = 128
HG_VDIM = 128
HG_CHUNK = 64
HG_WIDTH = HG_HEADS * HG_KDIM
ATT_GROUPS = ((128, 1), (512, 4), (2048, 16))
ATT_N_GROUPS = 3
ATT_HEADS_PER_GROUP = 4
ATT_HEAD_DIM = 64
ATT_BLOCK = 128
ATT_WIDTH = ATT_N_GROUPS * ATT_HEADS_PER_GROUP * ATT_HEAD_DIM
ATT_OUT_WIDTH = ATT_HEADS_PER_GROUP * ATT_HEAD_DIM
PEER_HEADS = 8
PEER_NKEYS = 128
PEER_N_EXPERTS = PEER_NKEYS * PEER_NKEYS
PEER_QDIM = 128
PEER_HALF = PEER_QDIM // 2
PEER_TOPK = 16
PEER_TOKEN_BLOCK = 128
IN_COLS = 4 * HG_WIDTH + 3 * ATT_WIDTH + 2 * D_MODEL
IN_SPLITS = (HG_WIDTH, 2 * HG_WIDTH, 3 * HG_WIDTH, 4 * HG_WIDTH,
             4 * HG_WIDTH + ATT_WIDTH, 4 * HG_WIDTH + 2 * ATT_WIDTH,
             4 * HG_WIDTH + 3 * ATT_WIDTH, 4 * HG_WIDTH + 3 * ATT_WIDTH + D_MODEL)

kernel_name = "hybrid_hgrn2_dilated_attn_peer"


def rms_norm(x, g):
    xf = x.astype(jnp.float32)
    y = xf * lax.rsqrt(jnp.mean(xf * xf, axis=-1, keepdims=True) + NORM_EPS)
    return (y * g.astype(jnp.float32)).astype(x.dtype)


def hgrn2_mixer(q_pre, f_pre, i_pre, og_pre, lb, norm_g):
    B, S, _ = q_pre.shape
    f32 = jnp.float32
    lb = lb.astype(f32)
    f = lb + (1.0 - lb) * jax.nn.sigmoid(f_pre.astype(f32))
    log_f = jnp.log(f)
    k = 1.0 - f
    q = jax.nn.sigmoid(q_pre.astype(f32))
    v = i_pre.astype(f32)
    nc = S // HG_CHUNK

    def heads(t):
        return t.reshape(B, nc, HG_CHUNK, HG_HEADS, -1).transpose(0, 3, 1, 2, 4)

    q, k, v, log_f = heads(q), heads(k), heads(v), heads(log_f)
    G = jnp.cumsum(log_f, axis=3)
    G_last = G[:, :, :, -1:, :]
    q_dec = q * jnp.exp(G)
    k_intra = k * jnp.exp(-G)
    k_state = k * jnp.exp(G_last - G)
    causal = jnp.tril(jnp.ones((HG_CHUNK, HG_CHUNK), dtype=bool))
    A = jnp.where(causal, jnp.einsum('bhnck,bhnsk->bhncs', q_dec, k_intra), 0.0)
    o_intra = jnp.einsum('bhncs,bhnsv->bhncv', A, v)

    def step(state, inp):
        q_c, ks_c, v_c, decay_c = inp
        o_c = jnp.einsum('bhck,bhkv->bhcv', q_c, state)
        new_state = decay_c[..., None] * state + jnp.einsum('bhck,bhcv->bhkv', ks_c, v_c)
        return new_state, o_c

    state0 = jnp.zeros((B, HG_HEADS, HG_KDIM, HG_VDIM), f32)
    xs = (jnp.moveaxis(q_dec, 2, 0), jnp.moveaxis(k_state, 2, 0), jnp.moveaxis(v, 2, 0),
          jnp.moveaxis(jnp.exp(G_last[:, :, :, 0, :]), 2, 0))
    _, o_inter = lax.scan(step, state0, xs)
    o = o_intra + jnp.moveaxis(o_inter, 0, 2)
    o = o.transpose(0, 2, 3, 1, 4).reshape(B, S, HG_HEADS, HG_VDIM)
    o = o * lax.rsqrt(jnp.mean(o * o, axis=-1, keepdims=True) + NORM_EPS) * norm_g.astype(f32)
    o = o.reshape(B, S, HG_WIDTH) * jax.nn.silu(og_pre.astype(f32))
    return o.astype(q_pre.dtype)


def dilated_window_attention(q, k, v, window, dilation):
    B, S, H, E = q.shape
    L = S // dilation
    n_blk = -(-L // ATT_BLOCK)
    Lp = n_blk * ATT_BLOCK

    def to_residue(t):
        t = t.reshape(B, L, dilation, H, E).transpose(0, 2, 3, 1, 4)
        return jnp.pad(t, ((0, 0), (0, 0), (0, 0), (0, Lp - L), (0, 0)))

    def with_prev(t):
        tb = t.reshape(B, dilation, H, n_blk, ATT_BLOCK, E)
        prev = jnp.pad(tb[:, :, :, :-1], ((0, 0), (0, 0), (0, 0), (1, 0), (0, 0), (0, 0)))
        return jnp.concatenate([prev, tb], axis=4)

    qb = to_residue(q).reshape(B, dilation, H, n_blk, ATT_BLOCK, E)
    kb = with_prev(to_residue(k))
    vb = with_prev(to_residue(v))
    scores = jnp.einsum('bdhnqe,bdhnke->bdhnqk', qb, kb) * (E ** -0.5)
    n_back = window // dilation
    blk = jnp.arange(n_blk)[:, None, None]
    q_pos = blk * ATT_BLOCK + jnp.arange(ATT_BLOCK)[None, :, None]
    k_pos = (blk - 1) * ATT_BLOCK + jnp.arange(2 * ATT_BLOCK)[None, None, :]
    dist = q_pos - k_pos
    valid = (dist >= 0) & (dist <= n_back) & (k_pos >= 0)
    scores = jnp.where(valid, scores, -jnp.inf)
    m = jnp.max(scores, axis=-1, keepdims=True)
    p = jnp.exp(scores - m)
    l = jnp.sum(p, axis=-1, keepdims=True)
    o = jnp.einsum('bdhnqk,bdhnke->bdhnqe', p, vb) / l

    def from_residue(t):
        X = t.shape[-1]
        t = t.reshape(B, dilation, H, Lp, X)[:, :, :, :L]
        return t.transpose(0, 3, 1, 2, 4).reshape(B, S, H, X)

    return from_residue(o), from_residue(m), from_residue(l)


def dilated_attention_mixer(q_pre, k_pre, v_pre, q_norm_g, k_norm_g):
    B, S, _ = q_pre.shape
    f32 = jnp.float32
    shp = (B, S, ATT_N_GROUPS, ATT_HEADS_PER_GROUP, ATT_HEAD_DIM)

    def head_rms(t, g):
        return t * lax.rsqrt(jnp.mean(t * t, axis=-1, keepdims=True) + NORM_EPS) * g.astype(f32)

    q = head_rms(q_pre.astype(f32).reshape(shp), q_norm_g)
    k = head_rms(k_pre.astype(f32).reshape(shp), k_norm_g)
    v = v_pre.astype(f32).reshape(shp)
    outs = [dilated_window_attention(q[:, :, g], k[:, :, g], v[:, :, g], w, d)
            for g, (w, d) in enumerate(ATT_GROUPS)]
    o_all = jnp.stack([o for o, _, _ in outs])
    m_all = jnp.stack([m for _, m, _ in outs])
    l_all = jnp.stack([l for _, _, l in outs])
    w_all = l_all * jnp.exp(m_all - jnp.max(m_all, axis=0, keepdims=True))
    o = jnp.sum(w_all * o_all, axis=0) / jnp.sum(w_all, axis=0)
    return o.reshape(B, S, ATT_OUT_WIDTH).astype(q_pre.dtype)


def peer_ffn(x, w_q, sub_keys, u, v):
    B, S, D = x.shape
    q = (x @ w_q).reshape(B, S, PEER_HEADS, 2, PEER_HALF)
    s = jnp.einsum('bshpc,hpnc->bshpn', q, sub_keys).astype(jnp.float32)
    s1, i1 = lax.top_k(s[..., 0, :], PEER_TOPK)
    s2, i2 = lax.top_k(s[..., 1, :], PEER_TOPK)
    cand_s = (s1[..., :, None] + s2[..., None, :]).reshape(B, S, PEER_HEADS, PEER_TOPK * PEER_TOPK)
    cand_i = (i1[..., :, None] * PEER_NKEYS + i2[..., None, :]).reshape(B, S, PEER_HEADS, PEER_TOPK * PEER_TOPK)
    top_s, pos = lax.top_k(cand_s, PEER_TOPK)
    idx = jnp.take_along_axis(cand_i, pos, axis=-1)
    gate = jax.nn.softmax(top_s, axis=-1)
    n_blk = (B * S) // PEER_TOKEN_BLOCK
    xt = x.reshape(n_blk, PEER_TOKEN_BLOCK, D)
    it = idx.reshape(n_blk, PEER_TOKEN_BLOCK, PEER_HEADS, PEER_TOPK)
    gt = gate.reshape(n_blk, PEER_TOKEN_BLOCK, PEER_HEADS, PEER_TOPK)

    def block(args):
        xb, ib, gb = args
        hid = jnp.einsum('thkd,td->thk', u[ib], xb)
        a = jax.nn.gelu(hid.astype(jnp.float32), approximate=False) * gb
        return jnp.einsum('thk,thkd->td', a.astype(x.dtype), v[ib])

    out = lax.map(block, (xt, it, gt))
    return out.reshape(B, S, D)


def setup_inputs(seed: int = 0) -> dict:
    key = jax.random.key(seed)
    ks = jax.random.split(key, 16)
    f32 = jnp.float32
    nrm = lambda k, shape, scale: jax.random.normal(k, shape, f32) * scale
    return {
        "x": nrm(ks[0], (BATCH, SEQ, D_MODEL), 1.0),
        "norm1_g": 1.0 + nrm(ks[1], (DEPTH, D_MODEL), 0.02),
        "w_in": nrm(ks[2], (DEPTH, D_MODEL, IN_COLS), D_MODEL ** -0.5),
        "hg_norm_g": 1.0 + nrm(ks[3], (DEPTH, HG_VDIM), 0.02),
        "hg_lb_logits": nrm(ks[4], (DEPTH + 1, HG_WIDTH), 0.02),
        "q_norm_g": 1.0 + nrm(ks[5], (DEPTH, ATT_HEAD_DIM), 0.02),
        "k_norm_g": 1.0 + nrm(ks[6], (DEPTH, ATT_HEAD_DIM), 0.02),
        "w_branch_a": nrm(ks[7], (DEPTH, HG_WIDTH, D_MODEL), HG_WIDTH ** -0.5),
        "w_branch_b": nrm(ks[8], (DEPTH, ATT_OUT_WIDTH, D_MODEL), ATT_OUT_WIDTH ** -0.5),
        "w_out": nrm(ks[9], (DEPTH, D_MODEL, D_MODEL), D_MODEL ** -0.5),
        "norm2_g": 1.0 + nrm(ks[10], (DEPTH, D_MODEL), 0.02),
        "peer_wq": nrm(ks[11], (DEPTH, D_MODEL, PEER_HEADS * PEER_QDIM), D_MODEL ** -0.5),
        "peer_subkeys": nrm(ks[12], (DEPTH, PEER_HEADS, 2, PEER_NKEYS, PEER_HALF), PEER_HALF ** -0.5),
        "peer_u": nrm(ks[13], (DEPTH, PEER_N_EXPERTS, D_MODEL), D_MODEL ** -0.5),
        "peer_v": nrm(ks[14], (DEPTH, PEER_N_EXPERTS, D_MODEL), PEER_HEADS ** -0.5),
    }


def reference(x, norm1_g, w_in, hg_norm_g, hg_lb_logits, q_norm_g, k_norm_g, w_branch_a,
              w_branch_b, w_out, norm2_g, peer_wq, peer_subkeys, peer_u, peer_v):
    lb_all = jnp.cumsum(jax.nn.softmax(hg_lb_logits.astype(jnp.float32), axis=0), axis=0)
    for layer in range(DEPTH):
        h = rms_norm(x, norm1_g[layer])
        proj = h @ w_in[layer]
        hq, hf, hi, hog, aq, ak, av, ga, gb = jnp.split(proj, IN_SPLITS, axis=-1)
        y_a = hgrn2_mixer(hq, hf, hi, hog, lb_all[layer], hg_norm_g[layer])
        y_b = dilated_attention_mixer(aq, ak, av, q_norm_g[layer], k_norm_g[layer])
        merged = (jax.nn.sigmoid(ga) * (y_a @ w_branch_a[layer])
                  + jax.nn.sigmoid(gb) * (y_b @ w_branch_b[layer]))
        x = x + merged @ w_out[layer]
        h2 = rms_norm(x, norm2_g[layer])
        x = x + peer_ffn(h2, peer_wq[layer], peer_subkeys[layer], peer_u[layer], peer_v[layer])
    return x
```

```cpp
#include <hip/hip_runtime.h>
#include <hip/hip_cooperative_groups.h>
#include <cstdio>
#include <cstdint>
#include <cmath>
namespace cg = cooperative_groups;
#ifndef MK_FUSED
#define MK_FUSED 1
#endif
namespace pg8 {
#define PG8_LAS __attribute__((address_space(3)))
typedef unsigned short bf16_t;
typedef short bf16x8 __attribute__((ext_vector_type(8)));
typedef float f32x4 __attribute__((ext_vector_type(4)));
typedef unsigned u32x4 __attribute__((ext_vector_type(4)));
constexpr int BM = 256, BK = 64, HALF = 128, HTB = HALF * BK * 2  , STAGE_BYTES = 8 * HTB, NXCD = 8, WGM = 8;

__host__ __device__ __forceinline__ int lds_byte(int r, int c) { const int st = (r >> 4) * 2 + (c >> 5), rr = r & 15, cc = c & 31, ob = rr * 64 + cc * 2; return st * 1024 + (ob ^ (((ob >> 9) & 1) << 5)); }
__host__ __device__ __forceinline__ void stage_rc(int b, int& R, int& C) { const int st = b / 1024, sb = b % 1024, swz = sb ^ (((sb >> 9) & 1) << 5); R = (st >> 1) * 16 + swz / 64; C = (st & 1) * 32 + (swz % 64) / 2; }
__host__ __device__ __forceinline__ int perm32(int rho) { const int n = rho >> 4, i = rho & 15; return 8 * (i >> 2) + 4 * n + (i & 3); }

struct Unit { int pm, pn; };
struct Gemm { const bf16_t* A; const bf16_t* Bt; int M, N, K; };

struct StaticOrder {
    int nM, nN, nwg, G, c;
    __host__ __device__ void init(int M, int N, int G_, int c_) { nM = M / BM; nN = N / BM; nwg = nM * nN; G = G_; c = c_; }
    __host__ __device__ bool next(int i, Unit& u) const {
        const long L = (long)i * G + c; if (L >= nwg) return false;
        int wgid = (int)L; { const int q = nwg / NXCD, r = nwg % NXCD, xcd = wgid % NXCD, off = wgid / NXCD; wgid = (xcd < r ? xcd * (q + 1) : r * (q + 1) + (xcd - r) * q) + off; }
        const int nig = WGM * nN, gid = wgid / nig, fm = gid * WGM, gsz = (nM - fm) < WGM ? (nM - fm) : WGM;
        u.pm = fm + ((wgid % nig) % gsz); u.pn = (wgid % nig) / gsz; return true;
    }
    __device__ __forceinline__ void a_ready(const Unit&) const {}
    __device__ __forceinline__ void done(const Unit&) const {}
};

__device__ __forceinline__ unsigned cvt_pk_bf16(float lo, float hi) { unsigned r; asm volatile("v_cvt_pk_bf16_f32 %0, %1, %2" : "=v"(r) : "v"(lo), "v"(hi)); return r; }
__device__ __forceinline__ void st_wt(void* p, u32x4 v) { asm volatile("global_store_dwordx4 %0, %1, off sc1\n\ts_nop 1" :: "v"(p), "v"(v) : "memory"); }
typedef float f32x2 __attribute__((ext_vector_type(2)));
__device__ __forceinline__ f32x2 gelu_pk(f32x2 v) {
    const f32x2 av = __builtin_elementwise_abs(v), d = av * 0.2316418882f + 1.0f;
    f32x2 t; t.x = __builtin_amdgcn_rcpf(d.x); t.y = __builtin_amdgcn_rcpf(d.y);
    f32x2 q = t * 0.5307027145f + (-0.7265760135f); q = q * t + 0.7107068705f; q = q * t + (-0.142248368f); q = q * t + 0.127414796f; q = q * t;
    const f32x2 s = (v * v) * (-0.72134752044f);
    f32x2 e; e.x = __builtin_amdgcn_exp2f(s.x); e.y = __builtin_amdgcn_exp2f(s.y);
    const f32x2 m = v * (q * e), r = v - m;
    f32x2 o; o.x = v.x < 0.f ? m.x : r.x; o.y = v.y < 0.f ? m.y : r.y; return o;
}

template <int ACT  > struct EpiBf16 {
    static constexpr bool PERM = true, AFTER_DRAIN = false; static_assert(ACT == 0 || ACT == 1, "EpiBf16: ACT is 0 (none) or 1 (gelu_pk)");
    bf16_t* O; int ldc; const float* bias; int split_cols; size_t split_stride; float scale0;
    __device__ __forceinline__ void operator()(const f32x4 (&acc)[2][2][4][2], const Unit& u, int wr, int wc, int fr, int fq) const {
        const int row0 = u.pm * BM + wr * 64 + fr; int colt = u.pn * BM; bf16_t* base = O;
        float sc = 1.f; if (split_cols) { const int t = colt / split_cols; base += (size_t)t * split_stride; colt -= t * split_cols; if (t == 0) sc = scale0; }
        const int col0 = colt + wc * 32 + 8 * fq, bcol0 = u.pn * BM + wc * 32 + 8 * fq;
        f32x4 bv[2][2];
#pragma unroll
        for (int bj = 0; bj < 2; ++bj)
#pragma unroll
            for (int n = 0; n < 2; ++n) bv[bj][n] = bias ? *(const f32x4*)(bias + bcol0 + bj * HALF + 4 * n) : (f32x4){0.f, 0.f, 0.f, 0.f};
#pragma unroll
        for (int ai = 0; ai < 2; ++ai)
#pragma unroll
            for (int m = 0; m < 4; ++m) { bf16_t* rowp = base + (size_t)(row0 + ai * HALF + m * 16) * ldc + col0;
#pragma unroll
                for (int bj = 0; bj < 2; ++bj) { f32x4 v0 = acc[ai][bj][m][0] + bv[bj][0], v1 = acc[ai][bj][m][1] + bv[bj][1];
                    if (ACT == 1) { f32x2 a = gelu_pk((f32x2){v0[0], v0[1]}), b = gelu_pk((f32x2){v0[2], v0[3]}), c = gelu_pk((f32x2){v1[0], v1[1]}), d = gelu_pk((f32x2){v1[2], v1[3]});
                        v0 = (f32x4){a.x, a.y, b.x, b.y}; v1 = (f32x4){c.x, c.y, d.x, d.y}; }
                    v0 = v0 * sc; v1 = v1 * sc; u32x4 w; w.x = cvt_pk_bf16(v0[0], v0[1]); w.y = cvt_pk_bf16(v0[2], v0[3]); w.z = cvt_pk_bf16(v1[0], v1[1]); w.w = cvt_pk_bf16(v1[2], v1[3]);
                    *(u32x4*)(rowp + bj * HALF) = w; } }
    }
};

__device__ __forceinline__ float bf2f(unsigned short b) { return __builtin_bit_cast(float, (unsigned)b << 16); }
__device__ __forceinline__ float bflo(unsigned w) { return __builtin_bit_cast(float, w << 16); }
__device__ __forceinline__ float bfhi(unsigned w) { return __builtin_bit_cast(float, w & 0xffff0000u); }
__device__ __forceinline__ float sigmoidf_(float v) { return __builtin_amdgcn_rcpf(1.0f + __expf(-v)); }
constexpr int PROJ_LD = 6400;
constexpr float NORM_EPS_ = 1e-6f;
constexpr float QSCALE = 0.125f * 1.4426950408889634f;

struct EpiProj {
    static constexpr bool PERM = true, AFTER_DRAIN = false;
    bf16_t* O; const float* lbl; const float* gq; const float* gk; const float* sxn; const float* sw; bf16_t* KIO;
    __device__ __forceinline__ void operator()(const f32x4 (&acc)[2][2][4][2], const Unit& u, int wr, int wc, int fr, int fq) const {
        const int pn = u.pn;
        int type;
        if (pn < 2) type = 1; else if (pn < 4) type = 2; else if (pn < 6) type = 0; else if (pn < 8) type = 3; else if (pn < 11) type = 4; else if (pn < 14) type = 5; else if (pn < 17) type = 0; else type = 1;
        const int row0 = u.pm * BM + wr * 64 + fr;
        const int colL0 = pn * BM + wc * 64 + 8 * fq;
        float aux[2][8];
#pragma unroll
        for (int bj = 0; bj < 2; ++bj)
#pragma unroll
            for (int e = 0; e < 8; ++e) aux[bj][e] = 1.0f;
        if (type == 2) {
#pragma unroll
            for (int bj = 0; bj < 2; ++bj)
#pragma unroll
                for (int e = 0; e < 8; ++e) { const int c = colL0 + 32 * bj + e - 512; aux[bj][e] = sigmoidf_(lbl[c] - lbl[512 + c]); }
        } else if (type == 4 || type == 5) {
            const float* g = (type == 4) ? gq : gk; const float sc = (type == 4) ? QSCALE : 1.0f;
#pragma unroll
            for (int bj = 0; bj < 2; ++bj)
#pragma unroll
                for (int e = 0; e < 8; ++e) aux[bj][e] = g[32 * bj + 8 * fq + e] * sc;
        }
        float swv[2][8];
#pragma unroll
        for (int bj = 0; bj < 2; ++bj)
#pragma unroll
            for (int e = 0; e < 8; ++e) swv[bj][e] = sw[pn * BM + bj * HALF + wc * 32 + 8 * fq + e];
        float carry[2][8];
#pragma unroll
        for (int bj = 0; bj < 2; ++bj)
#pragma unroll
            for (int e = 0; e < 8; ++e) carry[bj][e] = 0.f;
        float rscv[8];
#pragma unroll
        for (int q = 0; q < 8; ++q) rscv[q] = sxn[row0 + (q >> 2) * HALF + (q & 3) * 16];
        asm volatile("" ::: "memory");
#pragma unroll
        for (int ai = 0; ai < 2; ++ai)
#pragma unroll
            for (int m = 0; m < 4; ++m) {
                const float rsc = rscv[4 * ai + m];
                float v[2][8];
#pragma unroll
                for (int bj = 0; bj < 2; ++bj)
#pragma unroll
                    for (int n = 0; n < 2; ++n) { typedef int i32x4_ __attribute__((ext_vector_type(4))); const i32x4_ iv = __builtin_bit_cast(i32x4_, acc[ai][bj][m][n]);
#pragma unroll
                        for (int i = 0; i < 4; ++i) v[bj][4 * n + i] = (float)iv[i] * (rsc * swv[bj][4 * n + i]); }
                if (type == 1) {
#pragma unroll
                    for (int bj = 0; bj < 2; ++bj)
#pragma unroll
                        for (int e = 0; e < 8; ++e) v[bj][e] = sigmoidf_(v[bj][e]);
                } else if (type == 2) {
                    float ki[2][8];
#pragma unroll
                    for (int bj = 0; bj < 2; ++bj)
#pragma unroll
                        for (int e = 0; e < 8; ++e) { const float lb = aux[bj][e]; const float ex = fminf(__expf(-v[bj][e]), 1e30f), sg = __builtin_amdgcn_rcpf(1.0f + ex);
                            const float f = lb + (1.0f - lb) * sg, kk = (1.0f - lb) * (ex * sg);
                            float g = __builtin_amdgcn_logf(f);
                            g += __builtin_bit_cast(float, __builtin_amdgcn_update_dpp(0, __builtin_bit_cast(int, g), 0x111, 0xf, 0xf, true));
                            g += __builtin_bit_cast(float, __builtin_amdgcn_update_dpp(0, __builtin_bit_cast(int, g), 0x112, 0xf, 0xf, true));
                            g += __builtin_bit_cast(float, __builtin_amdgcn_update_dpp(0, __builtin_bit_cast(int, g), 0x114, 0xf, 0xf, true));
                            g += __builtin_bit_cast(float, __builtin_amdgcn_update_dpp(0, __builtin_bit_cast(int, g), 0x118, 0xf, 0xf, true));
                            if (m > 0) g += carry[bj][e];
                            if (m < 3) carry[bj][e] = __shfl(g, 16 * fq + 15);
                            v[bj][e] = __builtin_amdgcn_exp2f(g); ki[bj][e] = kk * __builtin_amdgcn_exp2f(-g); }
                    bf16_t* kp = KIO + (size_t)(row0 + ai * HALF + m * 16) * 512 + (colL0 - 512);
#pragma unroll
                    for (int bj = 0; bj < 2; ++bj) { u32x4 w; w.x = cvt_pk_bf16(ki[bj][0], ki[bj][1]); w.y = cvt_pk_bf16(ki[bj][2], ki[bj][3]); w.z = cvt_pk_bf16(ki[bj][4], ki[bj][5]); w.w = cvt_pk_bf16(ki[bj][6], ki[bj][7]);
                        st_wt(kp + 32 * bj, w); }
                } else if (type == 3) {
#pragma unroll
                    for (int bj = 0; bj < 2; ++bj)
#pragma unroll
                        for (int e = 0; e < 8; ++e) v[bj][e] = v[bj][e] * sigmoidf_(v[bj][e]);
                } else if (type >= 4) {
                    float ss = 0.f;
#pragma unroll
                    for (int bj = 0; bj < 2; ++bj)
#pragma unroll
                        for (int e = 0; e < 8; ++e) ss += v[bj][e] * v[bj][e];
                    ss += __shfl_xor(ss, 16); ss += __shfl_xor(ss, 32);
                    const float rs = rsqrtf(ss * (1.0f / 64.0f) + NORM_EPS_);
#pragma unroll
                    for (int bj = 0; bj < 2; ++bj)
#pragma unroll
                        for (int e = 0; e < 8; ++e) v[bj][e] = v[bj][e] * rs * aux[bj][e];
                }
                bf16_t* rowp = O + (size_t)(row0 + ai * HALF + m * 16) * PROJ_LD + colL0;
#pragma unroll
                for (int bj = 0; bj < 2; ++bj) { u32x4 w; w.x = cvt_pk_bf16(v[bj][0], v[bj][1]); w.y = cvt_pk_bf16(v[bj][2], v[bj][3]); w.z = cvt_pk_bf16(v[bj][4], v[bj][5]); w.w = cvt_pk_bf16(v[bj][6], v[bj][7]);
                    st_wt(rowp + 32 * bj, w); }
            }
    }
};

template <int SECOND> struct EpiGate {
    static constexpr bool PERM = true, AFTER_DRAIN = false;
    bf16_t* O; const bf16_t* gate;
    __device__ __forceinline__ void operator()(const f32x4 (&acc)[2][2][4][2], const Unit& u, int wr, int wc, int fr, int fq) const {
        const int row0 = u.pm * BM + wr * 64 + fr; const int col0 = u.pn * BM + wc * 32 + 8 * fq;
#pragma unroll
        for (int ai = 0; ai < 2; ++ai)
#pragma unroll
            for (int m = 0; m < 4; ++m) { const size_t r = (size_t)(row0 + ai * HALF + m * 16);
#pragma unroll
                for (int bj = 0; bj < 2; ++bj) { const int c = col0 + bj * HALF;
                    const u32x4 gw = *(const u32x4*)(gate + r * PROJ_LD + c);
                    float v[8];
#pragma unroll
                    for (int n = 0; n < 2; ++n)
#pragma unroll
                        for (int i = 0; i < 4; ++i) v[4 * n + i] = acc[ai][bj][m][n][i];
                    v[0] *= bflo(gw.x); v[1] *= bfhi(gw.x); v[2] *= bflo(gw.y); v[3] *= bfhi(gw.y); v[4] *= bflo(gw.z); v[5] *= bfhi(gw.z); v[6] *= bflo(gw.w); v[7] *= bfhi(gw.w);
                    if (SECOND) { const u32x4 tw = *(const u32x4*)(O + r * 1024 + c);
                        v[0] += bflo(tw.x); v[1] += bfhi(tw.x); v[2] += bflo(tw.y); v[3] += bfhi(tw.y); v[4] += bflo(tw.z); v[5] += bfhi(tw.z); v[6] += bflo(tw.w); v[7] += bfhi(tw.w); }
                    u32x4 w; w.x = cvt_pk_bf16(v[0], v[1]); w.y = cvt_pk_bf16(v[2], v[3]); w.z = cvt_pk_bf16(v[4], v[5]); w.w = cvt_pk_bf16(v[6], v[7]);
                    if (SECOND) st_wt(O + r * 1024 + c, w); else { *(u32x4*)(O + r * 1024 + c) = w; asm volatile("" ::: "memory"); } } }
    }
};

struct EpiResid {
    static constexpr bool PERM = true, AFTER_DRAIN = false;
    const float* X; bf16_t* X1B; float* sumsq;
    __device__ __forceinline__ void operator()(const f32x4 (&acc)[2][2][4][2], const Unit& u, int wr, int wc, int fr, int fq) const {
        const int row0 = u.pm * BM + wr * 64 + fr; const int col0 = u.pn * BM + wc * 32 + 8 * fq;
        f32x4 xv[2][8];
#define ER_LOAD(g_, buf_) do { _Pragma("unroll") for (int j = 0; j < 4; ++j) { const int ai = (g_) >> 1, m = 2 * ((g_) & 1) + (j >> 1), bj = j & 1; const size_t off = (size_t)(row0 + ai * HALF + m * 16) * 1024 + col0 + bj * HALF; \
            xv[buf_][2 * j] = *(const f32x4*)(X + off); xv[buf_][2 * j + 1] = *(const f32x4*)(X + off + 4); } } while (0)
        ER_LOAD(0, 0);
#pragma unroll
        for (int g = 0; g < 4; ++g) {
            if (g + 1 < 4) ER_LOAD(g + 1, (g + 1) & 1);
#pragma unroll
            for (int mm = 0; mm < 2; ++mm) { const int ai = g >> 1, m = 2 * (g & 1) + mm; const size_t r = (size_t)(row0 + ai * HALF + m * 16); float ss = 0.f;
#pragma unroll
                for (int bj = 0; bj < 2; ++bj) { const size_t off = r * 1024 + col0 + bj * HALF; const int j = 2 * mm + bj;
                    const f32x4 v0 = acc[ai][bj][m][0] + xv[g & 1][2 * j], v1 = acc[ai][bj][m][1] + xv[g & 1][2 * j + 1];
                    ss += (v0[0] * v0[0] + v0[1] * v0[1]) + (v0[2] * v0[2] + v0[3] * v0[3]) + (v1[0] * v1[0] + v1[1] * v1[1]) + (v1[2] * v1[2] + v1[3] * v1[3]);
                    u32x4 w; w.x = cvt_pk_bf16(v0[0], v0[1]); w.y = cvt_pk_bf16(v0[2], v0[3]); w.z = cvt_pk_bf16(v1[0], v1[1]); w.w = cvt_pk_bf16(v1[2], v1[3]);
                    st_wt(X1B + off, w); }
                ss += __shfl_xor(ss, 16); ss += __shfl_xor(ss, 32);
                if (fq == 0) atomicAdd(sumsq + r, ss); }
            asm volatile("" ::: "memory");
        }
#undef ER_LOAD
    }
};

struct EpiRowScale {
    static constexpr bool PERM = true, AFTER_DRAIN = false;
    bf16_t* O; const float* sumsq;
    __device__ __forceinline__ void operator()(const f32x4 (&acc)[2][2][4][2], const Unit& u, int wr, int wc, int fr, int fq) const {
        const int row0 = u.pm * BM + wr * 64 + fr; const int col0 = u.pn * BM + wc * 32 + 8 * fq;
        float sq[8];
#pragma unroll
        for (int q = 0; q < 8; ++q) sq[q] = __hip_atomic_load(sumsq + (size_t)(row0 + (q >> 2) * HALF + (q & 3) * 16), __ATOMIC_RELAXED, __HIP_MEMORY_SCOPE_AGENT);
        asm volatile("" ::: "memory");
#pragma unroll
        for (int ai = 0; ai < 2; ++ai)
#pragma unroll
            for (int m = 0; m < 4; ++m) { const size_t r = (size_t)(row0 + ai * HALF + m * 16);
                const float rs = rsqrtf(sq[4 * ai + m] * (1.0f / 1024.0f) + NORM_EPS_);
#pragma unroll
                for (int bj = 0; bj < 2; ++bj) { const f32x4 v0 = acc[ai][bj][m][0] * rs, v1 = acc[ai][bj][m][1] * rs;
                    u32x4 w; w.x = cvt_pk_bf16(v0[0], v0[1]); w.y = cvt_pk_bf16(v0[2], v0[3]); w.z = cvt_pk_bf16(v1[0], v1[1]); w.w = cvt_pk_bf16(v1[2], v1[3]);
                    st_wt(O + r * 1024 + col0 + bj * HALF, w); } }
    }
};
template <class Epi, class Sched, bool ALIGN_EPI = false, bool SP2 = false, bool I8 = false>
__device__ __forceinline__ void gemm_phase(PG8_LAS unsigned char* lds, const Gemm g, const Sched& S, const Epi& E, const int wid  ) {
    int lane; asm volatile("v_mbcnt_lo_u32_b32 %0, -1, 0\n\tv_mbcnt_hi_u32_b32 %0, -1, %0" : "=v"(lane));
    const int tid = wid * 64 + lane, wr = wid >> 2, wc = wid & 3, fr = lane & 15, fq = lane >> 4;
    const int K = g.K, nt = K / BK;
    unsigned voffA[2], voffB[2];
#pragma unroll
    for (int i = 0; i < 2; ++i) { int R, C; stage_rc(tid * 16 + i * 8192, R, C); const int Rb = Epi::PERM ? ((R & ~31) + perm32(R & 31)) : R;
        voffA[i] = (unsigned)(R * K + C) * 2u; voffB[i] = (unsigned)(Rb * K + C) * 2u; }
    const size_t kstep = (size_t)(BK * 2);
    const size_t hstep = (size_t)HALF * K * 2;
    const size_t tstep = 2 * hstep;
    const unsigned ldsw = (unsigned)wid * 1024u;
    const int aoff = lds_byte(wr * 64 + fr, fq * 8), boff = lds_byte(wc * 32 + fr, fq * 8);
#define PG8_SA(b, h) (((b) * 2 + (h)) * HTB)
#define PG8_SB(b, h) ((4 + (b) * 2 + (h)) * HTB)
#define PG8_STAGE(bufoff, gbase, voff) do { _Pragma("unroll") for (int _i = 0; _i < 2; ++_i) \
        __builtin_amdgcn_global_load_lds((const unsigned*)((const char*)(gbase) + (voff)[_i]), (PG8_LAS unsigned*)(lds + (bufoff) + ldsw + _i * 8192), 16, 0, 0); } while (0)
#define PG8_LDA(dst, b, h) do { _Pragma("unroll") for (int m = 0; m < 4; ++m) _Pragma("unroll") for (int k = 0; k < 2; ++k) dst[m][k] = *(const PG8_LAS bf16x8*)(lds + PG8_SA(b, h) + aoff + m * 2048 + k * 1024); } while (0)
#define PG8_LDB(dst, b, h) do { _Pragma("unroll") for (int n = 0; n < 2; ++n) _Pragma("unroll") for (int k = 0; k < 2; ++k) dst[n][k] = *(const PG8_LAS bf16x8*)(lds + PG8_SB(b, h) + boff + n * 2048 + k * 1024); } while (0)
#define PG8_MMA(ai, bj, At, Bt) do { __builtin_amdgcn_s_setprio(1); _Pragma("unroll") for (int m = 0; m < 4; ++m) _Pragma("unroll") for (int n = 0; n < 2; ++n) _Pragma("unroll") for (int k = 0; k < 2; ++k) \
        { if constexpr (I8) { typedef int i32x4_ __attribute__((ext_vector_type(4))); acc[ai][bj][m][n] = __builtin_bit_cast(f32x4, __builtin_amdgcn_mfma_i32_16x16x64_i8(__builtin_bit_cast(i32x4_, Bt[n][k]), __builtin_bit_cast(i32x4_, At[m][k]), __builtin_bit_cast(i32x4_, acc[ai][bj][m][n]), 0, 0, 0)); } \
          else acc[ai][bj][m][n] = __builtin_amdgcn_mfma_f32_16x16x32_bf16(Bt[n][k], At[m][k], acc[ai][bj][m][n], 0, 0, 0); } __builtin_amdgcn_s_setprio(0); } while (0)
#define PG8_WAIT_V(n) asm volatile("s_waitcnt vmcnt(" #n ")" ::: "memory")
#define PG8_WAIT_L(n) asm volatile("s_waitcnt lgkmcnt(" #n ")" ::: "memory")
#define PG8_BAR __builtin_amdgcn_s_barrier()
#define PG8_SCHED __builtin_amdgcn_sched_barrier(0)
    Unit cur, nxt; int ui = 0;
    if (!S.next(0, cur)) return;
    f32x4 acc[2][2][4][2];
#pragma unroll
    for (int a = 0; a < 2; ++a)
#pragma unroll
        for (int b = 0; b < 2; ++b)
#pragma unroll
            for (int m = 0; m < 4; ++m)
#pragma unroll
                for (int n = 0; n < 2; ++n) acc[a][b][m][n] = (f32x4){0.f, 0.f, 0.f, 0.f};
    bf16x8 At[4][2], B0[2][2], B1[2][2];
    const char* cA = (const char*)g.A + (size_t)cur.pm * tstep; const char* cB = (const char*)g.Bt + (size_t)cur.pn * tstep;
    S.a_ready(cur);
    if constexpr (SP2) {
        PG8_STAGE(PG8_SB(0, 0), cB, voffB); PG8_STAGE(PG8_SB(0, 1), cB + hstep, voffB); PG8_STAGE(PG8_SA(0, 0), cA, voffA); PG8_STAGE(PG8_SA(0, 1), cA + hstep, voffA);
        if (wr == 1) PG8_BAR;
        PG8_WAIT_V(2); PG8_BAR;
        PG8_STAGE(PG8_SB(1, 0), cB + kstep, voffB); PG8_STAGE(PG8_SA(1, 0), cA + kstep, voffA); PG8_STAGE(PG8_SB(1, 1), cB + hstep + kstep, voffB);
        PG8_WAIT_V(6); PG8_BAR;
    } else {
        PG8_STAGE(PG8_SB(0, 0), cB, voffB); PG8_STAGE(PG8_SA(0, 0), cA, voffA); PG8_STAGE(PG8_SB(0, 1), cB + hstep, voffB); PG8_STAGE(PG8_SA(0, 1), cA + hstep, voffA);
        if (wr == 1) PG8_BAR;
        PG8_WAIT_V(4); PG8_BAR;
        PG8_STAGE(PG8_SB(1, 0), cB + kstep, voffB); PG8_STAGE(PG8_SA(1, 0), cA + kstep, voffA); PG8_STAGE(PG8_SB(1, 1), cB + hstep + kstep, voffB);
        PG8_WAIT_V(6); PG8_BAR;
    }
    for (;;) {
        const bool has_next = S.next(ui + 1, nxt);
        const char* nA = has_next ? (const char*)g.A + (size_t)nxt.pm * tstep : cA; const char* nB = has_next ? (const char*)g.Bt + (size_t)nxt.pn * tstep : cB;
        for (int t = 0; t < nt; t += 2) {
            const bool last = (t == nt - 2);
            const char* a1 = cA + (size_t)(t + 1) * kstep;
            const char* a2 = last ? nA : cA + (size_t)(t + 2) * kstep; const char* b2 = last ? nB : cB + (size_t)(t + 2) * kstep;
            const char* a3 = a2 + kstep; const char* b3 = b2 + kstep;
            if (last && has_next) S.a_ready(nxt);
            if constexpr (SP2) {
            PG8_LDB(B0, 0, 0); PG8_LDB(B1, 0, 1); PG8_SCHED; PG8_LDA(At, 0, 0); PG8_STAGE(PG8_SA(1, 1), a1 + hstep, voffA);
            PG8_WAIT_V(8); PG8_WAIT_L(0); PG8_BAR; PG8_MMA(0, 0, At, B0); PG8_MMA(0, 1, At, B1); PG8_BAR; PG8_SCHED;
            PG8_LDA(At, 0, 1); PG8_STAGE(PG8_SB(0, 0), b2, voffB); PG8_STAGE(PG8_SB(0, 1), b2 + hstep, voffB); PG8_STAGE(PG8_SA(0, 0), a2, voffA);
            PG8_WAIT_V(8); PG8_WAIT_L(0); PG8_BAR; PG8_MMA(1, 0, At, B0); PG8_MMA(1, 1, At, B1); PG8_BAR; PG8_SCHED;
            PG8_LDB(B0, 1, 0); PG8_LDB(B1, 1, 1); PG8_SCHED; PG8_LDA(At, 1, 0); PG8_STAGE(PG8_SA(0, 1), a2 + hstep, voffA);
            PG8_WAIT_V(8); PG8_WAIT_L(0); PG8_BAR; PG8_MMA(0, 0, At, B0); PG8_MMA(0, 1, At, B1); PG8_BAR; PG8_SCHED;
            PG8_LDA(At, 1, 1); PG8_STAGE(PG8_SB(1, 0), b3, voffB); PG8_STAGE(PG8_SB(1, 1), b3 + hstep, voffB); PG8_STAGE(PG8_SA(1, 0), a3, voffA);
            PG8_WAIT_V(8); PG8_WAIT_L(0); PG8_BAR; PG8_MMA(1, 0, At, B0); PG8_MMA(1, 1, At, B1); PG8_BAR; PG8_SCHED;
            } else {
            PG8_LDB(B0, 0, 0); PG8_SCHED; PG8_LDA(At, 0, 0); PG8_STAGE(PG8_SA(1, 1), a1 + hstep, voffA);
            PG8_WAIT_L(8); PG8_BAR; PG8_WAIT_L(0); PG8_MMA(0, 0, At, B0); PG8_BAR; PG8_SCHED;
            PG8_LDB(B1, 0, 1); PG8_STAGE(PG8_SB(0, 0), b2, voffB);
            PG8_BAR; PG8_WAIT_L(0); PG8_MMA(0, 1, At, B1); PG8_BAR;
            PG8_LDA(At, 0, 1); PG8_STAGE(PG8_SA(0, 0), a2, voffA);
            PG8_BAR; PG8_WAIT_L(0); PG8_MMA(1, 0, At, B0); PG8_BAR; PG8_SCHED;
            PG8_STAGE(PG8_SB(0, 1), b2 + hstep, voffB);
            PG8_WAIT_V(6); PG8_BAR; PG8_MMA(1, 1, At, B1); PG8_BAR;
            PG8_LDB(B0, 1, 0); PG8_SCHED; PG8_LDA(At, 1, 0); PG8_STAGE(PG8_SA(0, 1), a2 + hstep, voffA);
            PG8_WAIT_L(8); PG8_BAR; PG8_WAIT_L(0); PG8_MMA(0, 0, At, B0); PG8_BAR; PG8_SCHED;
            PG8_LDB(B1, 1, 1); PG8_STAGE(PG8_SB(1, 0), b3, voffB);
            PG8_BAR; PG8_WAIT_L(0); PG8_MMA(0, 1, At, B1); PG8_BAR;
            PG8_LDA(At, 1, 1); PG8_STAGE(PG8_SA(1, 0), a3, voffA);
            PG8_BAR; PG8_WAIT_L(0); PG8_MMA(1, 0, At, B0); PG8_BAR; PG8_SCHED;
            PG8_STAGE(PG8_SB(1, 1), b3 + hstep, voffB);
            PG8_WAIT_V(6); PG8_BAR; PG8_MMA(1, 1, At, B1); PG8_BAR;
            }
        }
        if constexpr (ALIGN_EPI) { if (wr == 0) PG8_BAR; }
        if constexpr (!Epi::AFTER_DRAIN) { E(acc, cur, wr, wc, fr, fq); S.done(cur); }
        if (!has_next) break;
#pragma unroll
        for (int a = 0; a < 2; ++a)
#pragma unroll
            for (int b = 0; b < 2; ++b)
#pragma unroll
                for (int m = 0; m < 4; ++m)
#pragma unroll
                    for (int n = 0; n < 2; ++n) acc[a][b][m][n] = (f32x4){0.f, 0.f, 0.f, 0.f};
        cur = nxt; cA = nA; cB = nB; ++ui;
        if constexpr (ALIGN_EPI) { if (wr == 1) PG8_BAR; }
    }
    PG8_WAIT_V(0);
    if constexpr (!ALIGN_EPI) { if (wr == 0) PG8_BAR; }
    PG8_BAR;
    if constexpr (Epi::AFTER_DRAIN) { E.fused(acc, cur, wr, wc, fr, fq, lds, wid, lane); S.done(cur); }
#undef PG8_SA
#undef PG8_SB
#undef PG8_STAGE
#undef PG8_LDA
#undef PG8_LDB
#undef PG8_MMA
#undef PG8_WAIT_V
#undef PG8_WAIT_L
#undef PG8_BAR
#undef PG8_SCHED
}
}

#define GAS __attribute__((address_space(1)))
#define LAS __attribute__((address_space(3)))
typedef unsigned short bf16;
typedef unsigned v4u __attribute__((ext_vector_type(4)));
typedef float f32x4 __attribute__((ext_vector_type(4)));
typedef float f32x16 __attribute__((ext_vector_type(16)));
typedef short bf16x8 __attribute__((ext_vector_type(8)));
#define LDS_WAIT() asm volatile("s_waitcnt lgkmcnt(0)" ::: "memory")
#define VM_WAIT() asm volatile("s_waitcnt vmcnt(0)" ::: "memory")

constexpr int NWAVES = 8;
constexpr int BATCH = 16, SEQ = 2048, DM = 1024, MTOK = BATCH * SEQ, NIN = 6400;
constexpr int NEXP = 16384;
constexpr float EPS = 1e-6f;
constexpr size_t MiB = 1u << 20;
constexpr size_t WS_CTL = 0, CTL_ZERO_BYTES = 1 * MiB;
constexpr size_t WS_SUMSQ = 512 * 1024;
constexpr size_t WS_WIN = 1 * MiB, WS_WA = 14 * MiB, WS_WB = 15 * MiB, WS_WOUT = 16 * MiB, WS_WQ = 18 * MiB, WS_SK = 20 * MiB;
constexpr size_t WS_U = 24 * MiB, WS_V = 56 * MiB;
constexpr size_t WS_SXN = 22 * MiB, WS_SW = 22 * MiB + 262144;
constexpr size_t WS_CMAX = 65536;
constexpr size_t WS_SU = 21 * MiB;
constexpr size_t WS_PROJ = 88 * MiB;
constexpr size_t WS_X1F = 88 * MiB, WS_X1B = 216 * MiB, WS_Q = 280 * MiB;
constexpr size_t WS_END = 488 * MiB;
constexpr size_t OUT_XN = 0, OUT_MERGED = 0, OUT_KI = 32 * MiB, OUT_YA = 64 * MiB, OUT_YB = 96 * MiB;
constexpr int LDS_CTL = 155648, LDS_BYTES = LDS_CTL + 1024;

__device__ __forceinline__ unsigned pk2(float lo, float hi) { typedef __bf16 b2_ __attribute__((ext_vector_type(2))); typedef float f2_ __attribute__((ext_vector_type(2))); f2_ v = {lo, hi}; return __builtin_bit_cast(unsigned, __builtin_convertvector(v, b2_)); }
__device__ __forceinline__ unsigned f2bf(float f) { return pk2(f, 0.f) & 0xffffu; }
__device__ __forceinline__ float bf2f_(unsigned short b) { return __builtin_bit_cast(float, (unsigned)b << 16); }
__device__ __forceinline__ float wave_sum(float v) {
#pragma unroll
    for (int o = 1; o < 64; o <<= 1) v += __shfl_xor(v, o);
    return v;
}

__device__ __forceinline__ int fresh_lane() { int l; asm volatile("v_mbcnt_lo_u32_b32 %0, -1, 0\n\tv_mbcnt_hi_u32_b32 %0, -1, %0" : "=v"(l)); return l; }

#define XB_TMO      128
#define XB_XCNT(j)  (256  + 64 * (j))
#define XB_XSUB(j)  (1280 + 64 * (j))
#define XB_XGEN(j)  (2304 + 64 * (j))
#define XB_TOP      3328
#define XB_TOPGEN   3392
#define XCD_BAR_WORDS 3456
#define XB_SPIN_CAP (1u << 23)
__device__ __forceinline__ unsigned xb_ld(unsigned* p)              { return __hip_atomic_load(p, __ATOMIC_RELAXED, __HIP_MEMORY_SCOPE_AGENT); }
__device__ __forceinline__ unsigned xb_add(unsigned* p, unsigned v) { return __hip_atomic_fetch_add(p, v, __ATOMIC_RELAXED, __HIP_MEMORY_SCOPE_AGENT); }
__device__ __forceinline__ unsigned xb_xcc_id() { return (unsigned)__builtin_amdgcn_s_getreg((3 << 11) | 20) & 0xFu; }
#define XB_SPIN(cond, bar) do { unsigned _sp = 0; while (cond) { __builtin_amdgcn_s_sleep(1); \
    if ((++_sp & 255u) == 0u) { if (xb_ld(&(bar)[XB_TMO])) break; if (_sp > XB_SPIN_CAP) { atomicAdd(&(bar)[XB_TMO], 1u); break; } } } } while (0)
struct XcdBarrier { unsigned* bar; unsigned x; volatile LAS unsigned* st; };
__device__ __forceinline__ XcdBarrier xcd_barrier_post(unsigned* bar, volatile LAS unsigned* st, int tid) {
    XcdBarrier b; b.bar = bar; b.x = xb_xcc_id(); b.st = st;
    if (tid == 0) (void)xb_add(&bar[XB_XCNT(b.x)], 1u);
    return b;
}
__device__ __forceinline__ void xcd_barrier_complete(unsigned* bar, unsigned x, unsigned& nloc, unsigned& nx) {
    const unsigned G = gridDim.x;
    unsigned sum, cnt, mine, sp = 0u;
    for (;;) {
        sum = 0u; cnt = 0u; mine = 0u;
#pragma unroll
        for (unsigned j = 0; j < 16; ++j) { const unsigned c = xb_ld(&bar[XB_XCNT(j)]); sum += c; cnt += (c > 0u) ? 1u : 0u; mine = (j == x) ? c : mine; }
        if (sum == G) break;
        __builtin_amdgcn_s_sleep(1);
        if ((++sp & 255u) == 0u) { if (xb_ld(&bar[XB_TMO])) break; if (sp > XB_SPIN_CAP) { atomicAdd(&bar[XB_TMO], 1u); break; } }
    }
    nloc = mine > 0u ? mine : 1u; nx = cnt > 0u ? cnt : 1u;
}
__device__ __forceinline__ void xcd_barrier(const XcdBarrier& b, int tid) {
    asm volatile("s_waitcnt vmcnt(0)" ::: "memory");
    __syncthreads();
    if (tid == 0) {
        unsigned* bar = b.bar;
        __builtin_amdgcn_s_waitcnt(0);
        unsigned nloc = b.st[0], nx = b.st[1];
        if (nloc == 0u) { xcd_barrier_complete(bar, b.x, nloc, nx); b.st[0] = nloc; b.st[1] = nx; }
        const unsigned old = xb_add(&bar[XB_XSUB(b.x)], 1u);
        const unsigned gen = old / nloc;
        if (old + 1u == (gen + 1u) * nloc) {
            __builtin_amdgcn_fence(__ATOMIC_RELEASE, "agent");
            asm volatile("s_waitcnt vmcnt(0)" ::: "memory");
            const unsigned og = xb_add(&bar[XB_TOP], 1u);
            const unsigned tg = og / nx;
            if (og + 1u == (tg + 1u) * nx) xb_add(&bar[XB_TOPGEN], 1u);
            else XB_SPIN(xb_ld(&bar[XB_TOPGEN]) == tg, bar);
            __builtin_amdgcn_fence(__ATOMIC_ACQUIRE, "agent");
            xb_add(&bar[XB_XGEN(b.x)], 1u);
            asm volatile("s_waitcnt vmcnt(0)" ::: "memory");
        } else {
            XB_SPIN(xb_ld(&bar[XB_XGEN(b.x)]) == gen, bar);
            __builtin_amdgcn_fence(__ATOMIC_ACQUIRE, "agent");
            asm volatile("s_waitcnt vmcnt(0)" ::: "memory");
        }
    }
    __syncthreads();
}

struct Params {
    const float* x; const float* norm1_g; const float* w_in; const float* hg_norm_g; const float* hg_lb; const float* q_norm_g; const float* k_norm_g;
    const float* w_a; const float* w_b; const float* w_out; const float* norm2_g; const float* peer_wq; const float* peer_sk; const float* peer_u; const float* peer_v;
    float* out; unsigned char* ws; int ph_lo, ph_hi;
};

__device__ __forceinline__ void p0_transpose_item(const float* W, int K, int N, const float* gk, bool permute, bf16* WT, LAS float* scr, int item, int lane) {
    const int nblk = N / 32, kb = item / nblk, nb = item % nblk, k0 = 64 * kb, n0 = 32 * nb;
    { const int r8 = lane >> 3, c4 = (lane & 7) * 4; f32x4 w[8];
#pragma unroll
      for (int i = 0; i < 8; ++i) w[i] = *(const GAS f32x4*)(W + (size_t)(k0 + 8 * i + r8) * N + n0 + c4);
#pragma unroll
      for (int i = 0; i < 8; ++i) { const int kk = 8 * i + r8; const float g = gk ? gk[k0 + kk] : 1.0f; LAS float* d = scr + kk * 33 + c4; d[0] = w[i].x * g; d[1] = w[i].y * g; d[2] = w[i].z * g; d[3] = w[i].w * g; } }
    LDS_WAIT(); asm volatile("" ::: "memory");
    int prow0 = n0;
    if (permute) { const int tile = n0 >> 8, lc = n0 & 255, wc = lc >> 6, bj = (lc >> 5) & 1; prow0 = tile * 256 + 128 * bj + 32 * wc; }
    const int c = lane & 7;
#pragma unroll
    for (int j = 0; j < 4; ++j) { const int n = (lane >> 3) + 8 * j; const LAS float* s = scr + (8 * c) * 33 + n;
        v4u o; o.x = pk2(s[0 * 33], s[1 * 33]); o.y = pk2(s[2 * 33], s[3 * 33]); o.z = pk2(s[4 * 33], s[5 * 33]); o.w = pk2(s[6 * 33], s[7 * 33]);
        *(GAS v4u*)(WT + (size_t)(prow0 + n) * K + k0 + 8 * c) = o; }
    LDS_WAIT(); asm volatile("" ::: "memory");
}
template <bool SIGNED> __device__ __forceinline__ void row_quant8(const float* xrow, const float* gcol, unsigned char* orow, float* scale_out, int lane) {
    const GAS f32x4* xr = (const GAS f32x4*)xrow + 4 * lane;
    f32x4 v[4]; float m = 0.f;
#pragma unroll
    for (int j = 0; j < 4; ++j) { v[j] = xr[j]; if (gcol) v[j] = v[j] * ((const GAS f32x4*)gcol)[4 * lane + j]; m = fmaxf(m, fmaxf(fmaxf(fabsf(v[j].x), fabsf(v[j].y)), fmaxf(fabsf(v[j].z), fabsf(v[j].w)))); }
#pragma unroll
    for (int o = 1; o < 64; o <<= 1) m = fmaxf(m, __shfl_xor(m, o));
    const float inv = m > 0.f ? 127.0f / m : 0.f; const int off = SIGNED ? 0 : 128;
    v4u o; unsigned w[4];
#pragma unroll
    for (int j = 0; j < 4; ++j) { const int q0 = __float2int_rn(v[j].x * inv) + off, q1 = __float2int_rn(v[j].y * inv) + off, q2 = __float2int_rn(v[j].z * inv) + off, q3 = __float2int_rn(v[j].w * inv) + off;
        w[j] = (unsigned)(q0 & 255) | ((unsigned)(q1 & 255) << 8) | ((unsigned)(q2 & 255) << 16) | ((unsigned)(q3 & 255) << 24); }
    o.x = w[0]; o.y = w[1]; o.z = w[2]; o.w = w[3];
    *(GAS v4u*)(orow + 16 * lane) = o;
    if (lane == 0) *scale_out = m * (1.0f / 127.0f);
}
template <bool SIGNED> __device__ __forceinline__ void row_quant8_regs(const f32x4 (&v)[4], unsigned char* orow, float* scale_out, int lane) {
    float m = 0.f;
#pragma unroll
    for (int j = 0; j < 4; ++j) m = fmaxf(m, fmaxf(fmaxf(fabsf(v[j].x), fabsf(v[j].y)), fmaxf(fabsf(v[j].z), fabsf(v[j].w))));
#pragma unroll
    for (int o = 1; o < 64; o <<= 1) m = fmaxf(m, __shfl_xor(m, o));
    const float inv = m > 0.f ? 127.0f / m : 0.f; const int off = SIGNED ? 0 : 128;
    v4u o; unsigned w[4];
#pragma unroll
    for (int j = 0; j < 4; ++j) { const int q0 = __float2int_rn(v[j].x * inv) + off, q1 = __float2int_rn(v[j].y * inv) + off, q2 = __float2int_rn(v[j].z * inv) + off, q3 = __float2int_rn(v[j].w * inv) + off;
        w[j] = (unsigned)(q0 & 255) | ((unsigned)(q1 & 255) << 8) | ((unsigned)(q2 & 255) << 16) | ((unsigned)(q3 & 255) << 24); }
    o.x = w[0]; o.y = w[1]; o.z = w[2]; o.w = w[3];
    *(GAS v4u*)(orow + 16 * lane) = o;
    if (lane == 0) *scale_out = m * (1.0f / 127.0f);
}
__device__ __forceinline__ void quant_tables(const Params& P, int wi, int nw, int wave, int lane) {
    unsigned char* UQ = P.ws + WS_U; unsigned char* VQ = P.ws + WS_V; float* SUV = (float*)(P.ws + WS_SU);
    f32x4 gg[4];
#pragma unroll
    for (int j = 0; j < 4; ++j) gg[j] = ((const GAS f32x4*)P.norm2_g)[4 * lane + j];
    const int stride = nw * NWAVES;
    for (int e = wi * NWAVES + wave; e < NEXP; e += 2 * stride) {
        const int e2 = e + stride < NEXP ? e + stride : e;
        f32x4 ua[4], va[4], ub[4], vb[4];
#pragma unroll
        for (int j = 0; j < 4; ++j) { ua[j] = ((const GAS f32x4*)(P.peer_u + (size_t)e * DM))[4 * lane + j]; va[j] = ((const GAS f32x4*)(P.peer_v + (size_t)e * DM))[4 * lane + j];
            ub[j] = ((const GAS f32x4*)(P.peer_u + (size_t)e2 * DM))[4 * lane + j]; vb[j] = ((const GAS f32x4*)(P.peer_v + (size_t)e2 * DM))[4 * lane + j]; }
#pragma unroll
        for (int j = 0; j < 4; ++j) { ua[j] = ua[j] * gg[j]; ub[j] = ub[j] * gg[j]; }
        row_quant8_regs<true>(ua, UQ + (size_t)e * DM, SUV + 2 * e, lane); row_quant8_regs<true>(va, VQ + (size_t)e * DM, SUV + 2 * e + 1, lane);
        row_quant8_regs<true>(ub, UQ + (size_t)e2 * DM, SUV + 2 * e2, lane); row_quant8_regs<true>(vb, VQ + (size_t)e2 * DM, SUV + 2 * e2 + 1, lane);
    }
}
__device__ __forceinline__ void p0_colmax_item(const float* W, int N, const float* gk, unsigned* cmax, int item, int lane) {
    const int nblk = N / 32, kb = item / nblk, nb = item % nblk, k0 = 64 * kb, n0 = 32 * nb;
    const int r8 = lane >> 3, c4 = (lane & 7) * 4; f32x4 w[8];
#pragma unroll
    for (int i = 0; i < 8; ++i) w[i] = *(const GAS f32x4*)(W + (size_t)(k0 + 8 * i + r8) * N + n0 + c4);
    float m0 = 0.f, m1 = 0.f, m2 = 0.f, m3 = 0.f;
#pragma unroll
    for (int i = 0; i < 8; ++i) { const float g = gk[k0 + 8 * i + r8]; m0 = fmaxf(m0, fabsf(w[i].x * g)); m1 = fmaxf(m1, fabsf(w[i].y * g)); m2 = fmaxf(m2, fabsf(w[i].z * g)); m3 = fmaxf(m3, fabsf(w[i].w * g)); }
#pragma unroll
    for (int o = 8; o < 64; o <<= 1) { m0 = fmaxf(m0, __shfl_xor(m0, o)); m1 = fmaxf(m1, __shfl_xor(m1, o)); m2 = fmaxf(m2, __shfl_xor(m2, o)); m3 = fmaxf(m3, __shfl_xor(m3, o)); }
    if (lane < 8) { atomicMax(cmax + n0 + c4, __builtin_bit_cast(unsigned, m0)); atomicMax(cmax + n0 + c4 + 1, __builtin_bit_cast(unsigned, m1)); atomicMax(cmax + n0 + c4 + 2, __builtin_bit_cast(unsigned, m2)); atomicMax(cmax + n0 + c4 + 3, __builtin_bit_cast(unsigned, m3)); }
}
__device__ __forceinline__ void p0_quant_item(const float* W, int K, int N, const float* gk, const unsigned* cmax, unsigned char* WT8, float* sw, LAS float* scr, int item, int lane) {
    const int nblk = N / 32, kb = item / nblk, nb = item % nblk, k0 = 64 * kb, n0 = 32 * nb;
    const float cm = __builtin_bit_cast(float, __hip_atomic_load(cmax + n0 + (lane & 31), __ATOMIC_RELAXED, __HIP_MEMORY_SCOPE_AGENT)); const float inv = cm > 0.f ? 127.0f / cm : 0.f;
    { const int r8 = lane >> 3, c4 = (lane & 7) * 4; f32x4 w[8]; float iv[4];
#pragma unroll
      for (int i = 0; i < 8; ++i) w[i] = *(const GAS f32x4*)(W + (size_t)(k0 + 8 * i + r8) * N + n0 + c4);
#pragma unroll
      for (int j = 0; j < 4; ++j) { const float c = __builtin_bit_cast(float, __hip_atomic_load(cmax + n0 + c4 + j, __ATOMIC_RELAXED, __HIP_MEMORY_SCOPE_AGENT)); iv[j] = c > 0.f ? 127.0f / c : 0.f; }
#pragma unroll
      for (int i = 0; i < 8; ++i) { const int kk = 8 * i + r8; const float g = gk[k0 + kk]; LAS float* d = scr + kk * 33 + c4; d[0] = w[i].x * g * iv[0]; d[1] = w[i].y * g * iv[1]; d[2] = w[i].z * g * iv[2]; d[3] = w[i].w * g * iv[3]; } }
    (void)inv;
    LDS_WAIT(); asm volatile("" ::: "memory");
    const int tile = n0 >> 8, lc = n0 & 255, wc = lc >> 6, bj = (lc >> 5) & 1; const int prow0 = tile * 256 + 128 * bj + 32 * wc;
    if (kb == 0 && lane < 32) sw[prow0 + lane] = cm * (1.0f / 127.0f);
    const int n = lane >> 1, hf = lane & 1; const LAS float* sp = scr + (32 * hf) * 33 + n; unsigned w[8];
#pragma unroll
    for (int j = 0; j < 8; ++j) { const int q0 = __float2int_rn(sp[(4 * j) * 33]), q1 = __float2int_rn(sp[(4 * j + 1) * 33]), q2 = __float2int_rn(sp[(4 * j + 2) * 33]), q3 = __float2int_rn(sp[(4 * j + 3) * 33]);
        w[j] = (unsigned)(q0 & 255) | ((unsigned)(q1 & 255) << 8) | ((unsigned)(q2 & 255) << 16) | ((unsigned)(q3 & 255) << 24); }
    v4u o0, o1; o0.x = w[0]; o0.y = w[1]; o0.z = w[2]; o0.w = w[3]; o1.x = w[4]; o1.y = w[5]; o1.z = w[6]; o1.w = w[7];
    GAS v4u* dst = (GAS v4u*)(WT8 + (size_t)(prow0 + n) * K + k0 + 32 * hf); dst[0] = o0; dst[1] = o1;
    LDS_WAIT(); asm volatile("" ::: "memory");
}
__device__ __forceinline__ void row_quant_rms_regs(const f32x4 (&v)[4], unsigned char* orow, float* scale_out, int lane) {
    float m = 0.f, ss = 0.f;
#pragma unroll
    for (int j = 0; j < 4; ++j) { m = fmaxf(m, fmaxf(fmaxf(fabsf(v[j].x), fabsf(v[j].y)), fmaxf(fabsf(v[j].z), fabsf(v[j].w)))); ss += (v[j].x * v[j].x + v[j].y * v[j].y) + (v[j].z * v[j].z + v[j].w * v[j].w); }
#pragma unroll
    for (int o = 1; o < 64; o <<= 1) { m = fmaxf(m, __shfl_xor(m, o)); ss += __shfl_xor(ss, o); }
    const float inv = m > 0.f ? 127.0f / m : 0.f; unsigned w[4];
#pragma unroll
    for (int j = 0; j < 4; ++j) { const int q0 = __float2int_rn(v[j].x * inv), q1 = __float2int_rn(v[j].y * inv), q2 = __float2int_rn(v[j].z * inv), q3 = __float2int_rn(v[j].w * inv);
        w[j] = (unsigned)(q0 & 255) | ((unsigned)(q1 & 255) << 8) | ((unsigned)(q2 & 255) << 16) | ((unsigned)(q3 & 255) << 24); }
    v4u o; o.x = w[0]; o.y = w[1]; o.z = w[2]; o.w = w[3];
    *(GAS v4u*)(orow + 16 * lane) = o;
    if (lane == 0) *scale_out = rsqrtf(ss * (1.0f / DM) + EPS) * m * (1.0f / 127.0f);
}
__device__ __forceinline__ void p0_prologue_a(const Params& P, LAS unsigned char* lds, int wave, int lane, int part) {
    const int tid = wave * 64 + lane;
    LAS float* scr = (LAS float*)(lds + wave * 16384);
    const int gw = blockIdx.x * NWAVES + wave, NGW = gridDim.x * NWAVES;
    bf16* WA = (bf16*)(P.ws + WS_WA); bf16* WB = (bf16*)(P.ws + WS_WB); bf16* WOUT = (bf16*)(P.ws + WS_WOUT); bf16* WQ = (bf16*)(P.ws + WS_WQ);
    constexpr int I_IN = (1024 / 64) * (NIN / 32), I_A = (512 / 64) * (1024 / 32), I_B = (256 / 64) * (1024 / 32), I_O = (1024 / 64) * (1024 / 32), I_Q = I_O;
    constexpr int NITEMS = I_IN + I_A + I_B + I_O + I_Q;
    if (part == 0) { for (int it = gw; it < I_IN; it += NGW) p0_colmax_item(P.w_in, NIN, P.norm1_g, (unsigned*)(P.ws + WS_CMAX), it, lane); return; }
    for (int it = I_IN + gw; it < NITEMS; it += NGW) {
        int r = it - I_IN;
        if (r < I_A) { p0_transpose_item(P.w_a, 512, 1024, nullptr, false, WA, scr, r, lane); continue; } r -= I_A;
        if (r < I_B) { p0_transpose_item(P.w_b, 256, 1024, nullptr, false, WB, scr, r, lane); continue; } r -= I_B;
        if (r < I_O) { p0_transpose_item(P.w_out, 1024, 1024, nullptr, false, WOUT, scr, r, lane); continue; } r -= I_O;
        p0_transpose_item(P.peer_wq, 1024, 1024, P.norm2_g, false, WQ, scr, r, lane);
    }
    { bf16* SK = (bf16*)(P.ws + WS_SK); const int gt = blockIdx.x * (NWAVES * 64) + tid, NT = gridDim.x * NWAVES * 64;
      for (int i = gt; i < 8 * 2 * 128 * 64 / 2; i += NT) ((unsigned*)SK)[i] = pk2(P.peer_sk[2 * i], P.peer_sk[2 * i + 1]); }
    { unsigned char* XN8 = (unsigned char*)P.out + OUT_XN; float* sxn = (float*)(P.ws + WS_SXN);
      for (int m = gw; m < MTOK; m += 2 * NGW) { const int m2 = m + NGW < MTOK ? m + NGW : m;
          f32x4 va[4], vb[4];
#pragma unroll
          for (int j = 0; j < 4; ++j) { va[j] = ((const GAS f32x4*)(P.x + (size_t)m * DM))[4 * lane + j]; vb[j] = ((const GAS f32x4*)(P.x + (size_t)m2 * DM))[4 * lane + j]; }
          row_quant_rms_regs(va, XN8 + (size_t)m * DM, sxn + m, lane); row_quant_rms_regs(vb, XN8 + (size_t)m2 * DM, sxn + m2, lane); } }
}
__device__ __forceinline__ void p0_prologue_b(const Params& P, LAS unsigned char* lds, int wave, int lane) {
    LAS float* scr = (LAS float*)(lds + wave * 16384);
    const int gw = blockIdx.x * NWAVES + wave, NGW = gridDim.x * NWAVES;
    constexpr int I_IN = (1024 / 64) * (NIN / 32);
    for (int it = gw; it < I_IN; it += NGW) p0_quant_item(P.w_in, 1024, NIN, P.norm1_g, (const unsigned*)(P.ws + WS_CMAX), P.ws + WS_WIN, (float*)(P.ws + WS_SW), scr, it, lane);
}

__device__ __forceinline__ unsigned cvtpk(float lo, float hi) { typedef __bf16 b2 __attribute__((ext_vector_type(2))); typedef float f2 __attribute__((ext_vector_type(2))); f2 v = {lo, hi}; return __builtin_bit_cast(unsigned, __builtin_convertvector(v, b2)); }
typedef short s16x4 __attribute__((ext_vector_type(4)));
__device__ __forceinline__ s16x4 ds_tr16(const LAS unsigned char* p) { return __builtin_bit_cast(s16x4, __builtin_amdgcn_ds_read_tr16_b64_v4i16((LAS s16x4*)p)); }
__device__ __forceinline__ void hgrn_chunked_item(const Params& P, LAS unsigned char* lds, int item, int wave, int lane) {
    constexpr int QD_P = 272, TR_P = 320;
    constexpr int L_QD = 0, L_KI = 17408, L_KT = 34816, L_V = 55296, L_DEC = 75776, L_AP = 76288, L_OB = 82432;
    const int tid = wave * 64 + lane, b = item >> 2, h = item & 3;
    const int lrow = tid >> 3, lc = (tid & 7) * 16;
    const int l31 = lane & 31, hh = lane >> 5, jv = wave & 3, kh = wave >> 2;
    const bf16* base = (const bf16*)(P.ws + WS_PROJ) + (size_t)b * SEQ * NIN + h * 128;
    const bf16* kib = (const bf16*)((const unsigned char*)P.out + OUT_KI) + (size_t)b * SEQ * 512 + h * 128;
    bf16* YA = (bf16*)((unsigned char*)P.out + OUT_YA) + (size_t)b * SEQ * 512 + h * 128;
    float gn[16];
#pragma unroll
    for (int e = 0; e < 16; ++e) gn[e] = P.hg_norm_g[lc + e];
    f32x16 S[2];
    S[0] = f32x16{}; S[1] = f32x16{};
    v4u pq[2], pd[2], pk[2], pv[2], pg[2];
#define HG_LOAD(n_) do { const size_t ro_ = (size_t)((n_) * 64 + lrow); const bf16* r = base + ro_ * NIN + lc; const bf16* kr = kib + ro_ * 512 + lc; \
      pg[0] = *(const v4u*)(r + 1536); pg[1] = *(const v4u*)(r + 1544);   \
      pq[0] = *(const v4u*)r; pq[1] = *(const v4u*)(r + 8); pd[0] = *(const v4u*)(r + 512); pd[1] = *(const v4u*)(r + 520); pk[0] = *(const v4u*)kr; pk[1] = *(const v4u*)(kr + 8); \
      pv[0] = *(const v4u*)(r + 1024); pv[1] = *(const v4u*)(r + 1032); } while (0)
    HG_LOAD(0);
    const int tro = (4 * hh + ((lane & 15) >> 2)) * TR_P + (16 * ((lane >> 4) & 1) + 4 * (lane & 3)) * 2;
#pragma unroll 1
    for (int n = 0; n < SEQ / 64; ++n) {
        { const unsigned qw[8] = {pq[0].x, pq[0].y, pq[0].z, pq[0].w, pq[1].x, pq[1].y, pq[1].z, pq[1].w}, dw[8] = {pd[0].x, pd[0].y, pd[0].z, pd[0].w, pd[1].x, pd[1].y, pd[1].z, pd[1].w};
          unsigned w[8];
#pragma unroll
          for (int e = 0; e < 8; ++e) w[e] = pk2(pg8::bflo(qw[e]) * pg8::bflo(dw[e]), pg8::bfhi(qw[e]) * pg8::bfhi(dw[e]));
          v4u a0, a1; a0.x = w[0]; a0.y = w[1]; a0.z = w[2]; a0.w = w[3]; a1.x = w[4]; a1.y = w[5]; a1.z = w[6]; a1.w = w[7];
          *(LAS v4u*)(lds + L_QD + lrow * QD_P + lc * 2) = a0; *(LAS v4u*)(lds + L_QD + lrow * QD_P + lc * 2 + 16) = a1;
          if (lrow == 63) {
#pragma unroll
              for (int e4 = 0; e4 < 4; ++e4) *(LAS f32x4*)(lds + L_DEC + (lc + 4 * e4) * 4) = (f32x4){pg8::bflo(dw[2 * e4]), pg8::bfhi(dw[2 * e4]), pg8::bflo(dw[2 * e4 + 1]), pg8::bfhi(dw[2 * e4 + 1])}; } }
        *(LAS v4u*)(lds + L_KI + lrow * QD_P + lc * 2) = pk[0]; *(LAS v4u*)(lds + L_KI + lrow * QD_P + lc * 2 + 16) = pk[1];
        *(LAS v4u*)(lds + L_KT + lrow * TR_P + lc * 2) = pk[0]; *(LAS v4u*)(lds + L_KT + lrow * TR_P + lc * 2 + 16) = pk[1];
        *(LAS v4u*)(lds + L_V + lrow * TR_P + lc * 2) = pv[0]; *(LAS v4u*)(lds + L_V + lrow * TR_P + lc * 2 + 16) = pv[1];
        const v4u og0 = pg[0], og1 = pg[1];
        HG_LOAD(n + 1 < SEQ / 64 ? n + 1 : n);
        __syncthreads();
        if (wave < 3) {
            const int st = wave >> 1, ct = (wave + 1) >> 1;
            f32x16 a_ = f32x16{};
#pragma unroll
            for (int ks = 0; ks < 8; ++ks) { const bf16x8 af = *(const LAS bf16x8*)(lds + L_KI + (32 * st + l31) * QD_P + (16 * ks + 8 * hh) * 2), bfr = *(const LAS bf16x8*)(lds + L_QD + (32 * ct + l31) * QD_P + (16 * ks + 8 * hh) * 2);
                a_ = __builtin_amdgcn_mfma_f32_32x32x16_bf16(af, bfr, a_, 0, 0, 0); }
            if (st == ct) {
#pragma unroll
                for (int r = 0; r < 16; ++r) if ((r & 3) + 8 * (r >> 2) + 4 * hh > l31) a_[r] = 0.f; }
            v4u a0, a1;
            a0.x = cvtpk(a_[0], a_[1]); a0.y = cvtpk(a_[2], a_[3]); a0.z = cvtpk(a_[4], a_[5]); a0.w = cvtpk(a_[6], a_[7]);
            a1.x = cvtpk(a_[8], a_[9]); a1.y = cvtpk(a_[10], a_[11]); a1.z = cvtpk(a_[12], a_[13]); a1.w = cvtpk(a_[14], a_[15]);
            *(LAS v4u*)(lds + L_AP + wave * 2048 + lane * 16) = a0; *(LAS v4u*)(lds + L_AP + wave * 2048 + 1024 + lane * 16) = a1;
        }
        f32x16 oacc[2]; oacc[0] = f32x16{}; oacc[1] = f32x16{};
#pragma unroll
        for (int kl = 0; kl < 2; ++kl)
#pragma unroll
            for (int st = 0; st < 2; ++st) {
                v4u sb; sb.x = cvtpk(S[kl][8 * st + 0], S[kl][8 * st + 1]); sb.y = cvtpk(S[kl][8 * st + 2], S[kl][8 * st + 3]); sb.z = cvtpk(S[kl][8 * st + 4], S[kl][8 * st + 5]); sb.w = cvtpk(S[kl][8 * st + 6], S[kl][8 * st + 7]);
                typedef unsigned u2v __attribute__((ext_vector_type(2)));
#pragma unroll
                for (int rt = 0; rt < 2; ++rt) {
                    const LAS unsigned char* qp = lds + L_QD + (32 * rt + l31) * QD_P + (32 * (2 * kh + kl) + 16 * st + 4 * hh) * 2;
                    const u2v lo = *(const LAS u2v*)qp, hi = *(const LAS u2v*)(qp + 16);
                    v4u av; av.x = lo.x; av.y = lo.y; av.z = hi.x; av.w = hi.y;
                    oacc[rt] = __builtin_amdgcn_mfma_f32_32x32x16_bf16(__builtin_bit_cast(bf16x8, av), __builtin_bit_cast(bf16x8, sb), oacc[rt], 0, 0, 0); } }
        bf16x8 vf[4];
#pragma unroll
        for (int ks = 0; ks < 4; ++ks) { const LAS unsigned char* a1 = lds + L_V + tro + (16 * ks) * TR_P + (32 * jv) * 2; const s16x4 lo = ds_tr16(a1), hi = ds_tr16(a1 + 8 * TR_P);
            vf[ks] = (bf16x8){lo[0], lo[1], lo[2], lo[3], hi[0], hi[1], hi[2], hi[3]}; }
#pragma unroll
        for (int kl = 0; kl < 2; ++kl) {
            const int kt = 2 * kh + kl;
#pragma unroll
            for (int ks = 0; ks < 4; ++ks) { const LAS unsigned char* a1 = lds + L_KT + tro + (16 * ks) * TR_P + (32 * kt) * 2; const s16x4 lo = ds_tr16(a1), hi = ds_tr16(a1 + 8 * TR_P);
                const bf16x8 kf = {lo[0], lo[1], lo[2], lo[3], hi[0], hi[1], hi[2], hi[3]};
                S[kl] = __builtin_amdgcn_mfma_f32_32x32x16_bf16(kf, vf[ks], S[kl], 0, 0, 0); }
#pragma unroll
            for (int r4 = 0; r4 < 4; ++r4) { const f32x4 d = *(const LAS f32x4*)(lds + L_DEC + (32 * kt + 8 * r4 + 4 * hh) * 4);
                S[kl][4 * r4 + 0] *= d.x; S[kl][4 * r4 + 1] *= d.y; S[kl][4 * r4 + 2] *= d.z; S[kl][4 * r4 + 3] *= d.w; }
        }
        __syncthreads();
        if (kh == 0) {
            const v4u a0 = *(const LAS v4u*)(lds + L_AP + lane * 16), a1 = *(const LAS v4u*)(lds + L_AP + 1024 + lane * 16);
            oacc[0] = __builtin_amdgcn_mfma_f32_32x32x16_bf16(__builtin_bit_cast(bf16x8, a0), vf[0], oacc[0], 0, 0, 0);
            oacc[0] = __builtin_amdgcn_mfma_f32_32x32x16_bf16(__builtin_bit_cast(bf16x8, a1), vf[1], oacc[0], 0, 0, 0);
        } else {
#pragma unroll
            for (int st = 0; st < 2; ++st) { const v4u a0 = *(const LAS v4u*)(lds + L_AP + (1 + st) * 2048 + lane * 16), a1 = *(const LAS v4u*)(lds + L_AP + (1 + st) * 2048 + 1024 + lane * 16);
                oacc[1] = __builtin_amdgcn_mfma_f32_32x32x16_bf16(__builtin_bit_cast(bf16x8, a0), vf[2 * st], oacc[1], 0, 0, 0);
                oacc[1] = __builtin_amdgcn_mfma_f32_32x32x16_bf16(__builtin_bit_cast(bf16x8, a1), vf[2 * st + 1], oacc[1], 0, 0, 0); }
        }
#pragma unroll
        for (int rt = 0; rt < 2; ++rt)
#pragma unroll
            for (int r = 0; r < 16; ++r) ((LAS float*)(lds + L_OB + kh * 32768))[(32 * rt + (r & 3) + 8 * (r >> 2) + 4 * hh) * 128 + 32 * jv + l31] = oacc[rt][r];
        __syncthreads();
        {
            float o[16]; float ss = 0.f;
#pragma unroll
            for (int e4 = 0; e4 < 4; ++e4) { const f32x4 t = *(const LAS f32x4*)(lds + L_OB + (lrow * 128 + lc + 4 * e4) * 4) + *(const LAS f32x4*)(lds + L_OB + 32768 + (lrow * 128 + lc + 4 * e4) * 4);
                o[4 * e4] = t.x; o[4 * e4 + 1] = t.y; o[4 * e4 + 2] = t.z; o[4 * e4 + 3] = t.w; ss += (t.x * t.x + t.y * t.y) + (t.z * t.z + t.w * t.w); }
            ss += __shfl_xor(ss, 1); ss += __shfl_xor(ss, 2); ss += __shfl_xor(ss, 4);
            const float rs = rsqrtf(ss * (1.0f / 128.0f) + EPS);
            const unsigned gw[8] = {og0.x, og0.y, og0.z, og0.w, og1.x, og1.y, og1.z, og1.w};
            unsigned yw[8];
#pragma unroll
            for (int e = 0; e < 8; ++e) yw[e] = pk2(o[2 * e] * rs * gn[2 * e] * pg8::bflo(gw[e]), o[2 * e + 1] * rs * gn[2 * e + 1] * pg8::bfhi(gw[e]));
            bf16* yp = YA + (size_t)(n * 64 + lrow) * 512 + lc;
            v4u y0, y1; y0.x = yw[0]; y0.y = yw[1]; y0.z = yw[2]; y0.w = yw[3]; y1.x = yw[4]; y1.y = yw[5]; y1.z = yw[6]; y1.w = yw[7];
            pg8::st_wt(yp, __builtin_bit_cast(pg8::u32x4, y0)); pg8::st_wt(yp + 8, __builtin_bit_cast(pg8::u32x4, y1));
        }
    }
#undef HG_LOAD
    __syncthreads();
}

constexpr int KB_P = 144;
constexpr int VB_P = 192;
template <int CG> __device__ __forceinline__ void attn_group(const bf16* base, LAS unsigned char* vbuf, int h, int r, int p0, int lane, float Mfix, f32x16 (&oT)[2], float& lsum) {
    constexpr int dil = (CG == 0) ? 1 : (CG == 1) ? 4 : 16, Lg = SEQ / dil, NT = 5;
    const int l31 = lane & 31, hh = lane >> 5;
    const int qcol = 2048 + (CG * 4 + h) * 64, kcol = qcol + 768, vcol = qcol + 1536;
    bf16x8 qf[4];
    { const bf16* qr = base + (size_t)(dil * (p0 + l31) + r) * NIN + qcol + 8 * hh;
#pragma unroll
      for (int ks = 0; ks < 4; ++ks) qf[ks] = *(const bf16x8*)(qr + 16 * ks); }
    const int Pq = p0 + l31, lim = Pq < 128 ? Pq : 128;
    const int kp0 = p0 - 128;
    const bool full = p0 >= 128;
    const int r8 = lane >> 3, ch = lane & 7;
    LAS unsigned char* kbuf = vbuf + 32 * VB_P;
    v4u k0[4], v0[4], k1[4], v1[4], k2[4], v2[4];
#define ATT_LOAD(KR, VR, t_) do { _Pragma("unroll") for (int c = 0; c < 4; ++c) { int pa = kp0 + 32 * (t_) + r8 + 8 * c; pa = pa < 0 ? 0 : (pa > Lg - 1 ? Lg - 1 : pa); \
        const bf16* rr = base + (size_t)(pa * dil + r) * NIN + 8 * ch; KR[c] = *(const v4u*)(rr + kcol); VR[c] = *(const v4u*)(rr + vcol); } } while (0)
    const LAS unsigned char* trp = vbuf + (4 * hh + ((lane & 15) >> 2)) * VB_P + (16 * ((lane >> 4) & 1) + 4 * (lane & 3)) * 2;
    const LAS unsigned char* kfp = kbuf + l31 * KB_P + 16 * hh;
#define ATT_TILE(KR, VR, t_, EDGE) do { const int kp = kp0 + 32 * (t_); \
        _Pragma("unroll") for (int c = 0; c < 4; ++c) { *(LAS v4u*)(kbuf + (r8 + 8 * c) * KB_P + 16 * ch) = KR[c]; *(LAS v4u*)(vbuf + (r8 + 8 * c) * VB_P + 16 * ch) = VR[c]; } \
        f32x16 sc = f32x16{}; \
        _Pragma("unroll") for (int ks = 0; ks < 4; ++ks) sc = __builtin_amdgcn_mfma_f32_32x32x16_bf16(*(const LAS bf16x8*)(kfp + 32 * ks), qf[ks], sc, 0, 0, 0); \
        float p[16]; \
        if ((EDGE) || !full) { const int dl = Pq - kp - 4 * hh; \
            _Pragma("unroll") for (int q = 0; q < 16; ++q) { const int d = dl - ((q & 3) + 8 * (q >> 2)); const float e = __builtin_amdgcn_exp2f(sc[q] - Mfix); p[q] = ((unsigned)d <= (unsigned)lim) ? e : 0.f; lsum += p[q]; } } \
        else { _Pragma("unroll") for (int q = 0; q < 16; ++q) { p[q] = __builtin_amdgcn_exp2f(sc[q] - Mfix); lsum += p[q]; } } \
        v4u pk0, pk1; \
        pk0.x = cvtpk(p[0], p[1]); pk0.y = cvtpk(p[2], p[3]); pk0.z = cvtpk(p[4], p[5]); pk0.w = cvtpk(p[6], p[7]); \
        pk1.x = cvtpk(p[8], p[9]); pk1.y = cvtpk(p[10], p[11]); pk1.z = cvtpk(p[12], p[13]); pk1.w = cvtpk(p[14], p[15]); \
        _Pragma("unroll") for (int dt = 0; dt < 2; ++dt) _Pragma("unroll") for (int ss = 0; ss < 2; ++ss) { const LAS unsigned char* a1 = trp + (16 * ss) * VB_P + (32 * dt) * 2; \
                const s16x4 lo = ds_tr16(a1), hi = ds_tr16(a1 + 8 * VB_P); \
                const bf16x8 vf = {lo[0], lo[1], lo[2], lo[3], hi[0], hi[1], hi[2], hi[3]}; \
                oT[dt] = __builtin_amdgcn_mfma_f32_32x32x16_bf16(vf, __builtin_bit_cast(bf16x8, ss == 0 ? pk0 : pk1), oT[dt], 0, 0, 0); } } while (0)
    ATT_LOAD(k0, v0, 0); ATT_LOAD(k1, v1, 1);
#pragma unroll 1
    for (int tile = 0; tile < NT; tile += 3) {
        ATT_LOAD(k2, v2, (tile + 2 < NT ? tile + 2 : NT - 1)); ATT_TILE(k0, v0, tile, tile == 0);
        ATT_LOAD(k0, v0, (tile + 3 < NT ? tile + 3 : NT - 1)); ATT_TILE(k1, v1, tile + 1, tile + 1 == NT - 1);
        ATT_LOAD(k1, v1, (tile + 4 < NT ? tile + 4 : NT - 1)); if (tile + 2 < NT) ATT_TILE(k2, v2, tile + 2, false);
    }
#undef ATT_TILE
#undef ATT_LOAD
}
constexpr int AT_O0 = 86016, AT_L0 = AT_O0 + 65536, AT_TSK = AT_L0 + 2048;
__device__ __forceinline__ void attn_wg_task(const Params& P, LAS unsigned char* lds, int task, int wave, int lane, float Mfix) {
    const int pt = task & 3, h = (task >> 2) & 3, b = task >> 4;
    const bf16* base = (const bf16*)(P.ws + WS_PROJ) + (size_t)b * SEQ * NIN;
    LAS unsigned char* vbuf = lds + wave * 10752;
    typedef unsigned u2v __attribute__((ext_vector_type(2)));
    const int l31 = lane & 31, hh = lane >> 5;
#define AT_CHUNK(p_, dt_, r4_) (lds + AT_O0 + (p_) * 128 + ((8 * (dt_) + 2 * (r4_) + hh + ((p_) >> 4) + (p_)) & 15) * 8)
#pragma unroll 1
    for (int i = 0; i < 2; ++i) {
        f32x16 oT[2]; oT[0] = f32x16{}; oT[1] = f32x16{}; float lsum = 0.f;
        const int pl = 64 * wave + 32 * i;
        attn_group<0>(base, vbuf, h, 0, 512 * pt + pl, lane, Mfix, oT, lsum);
        lsum += __shfl_xor(lsum, 32);
        const int p = pl + l31;
        if (hh == 0) ((LAS float*)(lds + AT_L0))[p] = lsum;
#pragma unroll
        for (int dt = 0; dt < 2; ++dt)
#pragma unroll
            for (int r4 = 0; r4 < 4; ++r4) { u2v w; w.x = cvtpk(oT[dt][4 * r4], oT[dt][4 * r4 + 1]); w.y = cvtpk(oT[dt][4 * r4 + 2], oT[dt][4 * r4 + 3]); *(LAS u2v*)AT_CHUNK(p, dt, r4) = w; }
    }
    __syncthreads();
#pragma unroll 1
    for (int i = 0; i < 2; ++i) {
        f32x16 oT[2]; oT[0] = f32x16{}; oT[1] = f32x16{}; float lsum = 0.f;
        const int pair = 2 * wave + i, c4 = pair & 3, tq = pair >> 2;
        attn_group<1>(base, vbuf, h, c4, 128 * pt + 32 * tq, lane, Mfix, oT, lsum);
        lsum += __shfl_xor(lsum, 32);
        const int p = 4 * (32 * tq + l31) + c4;
        if (hh == 0) ((LAS float*)(lds + AT_L0))[p] += lsum;
#pragma unroll
        for (int dt = 0; dt < 2; ++dt)
#pragma unroll
            for (int r4 = 0; r4 < 4; ++r4) { LAS u2v* cp = (LAS u2v*)AT_CHUNK(p, dt, r4); const u2v o0 = *cp;
                u2v w; w.x = cvtpk(oT[dt][4 * r4] + pg8::bflo(o0.x), oT[dt][4 * r4 + 1] + pg8::bfhi(o0.x)); w.y = cvtpk(oT[dt][4 * r4 + 2] + pg8::bflo(o0.y), oT[dt][4 * r4 + 3] + pg8::bfhi(o0.y)); *cp = w; }
    }
    __syncthreads();
#pragma unroll 1
    for (int i = 0; i < 2; ++i) {
        const int r16 = 2 * wave + i;
        f32x16 oT[2]; oT[0] = f32x16{}; oT[1] = f32x16{}; float lsum = 0.f;
        attn_group<2>(base, vbuf, h, r16, 32 * pt, lane, Mfix, oT, lsum);
        lsum += __shfl_xor(lsum, 32);
        const int p = 16 * l31 + r16;
        lsum += ((const LAS float*)(lds + AT_L0))[p];
        const float rl = 1.0f / lsum;
        bf16* yb = (bf16*)((unsigned char*)P.out + OUT_YB) + (size_t)(b * SEQ + 512 * pt + p) * 256 + h * 64;
#pragma unroll
        for (int dt = 0; dt < 2; ++dt)
#pragma unroll
            for (int r4 = 0; r4 < 4; ++r4) { const u2v o0 = *(const LAS u2v*)AT_CHUNK(p, dt, r4);
                u2v w; w.x = cvtpk((oT[dt][4 * r4] + pg8::bflo(o0.x)) * rl, (oT[dt][4 * r4 + 1] + pg8::bfhi(o0.x)) * rl); w.y = cvtpk((oT[dt][4 * r4 + 2] + pg8::bflo(o0.y)) * rl, (oT[dt][4 * r4 + 3] + pg8::bfhi(o0.y)) * rl);
                *(u2v*)(yb + 32 * dt + 8 * r4 + 4 * hh) = w; }
    }
#undef AT_CHUNK
    __syncthreads();
}

__host__ __device__ __forceinline__ unsigned f2key(float f) { const unsigned u = __builtin_bit_cast(unsigned, f); return (u & 0x80000000u) ? ~u : (u | 0x80000000u); }
__host__ __device__ __forceinline__ float key2f(unsigned k) { const unsigned u = (k & 0x80000000u) ? (k & 0x7fffffffu) : ~k; return __builtin_bit_cast(float, u); }
__device__ __forceinline__ unsigned fkmax(unsigned a, unsigned b) { unsigned r; asm("v_max_f32 %0, %1, %2" : "=v"(r) : "v"(a), "v"(b)); return r; }
__device__ __forceinline__ unsigned fkmin(unsigned a, unsigned b) { unsigned r; asm("v_min_f32 %0, %1, %2" : "=v"(r) : "v"(a), "v"(b)); return r; }
#define CE(K, a, b) do { const unsigned x_ = K[a], y_ = K[b]; K[a] = fkmax(x_, y_); K[b] = fkmin(x_, y_); } while (0)
#define BSORT16(K) do { CE(K,0,1); CE(K,3,2); CE(K,4,5); CE(K,7,6); CE(K,8,9); CE(K,11,10); CE(K,12,13); CE(K,15,14); CE(K,0,2); CE(K,1,3); CE(K,6,4); CE(K,7,5); CE(K,8,10); CE(K,9,11); CE(K,14,12); CE(K,15,13); CE(K,0,1); CE(K,2,3); CE(K,5,4); CE(K,7,6); CE(K,8,9); CE(K,10,11); CE(K,13,12); CE(K,15,14); CE(K,0,4); CE(K,1,5); CE(K,2,6); CE(K,3,7); CE(K,12,8); CE(K,13,9); CE(K,14,10); CE(K,15,11); CE(K,0,2); CE(K,1,3); CE(K,4,6); CE(K,5,7); CE(K,10,8); CE(K,11,9); CE(K,14,12); CE(K,15,13); CE(K,0,1); CE(K,2,3); CE(K,4,5); CE(K,6,7); CE(K,9,8); CE(K,11,10); CE(K,13,12); CE(K,15,14); CE(K,0,8); CE(K,1,9); CE(K,2,10); CE(K,3,11); CE(K,4,12); CE(K,5,13); CE(K,6,14); CE(K,7,15); CE(K,0,4); CE(K,1,5); CE(K,2,6); CE(K,3,7); CE(K,8,12); CE(K,9,13); CE(K,10,14); CE(K,11,15); CE(K,0,2); CE(K,1,3); CE(K,4,6); CE(K,5,7); CE(K,8,10); CE(K,9,11); CE(K,12,14); CE(K,13,15); CE(K,0,1); CE(K,2,3); CE(K,4,5); CE(K,6,7); CE(K,8,9); CE(K,10,11); CE(K,12,13); CE(K,14,15); } while (0)
#define BMERGE16(K) do { CE(K,0,8); CE(K,1,9); CE(K,2,10); CE(K,3,11); CE(K,4,12); CE(K,5,13); CE(K,6,14); CE(K,7,15); CE(K,0,4); CE(K,1,5); CE(K,2,6); CE(K,3,7); CE(K,8,12); CE(K,9,13); CE(K,10,14); CE(K,11,15); CE(K,0,2); CE(K,1,3); CE(K,4,6); CE(K,5,7); CE(K,8,10); CE(K,9,11); CE(K,12,14); CE(K,13,15); CE(K,0,1); CE(K,2,3); CE(K,4,5); CE(K,6,7); CE(K,8,9); CE(K,10,11); CE(K,12,13); CE(K,14,15); } while (0)
#define TOPMERGE16(A, B) do { _Pragma("unroll") for (int i_ = 0; i_ < 16; ++i_) A[i_] = fkmax(A[i_], B[15 - i_]); BMERGE16(A); } while (0)
template <int A, int B> struct PairIns {
    static __device__ __forceinline__ void run(const float (&s1)[16], const float (&s2)[16], unsigned (&K)[16]) {
        if constexpr ((A + 1) * (B + 1) <= 16) {
            unsigned x = (__builtin_bit_cast(unsigned, s1[A] + s2[B]) & ~255u) | (unsigned)((A << 4) | B);
#pragma unroll
            for (int i = (A + 1) * (B + 1) - 1; i < 16; ++i) { const unsigned a_ = K[i]; K[i] = fkmax(a_, x); x = fkmin(a_, x); }
            PairIns<A, B + 1>::run(s1, s2, K);
        } else if constexpr (B != 0) { PairIns<A + 1, 0>::run(s1, s2, K); }
    }
};
template <> struct PairIns<16, 0> { static __device__ __forceinline__ void run(const float (&)[16], const float (&)[16], unsigned (&)[16]) {} };

__device__ __forceinline__ float gelu_erf(float v) { return 0.5f * v * (1.0f + erff(v * 0.70710678118654752f)); }


typedef __bf16 bf16x2_t __attribute__((ext_vector_type(2)));
typedef float f32x2 __attribute__((ext_vector_type(2)));
constexpr int RSHIFT = 10, NR = NEXP >> RSHIFT;
constexpr int PL_BUF = 16384, PL_GATE = 8192, PL_WS = 32768, PL_WSB = 12288;

__device__ __forceinline__ float dot2u(unsigned x, unsigned w, float acc) {
    return __builtin_amdgcn_fdot2_f32_bf16(__builtin_bit_cast(bf16x2_t, x), __builtin_bit_cast(bf16x2_t, w), acc, false);
}
__device__ __forceinline__ float dot16_bf16(const unsigned (&x)[8], const v4u a, const v4u b) {
    float p = 0.f;
    p = dot2u(x[0], a.x, p); p = dot2u(x[1], a.y, p); p = dot2u(x[2], a.z, p); p = dot2u(x[3], a.w, p);
    p = dot2u(x[4], b.x, p); p = dot2u(x[5], b.y, p); p = dot2u(x[6], b.z, p); p = dot2u(x[7], b.w, p);
    return p;
}
__device__ __forceinline__ void rows_axpy2(float (&acc)[16], float& corr, float a0, float a1, const v4u w0, const v4u w1) {
    typedef _Float16 h2_ __attribute__((ext_vector_type(2)));
    const h2_ c = {(_Float16)__builtin_amdgcn_fmed3f(a0 * 4096.0f, -60000.0f, 60000.0f), (_Float16)__builtin_amdgcn_fmed3f(a1 * 4096.0f, -60000.0f, 60000.0f)};
    const h2_ one = {(_Float16)1.0f, (_Float16)1.0f};
    corr = __builtin_amdgcn_fdot2(c, one, corr, false);
    const unsigned x0[4] = {w0.x, w0.y, w0.z, w0.w}, x1[4] = {w1.x, w1.y, w1.z, w1.w};
#pragma unroll
    for (int j = 0; j < 4; ++j) {
        acc[4 * j + 0] = __builtin_amdgcn_fdot2(__builtin_bit_cast(h2_, __builtin_amdgcn_perm(x1[j], x0[j], 0x0c040c00u) | 0x64006400u), c, acc[4 * j + 0], false);
        acc[4 * j + 1] = __builtin_amdgcn_fdot2(__builtin_bit_cast(h2_, __builtin_amdgcn_perm(x1[j], x0[j], 0x0c050c01u) | 0x64006400u), c, acc[4 * j + 1], false);
        acc[4 * j + 2] = __builtin_amdgcn_fdot2(__builtin_bit_cast(h2_, __builtin_amdgcn_perm(x1[j], x0[j], 0x0c060c02u) | 0x64006400u), c, acc[4 * j + 2], false);
        acc[4 * j + 3] = __builtin_amdgcn_fdot2(__builtin_bit_cast(h2_, __builtin_amdgcn_perm(x1[j], x0[j], 0x0c070c03u) | 0x64006400u), c, acc[4 * j + 3], false); }
}
__device__ __forceinline__ void row_axpy1(f32x2 (&acc)[8], float a, const v4u w) {
    const unsigned ww[4] = {w.x, w.y, w.z, w.w};
#pragma unroll
    for (int j = 0; j < 4; ++j) { const f32x2 lo = {(float)(ww[j] & 0xffu), (float)((ww[j] >> 8) & 0xffu)}, hi = {(float)((ww[j] >> 16) & 0xffu), (float)(ww[j] >> 24)};
        acc[2 * j] = lo * a + acc[2 * j]; acc[2 * j + 1] = hi * a + acc[2 * j + 1]; }
}
typedef int i32x4 __attribute__((ext_vector_type(4)));

constexpr int GL_SHS = 0, GL_XQ = 2048, GL_CNT = 6144, GL_RM = 8192, GL_SA = 10240;
__device__ __forceinline__ void peer_gather_u(const Params& P, LAS unsigned char* lds, int tok0, int wave, int lane, int parity) {
    const LAS unsigned short* idxs = (const LAS unsigned short*)(lds + parity * PL_BUF); const LAS _Float16* gates = (const LAS _Float16*)(lds + parity * PL_BUF + PL_GATE);
    LAS unsigned char* wsb = lds + PL_WS + wave * PL_WSB;
    LAS int* srm = (LAS int*)(wsb + GL_RM); LAS float* shs = (LAS float*)(wsb + GL_SHS); LAS float* sa = (LAS float*)(wsb + GL_SA);
    LAS int* cnt = (LAS int*)(wsb + GL_CNT); LAS int* start = cnt + 64;
    const unsigned char* UQ = P.ws + WS_U; const f32x2* SUV = (const f32x2*)(P.ws + WS_SU);
    const bf16* X1B = (const bf16*)(P.ws + WS_X1B); const float* sumsq = (const float*)(P.ws + WS_SUMSQ);
    float sx[4];
#pragma unroll
    for (int tk = 0; tk < 4; ++tk) { const size_t t = (size_t)(tok0 + wave * 4 + tk); const float r2 = rsqrtf(sumsq[t] * (1.0f / DM) + EPS);
        const v4u xa = *(const v4u*)(X1B + t * DM + lane * 16), xb = *(const v4u*)(X1B + t * DM + lane * 16 + 8); f32x4 x[4]; float m = 0.f;
        x[0] = (f32x4){pg8::bflo(xa.x), pg8::bfhi(xa.x), pg8::bflo(xa.y), pg8::bfhi(xa.y)} * r2; x[1] = (f32x4){pg8::bflo(xa.z), pg8::bfhi(xa.z), pg8::bflo(xa.w), pg8::bfhi(xa.w)} * r2;
        x[2] = (f32x4){pg8::bflo(xb.x), pg8::bfhi(xb.x), pg8::bflo(xb.y), pg8::bfhi(xb.y)} * r2; x[3] = (f32x4){pg8::bflo(xb.z), pg8::bfhi(xb.z), pg8::bflo(xb.w), pg8::bfhi(xb.w)} * r2;
#pragma unroll
        for (int j = 0; j < 4; ++j) m = fmaxf(m, fmaxf(fmaxf(fabsf(x[j].x), fabsf(x[j].y)), fmaxf(fabsf(x[j].z), fabsf(x[j].w))));
#pragma unroll
        for (int o = 1; o < 64; o <<= 1) m = fmaxf(m, __shfl_xor(m, o));
        const float inv = m > 0.f ? 127.0f / m : 0.f; sx[tk] = m * (1.0f / 127.0f); unsigned w[4];
#pragma unroll
        for (int j = 0; j < 4; ++j) { const int q0 = __float2int_rn(x[j].x * inv), q1 = __float2int_rn(x[j].y * inv), q2 = __float2int_rn(x[j].z * inv), q3 = __float2int_rn(x[j].w * inv);
            w[j] = (unsigned)(q0 & 255) | ((unsigned)(q1 & 255) << 8) | ((unsigned)(q2 & 255) << 16) | ((unsigned)(q3 & 255) << 24); }
        v4u xw_; xw_.x = w[0]; xw_.y = w[1]; xw_.z = w[2]; xw_.w = w[3]; *(LAS v4u*)(wsb + GL_XQ + tk * 1024 + lane * 16) = xw_; }
    { int ee[8], sl[8]; float gg[8];
#pragma unroll
      for (int tk = 0; tk < 4; ++tk) { const int tl = wave * 4 + tk;
          ee[2 * tk] = idxs[tl * 128 + lane]; ee[2 * tk + 1] = idxs[tl * 128 + 64 + lane]; gg[2 * tk] = (float)gates[tl * 128 + lane]; gg[2 * tk + 1] = (float)gates[tl * 128 + 64 + lane]; }
      cnt[lane] = 0;
      LDS_WAIT(); asm volatile("" ::: "memory");
#pragma unroll
      for (int i = 0; i < 8; ++i) sl[i] = __hip_atomic_fetch_add(cnt + ((ee[i] >> RSHIFT) * 4 + (i >> 1)), 1, __ATOMIC_RELAXED, __HIP_MEMORY_SCOPE_WORKGROUP);
      LDS_WAIT(); asm volatile("" ::: "memory");
      { const int c = cnt[lane]; int inc = c;
#pragma unroll
        for (int o = 1; o < 64; o <<= 1) { const int t = __shfl_up(inc, o); if (lane >= o) inc += t; }
        start[lane] = inc - c; }
      LDS_WAIT(); asm volatile("" ::: "memory");
#pragma unroll
      for (int i = 0; i < 8; ++i) { const int pos = start[(ee[i] >> RSHIFT) * 4 + (i >> 1)] + sl[i]; const f32x2 sc2 = SUV[ee[i]]; srm[pos] = ee[i] | ((i >> 1) << 14); sa[pos] = gg[i] * sc2.y; shs[pos] = sc2.x * sx[i >> 1]; }
      LDS_WAIT(); asm volatile("" ::: "memory"); }
    {
        const int lu = fresh_lane(); const unsigned ulo = (unsigned)lu * 16u;
        const LAS unsigned char* xql = wsb + GL_XQ + lu * 16;
        const bool hh = (lu & 32) != 0, b4 = (lu & 16) != 0, b3 = (lu & 8) != 0;
        v4u rA[8], rB[8];
#define U_LOAD(R, pos_) do { const i32x4 e0_ = *(const LAS i32x4*)(srm + (pos_)) & 0x3fff, e1_ = *(const LAS i32x4*)(srm + (pos_) + 4) & 0x3fff; \
        R[0] = *(const v4u*)(UQ + (((unsigned)e0_[0] << 10) + ulo)); R[1] = *(const v4u*)(UQ + (((unsigned)e0_[1] << 10) + ulo)); R[2] = *(const v4u*)(UQ + (((unsigned)e0_[2] << 10) + ulo)); R[3] = *(const v4u*)(UQ + (((unsigned)e0_[3] << 10) + ulo)); \
        R[4] = *(const v4u*)(UQ + (((unsigned)e1_[0] << 10) + ulo)); R[5] = *(const v4u*)(UQ + (((unsigned)e1_[1] << 10) + ulo)); R[6] = *(const v4u*)(UQ + (((unsigned)e1_[2] << 10) + ulo)); R[7] = *(const v4u*)(UQ + (((unsigned)e1_[3] << 10) + ulo)); } while (0)
#define U_DOT1(R, k_, ev_) do { const v4u xs_ = *(const LAS v4u*)(xql + (((ev_) >> 4) & 0xc00)); \
        const int p0_ = __builtin_amdgcn_sdot4((int)R[k_].x, (int)xs_.x, 0, false), p1_ = __builtin_amdgcn_sdot4((int)R[k_].y, (int)xs_.y, 0, false); \
        pd_[k_] = __builtin_amdgcn_sdot4((int)R[k_].z, (int)xs_.z, p0_, false) + __builtin_amdgcn_sdot4((int)R[k_].w, (int)xs_.w, p1_, false); } while (0)
#define U_COMP(R, pos_) do { int pd_[8]; \
        { const i32x4 t0v_ = *(const LAS i32x4*)(srm + (pos_)), t1v_ = *(const LAS i32x4*)(srm + (pos_) + 4); \
          U_DOT1(R, 0, t0v_[0]); U_DOT1(R, 1, t0v_[1]); U_DOT1(R, 2, t0v_[2]); U_DOT1(R, 3, t0v_[3]); U_DOT1(R, 4, t1v_[0]); U_DOT1(R, 5, t1v_[1]); U_DOT1(R, 6, t1v_[2]); U_DOT1(R, 7, t1v_[3]); } \
        typedef unsigned u2s_ __attribute__((ext_vector_type(2))); \
        const u2s_ w0_ = __builtin_amdgcn_permlane32_swap((unsigned)pd_[0], (unsigned)pd_[4], false, false), w1_ = __builtin_amdgcn_permlane32_swap((unsigned)pd_[1], (unsigned)pd_[5], false, false); \
        const u2s_ w2_ = __builtin_amdgcn_permlane32_swap((unsigned)pd_[2], (unsigned)pd_[6], false, false), w3_ = __builtin_amdgcn_permlane32_swap((unsigned)pd_[3], (unsigned)pd_[7], false, false); \
        const int k0_ = (int)(w0_.x + w0_.y), k1_ = (int)(w1_.x + w1_.y), k2_ = (int)(w2_.x + w2_.y), k3_ = (int)(w3_.x + w3_.y);     \
        const u2s_ y0_ = __builtin_amdgcn_permlane16_swap((unsigned)k0_, (unsigned)k2_, false, false), y1_ = __builtin_amdgcn_permlane16_swap((unsigned)k1_, (unsigned)k3_, false, false); \
        const int m0_ = (int)(y0_.x + y0_.y), m1_ = (int)(y1_.x + y1_.y);                  \
        int kk_ = b3 ? m1_ : m0_; const int tt_ = b3 ? m0_ : m1_; \
        kk_ += __builtin_amdgcn_update_dpp(0, tt_, 0x128, 0xf, 0xf, false);            \
        kk_ += __builtin_amdgcn_update_dpp(0, kk_, 0x141, 0xf, 0xf, false);            \
        kk_ += __builtin_amdgcn_update_dpp(0, kk_, 0xB1, 0xf, 0xf, false);             \
        kk_ += __builtin_amdgcn_update_dpp(0, kk_, 0x4E, 0xf, 0xf, false);             \
        if ((lu & 7) == 0) { const int p_ = (pos_) + (lu >> 3); const float hid_ = (float)kk_ * shs[p_]; sa[p_] = gelu_erf(hid_) * sa[p_]; } } while (0)
        U_LOAD(rA, 0);
#pragma unroll 1
        for (int m = 0; m < 64; m += 2) {
            U_LOAD(rB, 8 * m + 8);  U_COMP(rA, 8 * m);
            U_LOAD(rA, (m + 2 < 64 ? 8 * m + 16 : 0));  U_COMP(rB, 8 * m + 8);
        }
#undef U_LOAD
#undef U_DOT1
#undef U_COMP
    }
    LDS_WAIT(); asm volatile("" ::: "memory");
}
__device__ __forceinline__ void peer_gather_v(const Params& P, LAS unsigned char* lds, int tok0, int wave) {
    typedef int i32x4_ __attribute__((ext_vector_type(4)));
    LAS unsigned char* wsb = lds + PL_WS + wave * PL_WSB;
    LAS int* srm = (LAS int*)(wsb + GL_RM); LAS float* sa = (LAS float*)(wsb + GL_SA);
    const unsigned char* VQ = P.ws + WS_V; const bf16* X1B = (const bf16*)(P.ws + WS_X1B);
    const int lv = fresh_lane(); const unsigned vlo = (unsigned)lv * 16u;
    float amax[4] = {0.f, 0.f, 0.f, 0.f};
#pragma unroll
    for (int i = 0; i < 8; ++i) { const int p = lv + 64 * i; const float av = fabsf(sa[p]); const int tk = (srm[p] >> 14) & 3;
        amax[0] = fmaxf(amax[0], tk == 0 ? av : 0.f); amax[1] = fmaxf(amax[1], tk == 1 ? av : 0.f); amax[2] = fmaxf(amax[2], tk == 2 ? av : 0.f); amax[3] = fmaxf(amax[3], tk == 3 ? av : 0.f); }
#pragma unroll
    for (int o = 1; o < 64; o <<= 1) { amax[0] = fmaxf(amax[0], __shfl_xor(amax[0], o)); amax[1] = fmaxf(amax[1], __shfl_xor(amax[1], o)); amax[2] = fmaxf(amax[2], __shfl_xor(amax[2], o)); amax[3] = fmaxf(amax[3], __shfl_xor(amax[3], o)); }
    { float inv[4];
#pragma unroll
      for (int t = 0; t < 4; ++t) inv[t] = amax[t] > 0.f ? 127.0f / amax[t] : 0.f;
#pragma unroll
      for (int i = 0; i < 8; ++i) { const int p = lv + 64 * i; const int tk = (srm[p] >> 14) & 3; const float iv = tk == 0 ? inv[0] : tk == 1 ? inv[1] : tk == 2 ? inv[2] : inv[3];
          const int q = __float2int_rn(sa[p] * iv); ((LAS int*)sa)[p] = (q & 255) | (tk << 8); } }
    LDS_WAIT(); asm volatile("" ::: "memory");
    i32x4_ acc[16];
#pragma unroll
    for (int j = 0; j < 16; ++j) acc[j] = (i32x4_){0, 0, 0, 0};
    {
        const int li = lv & 3;
        v4u rA[8], rB[8], rC[8];
#define V_LOAD(R, pos_) do { const i32x4 e0_ = *(const LAS i32x4*)(srm + (pos_)) & 0x3fff, e1_ = *(const LAS i32x4*)(srm + (pos_) + 4) & 0x3fff; \
        R[0] = *(const v4u*)(VQ + (((unsigned)e0_[0] << 10) + vlo)); R[1] = *(const v4u*)(VQ + (((unsigned)e0_[1] << 10) + vlo)); R[2] = *(const v4u*)(VQ + (((unsigned)e0_[2] << 10) + vlo)); R[3] = *(const v4u*)(VQ + (((unsigned)e0_[3] << 10) + vlo)); \
        R[4] = *(const v4u*)(VQ + (((unsigned)e1_[0] << 10) + vlo)); R[5] = *(const v4u*)(VQ + (((unsigned)e1_[1] << 10) + vlo)); R[6] = *(const v4u*)(VQ + (((unsigned)e1_[2] << 10) + vlo)); R[7] = *(const v4u*)(VQ + (((unsigned)e1_[3] << 10) + vlo)); } while (0)
#define V_QUAD(r0_, r1_, r2_, r3_, aop_, j_) do { \
        const unsigned l01_ = __builtin_amdgcn_perm(r1_, r0_, 0x05010400u), h01_ = __builtin_amdgcn_perm(r1_, r0_, 0x07030602u); \
        const unsigned l23_ = __builtin_amdgcn_perm(r3_, r2_, 0x05010400u), h23_ = __builtin_amdgcn_perm(r3_, r2_, 0x07030602u); \
        acc[4 * (j_) + 0] = __builtin_amdgcn_mfma_i32_4x4x4i8((int)(aop_), (int)__builtin_amdgcn_perm(l23_, l01_, 0x05040100u), acc[4 * (j_) + 0], 0, 0, 0); \
        acc[4 * (j_) + 1] = __builtin_amdgcn_mfma_i32_4x4x4i8((int)(aop_), (int)__builtin_amdgcn_perm(l23_, l01_, 0x07060302u), acc[4 * (j_) + 1], 0, 0, 0); \
        acc[4 * (j_) + 2] = __builtin_amdgcn_mfma_i32_4x4x4i8((int)(aop_), (int)__builtin_amdgcn_perm(h23_, h01_, 0x05040100u), acc[4 * (j_) + 2], 0, 0, 0); \
        acc[4 * (j_) + 3] = __builtin_amdgcn_mfma_i32_4x4x4i8((int)(aop_), (int)__builtin_amdgcn_perm(h23_, h01_, 0x07060302u), acc[4 * (j_) + 3], 0, 0, 0); } while (0)
#define V_AOP(c0_, c1_, c2_, c3_) (((((c0_) >> 8) == li) ? ((unsigned)(c0_) & 255u) : 0u) | ((((c1_) >> 8) == li) ? (((unsigned)(c1_) & 255u) << 8) : 0u) | ((((c2_) >> 8) == li) ? (((unsigned)(c2_) & 255u) << 16) : 0u) | ((((c3_) >> 8) == li) ? (((unsigned)(c3_) & 255u) << 24) : 0u))
#define V_COMP(R, pos_) do { const i32x4 c0_ = *(const LAS i32x4*)((const LAS int*)sa + (pos_)), c1_ = *(const LAS i32x4*)((const LAS int*)sa + (pos_) + 4); \
        const unsigned a0_ = V_AOP(c0_[0], c0_[1], c0_[2], c0_[3]), a1_ = V_AOP(c1_[0], c1_[1], c1_[2], c1_[3]); \
        V_QUAD(R[0].x, R[1].x, R[2].x, R[3].x, a0_, 0); V_QUAD(R[0].y, R[1].y, R[2].y, R[3].y, a0_, 1); V_QUAD(R[0].z, R[1].z, R[2].z, R[3].z, a0_, 2); V_QUAD(R[0].w, R[1].w, R[2].w, R[3].w, a0_, 3); \
        V_QUAD(R[4].x, R[5].x, R[6].x, R[7].x, a1_, 0); V_QUAD(R[4].y, R[5].y, R[6].y, R[7].y, a1_, 1); V_QUAD(R[4].z, R[5].z, R[6].z, R[7].z, a1_, 2); V_QUAD(R[4].w, R[5].w, R[6].w, R[7].w, a1_, 3); } while (0)
        V_LOAD(rA, 0); V_LOAD(rB, 8);
#pragma unroll 1
        for (int m = 0; m < 63; m += 3) {
            V_LOAD(rC, 8 * m + 16);  V_COMP(rA, 8 * m);
            V_LOAD(rA, 8 * m + 24);  V_COMP(rB, 8 * m + 8);
            V_LOAD(rB, (m + 4 < 64 ? 8 * m + 32 : 0));  V_COMP(rC, 8 * m + 16);
        }
        V_COMP(rA, 8 * 63);
#undef V_LOAD
#undef V_QUAD
#undef V_AOP
#undef V_COMP
    }
    const int le = fresh_lane();
#pragma unroll
    for (int tk = 0; tk < 4; ++tk) { const size_t t = (size_t)(tok0 + wave * 4 + tk); const float sc = amax[tk] * (1.0f / 127.0f);
        const v4u xa = *(const v4u*)(X1B + t * DM + le * 16), xb = *(const v4u*)(X1B + t * DM + le * 16 + 8); float* orow = P.out + t * DM + le * 16;
        const unsigned xw[8] = {xa.x, xa.y, xa.z, xa.w, xb.x, xb.y, xb.z, xb.w};
#pragma unroll
        for (int j = 0; j < 4; ++j) *(f32x4*)(orow + 4 * j) = (f32x4){pg8::bflo(xw[2 * j]) + sc * (float)acc[4 * j][tk], pg8::bfhi(xw[2 * j]) + sc * (float)acc[4 * j + 1][tk], pg8::bflo(xw[2 * j + 1]) + sc * (float)acc[4 * j + 2][tk], pg8::bfhi(xw[2 * j + 1]) + sc * (float)acc[4 * j + 3][tk]}; }
}

__device__ __forceinline__ void topk_part(const Params& P, LAS unsigned char* lds, int item, int wave, int parity) {
    const int lane = fresh_lane();
    const int tok0 = item * 32, hh = lane >> 5, l31 = lane & 31;
    LAS unsigned short* idxs = (LAS unsigned short*)(lds + parity * PL_BUF);
    LAS _Float16* gates = (LAS _Float16*)(lds + parity * PL_BUF + PL_GATE);
    const bf16* Q = (const bf16*)(P.ws + WS_Q); const bf16* SK = (const bf16*)(P.ws + WS_SK);
    unsigned L0[16], L1[16];
#pragma unroll
    for (int p = 0; p < 2; ++p) {
        f32x16 acc[4];
        { LAS unsigned char* tb = lds + PL_WS + wave * PL_WSB;
          const int r8 = lane >> 3, ch = lane & 7;
          v4u tq[4], t0[4], t1[4];
#pragma unroll
          for (int c = 0; c < 4; ++c) tq[c] = *(const v4u*)(Q + (size_t)(tok0 + r8 + 8 * c) * DM + wave * 128 + p * 64 + 8 * ch);
          const bf16* skp = SK + (size_t)((wave * 2 + p) * 128 + r8) * 64 + 8 * ch;
#pragma unroll
          for (int c = 0; c < 4; ++c) t0[c] = *(const v4u*)(skp + (size_t)(8 * c) * 64);
#pragma unroll
          for (int c = 0; c < 4; ++c) *(LAS v4u*)(tb + (r8 + 8 * c) * 144 + 16 * ch) = tq[c];
          bf16x8 bq[4];
#pragma unroll
          for (int ks = 0; ks < 4; ++ks) bq[ks] = *(const LAS bf16x8*)(tb + l31 * 144 + 32 * ks + 16 * hh);
#define TK_TILE(TC, TN, nt_) do { \
          _Pragma("unroll") for (int c = 0; c < 4; ++c) *(LAS v4u*)(tb + (r8 + 8 * c) * 144 + 16 * ch) = TC[c]; \
          if ((nt_) + 1 < 4) { _Pragma("unroll") for (int c = 0; c < 4; ++c) TN[c] = *(const v4u*)(skp + (size_t)(32 * ((nt_) + 1) + 8 * c) * 64); } \
          acc[nt_] = f32x16{}; \
          _Pragma("unroll") for (int ks = 0; ks < 4; ++ks) acc[nt_] = __builtin_amdgcn_mfma_f32_32x32x16_bf16(*(const LAS bf16x8*)(tb + l31 * 144 + 32 * ks + 16 * hh), bq[ks], acc[nt_], 0, 0, 0); } while (0)
          TK_TILE(t0, t1, 0); TK_TILE(t1, t0, 1); TK_TILE(t0, t1, 2); TK_TILE(t1, t0, 3);
#undef TK_TILE
        }
        unsigned G0[16], G1[16], G2[16], G3[16];
#pragma unroll
        for (int r = 0; r < 16; ++r) { const unsigned n = (unsigned)((r & 3) + 8 * (r >> 2)) + 4u * (unsigned)hh;
            const float a0_ = acc[0][r], a1_ = acc[1][r], a2_ = acc[2][r], a3_ = acc[3][r];
            G0[r] = (__builtin_bit_cast(unsigned, a0_) & ~127u) | n; G1[r] = (__builtin_bit_cast(unsigned, a1_) & ~127u) | (n + 32u); G2[r] = (__builtin_bit_cast(unsigned, a2_) & ~127u) | (n + 64u); G3[r] = (__builtin_bit_cast(unsigned, a3_) & ~127u) | (n + 96u); }
        BSORT16(G0); BSORT16(G1); BSORT16(G2); BSORT16(G3);
        TOPMERGE16(G0, G1); TOPMERGE16(G2, G3); TOPMERGE16(G0, G2);
#pragma unroll
        for (int i = 0; i < 16; ++i) { if (p == 0) L0[i] = G0[i]; else L1[i] = G0[i]; }
        __builtin_amdgcn_sched_barrier(0);
    }
    {
        unsigned O0[16], O1[16];
#pragma unroll
        for (int i = 0; i < 16; ++i) { O0[i] = (unsigned)__shfl_xor((int)L0[i], 32); O1[i] = (unsigned)__shfl_xor((int)L1[i], 32); }
        TOPMERGE16(L0, O0); TOPMERGE16(L1, O1);
    }
    {
        float s1[16], s2[16]; unsigned K[16];
        LAS int* tab = (LAS int*)(lds + PL_WS + wave * PL_WSB);
#pragma unroll
        for (int i = 0; i < 16; ++i) { s1[i] = __builtin_bit_cast(float, L0[i] & ~127u); s2[i] = __builtin_bit_cast(float, L1[i] & ~127u); tab[i * 64 + lane] = (int)(L0[i] & 127u); tab[1024 + i * 64 + lane] = (int)(L1[i] & 127u); K[i] = 0xff800000u; }
        PairIns<0, 0>::run(s1, s2, K);
        float e[16], sum = 0.f; const float v0 = __builtin_bit_cast(float, K[0] & ~255u);
#pragma unroll
        for (int i = 0; i < 16; ++i) { e[i] = __expf(__builtin_bit_cast(float, K[i] & ~255u) - v0); sum += e[i]; }
        const float rs = 1.0f / sum;
        LDS_WAIT();
        if (hh == 0) {
#pragma unroll
            for (int i = 0; i < 16; ++i) { const int a_ = (int)((K[i] >> 4) & 15u), b_ = (int)(K[i] & 15u);
                idxs[l31 * 128 + wave * 16 + i] = (unsigned short)(tab[a_ * 64 + lane] * 128 + tab[1024 + b_ * 64 + lane]); gates[l31 * 128 + wave * 16 + i] = (_Float16)(e[i] * rs); }
        }
    }
}

constexpr int NPHASE = 8;
__global__ void __launch_bounds__(NWAVES * 64, 2) mk_fwd(Params P) {
    extern __shared__ __attribute__((aligned(16))) unsigned char lds_raw[];
    LAS unsigned char* lds = (LAS unsigned char*)lds_raw;
    const int wave = __builtin_amdgcn_readfirstlane((int)threadIdx.x >> 6);
    const int G = gridDim.x;
    unsigned char* ws = P.ws;
#if MK_FUSED
    { const int l0 = fresh_lane(); for (int u = wave * 64 + l0; u < (LDS_BYTES - LDS_CTL) / 4; u += NWAVES * 64) ((LAS unsigned*)(lds + LDS_CTL))[u] = 0u; }
    __syncthreads();
    const XcdBarrier xbar = xcd_barrier_post((unsigned*)(ws + WS_CTL) + 4096, (volatile LAS unsigned*)(lds + LDS_CTL + 320) + 8, wave * 64 + fresh_lane());
#define SEAM0() cg::this_grid().sync()
#define SEAM() xcd_barrier(xbar, wave * 64 + fresh_lane())
#else
#define SEAM0() do {} while (0)
#define SEAM() do {} while (0)
#endif
#ifndef PHASE_MASK
#define PHASE_MASK 0xff
#endif
#define IN(k) (((PHASE_MASK >> (k)) & 1) && P.ph_lo <= (k) && (k) < P.ph_hi)
    bf16* XN = (bf16*)((unsigned char*)P.out + OUT_XN); bf16* MERGED = (bf16*)((unsigned char*)P.out + OUT_MERGED);
    bf16* YA = (bf16*)((unsigned char*)P.out + OUT_YA); bf16* YB = (bf16*)((unsigned char*)P.out + OUT_YB);
    bf16* PROJ = (bf16*)(ws + WS_PROJ);
    float* sumsq = (float*)(ws + WS_SUMSQ);

    if (IN(0)) {
        unsigned* sb = (unsigned*)(ws + WS_CTL) + 12000;
        p0_prologue_a(P, lds, wave, fresh_lane(), 0);
#if MK_FUSED
        asm volatile("s_waitcnt vmcnt(0)" ::: "memory"); __syncthreads();
        if (wave == 0 && fresh_lane() == 0) { __builtin_amdgcn_fence(__ATOMIC_RELEASE, "agent"); asm volatile("s_waitcnt vmcnt(0)" ::: "memory"); (void)__hip_atomic_fetch_add(sb, 1u, __ATOMIC_RELAXED, __HIP_MEMORY_SCOPE_AGENT); }
#endif
        p0_prologue_a(P, lds, wave, fresh_lane(), 1);
#if MK_FUSED
        if (wave == 0 && fresh_lane() == 0) { unsigned sp = 0; while (__hip_atomic_load(sb, __ATOMIC_RELAXED, __HIP_MEMORY_SCOPE_AGENT) < (unsigned)G) { __builtin_amdgcn_s_sleep(2); if (++sp > (1u << 22)) break; }
            __builtin_amdgcn_fence(__ATOMIC_ACQUIRE, "agent"); asm volatile("s_waitcnt vmcnt(0)" ::: "memory"); }
        __syncthreads();
#endif
        p0_prologue_b(P, lds, wave, fresh_lane()); SEAM0(); }
    if (IN(1)) {
        pg8::Gemm g{XN, (const bf16*)(ws + WS_WIN), MTOK, NIN, DM / 2};
        pg8::StaticOrder S; S.init(MTOK, NIN, G, (int)blockIdx.x);
        pg8::EpiProj E{PROJ, P.hg_lb, P.q_norm_g, P.k_norm_g, (const float*)(ws + WS_SXN), (const float*)(ws + WS_SW), (bf16*)((unsigned char*)P.out + OUT_KI)};
        pg8::gemm_phase<pg8::EpiProj, pg8::StaticOrder, true, true, true>(lds, g, S, E, wave);
        { const int nunits = (MTOK / 256) * (NIN / 256), rem = nunits % G;
          const int lq = fresh_lane();
          if (rem == 0) quant_tables(P, (int)blockIdx.x, G, wave, lq); else if ((int)blockIdx.x >= rem) quant_tables(P, (int)blockIdx.x - rem, G - rem, wave, lq); }
        SEAM();
    }
    if (IN(2)) {
        const int lane2 = fresh_lane();
        const int nh = (G >= 128) ? 64 : 0;
        if (nh) { if ((int)blockIdx.x < nh) hgrn_chunked_item(P, lds, (int)blockIdx.x, wave, lane2); }
        else { for (int it = (int)blockIdx.x; it < BATCH * 4; it += G) hgrn_chunked_item(P, lds, it, wave, lane2); }
        {
            float mq = fabsf(P.q_norm_g[lane2]), mk = fabsf(P.k_norm_g[lane2]);
#pragma unroll
            for (int o = 1; o < 64; o <<= 1) { mq = fmaxf(mq, __shfl_xor(mq, o)); mk = fmaxf(mk, __shfl_xor(mk, o)); }
            const float Mfix = 8.0f * 1.4426950408889634f * 1.02f * mq * mk;
            unsigned* ctr = (unsigned*)(ws + WS_CTL) + 8192;
            for (;;) { if (wave == 0 && lane2 == 0) *(volatile LAS unsigned*)(lds + AT_TSK) = __hip_atomic_fetch_add(ctr, 1u, __ATOMIC_RELAXED, __HIP_MEMORY_SCOPE_AGENT);
                __syncthreads();
                const int task = __builtin_amdgcn_readfirstlane((int)*(volatile LAS unsigned*)(lds + AT_TSK)); if (task >= BATCH * 4 * 4) break;
                attn_wg_task(P, lds, task, wave, lane2, Mfix); }
        }
        SEAM();
    }
    if (IN(3)) {
        { pg8::Gemm g{YA, (const bf16*)(ws + WS_WA), MTOK, DM, 512}; pg8::StaticOrder S; S.init(MTOK, DM, G, (int)blockIdx.x);
          pg8::EpiGate<0> E{MERGED, PROJ + 4352};
          pg8::gemm_phase<pg8::EpiGate<0>, pg8::StaticOrder, true, true>(lds, g, S, E, wave); }
        VM_WAIT(); __syncthreads();
        { pg8::Gemm g{YB, (const bf16*)(ws + WS_WB), MTOK, DM, 256}; pg8::StaticOrder S; S.init(MTOK, DM, G, (int)blockIdx.x);
          pg8::EpiGate<1> E{MERGED, PROJ + 5376};
          pg8::gemm_phase<pg8::EpiGate<1>, pg8::StaticOrder, true, true>(lds, g, S, E, wave); }
        SEAM();
    }
    if (IN(4)) {
        pg8::Gemm g{MERGED, (const bf16*)(ws + WS_WOUT), MTOK, DM, DM}; pg8::StaticOrder S; S.init(MTOK, DM, G, (int)blockIdx.x);
        pg8::EpiResid E{P.x, (bf16*)(ws + WS_X1B), sumsq};
        pg8::gemm_phase<pg8::EpiResid, pg8::StaticOrder, true, true>(lds, g, S, E, wave);
        SEAM();
    }
    if (IN(5)) {
        pg8::Gemm g{(const bf16*)(ws + WS_X1B), (const bf16*)(ws + WS_WQ), MTOK, DM, DM}; pg8::StaticOrder S; S.init(MTOK, DM, G, (int)blockIdx.x);
        pg8::EpiRowScale E{(bf16*)(ws + WS_Q), sumsq};
        pg8::gemm_phase<pg8::EpiRowScale, pg8::StaticOrder, true, true>(lds, g, S, E, wave);
        SEAM();
    }
    if (IN(6)) {
        const int nit = (MTOK / 32 - (int)blockIdx.x + G - 1) / G;
        if (nit > 0) topk_part(P, lds, (int)blockIdx.x, wave, 0);
        __syncthreads();
#pragma unroll 1
        for (int k = 0; k < nit; ++k) {
            const int item = (int)blockIdx.x + k * G;
            peer_gather_u(P, lds, item * 32, wave, fresh_lane(), k & 1);
            if (wave < 4) { __builtin_amdgcn_s_setprio(2); peer_gather_v(P, lds, item * 32, wave); __builtin_amdgcn_s_setprio(0); if (k + 1 < nit) topk_part(P, lds, item + G, wave, (k + 1) & 1); }
            else { if (k + 1 < nit) topk_part(P, lds, item + G, wave, (k + 1) & 1); __builtin_amdgcn_s_setprio(2); peer_gather_v(P, lds, item * 32, wave); __builtin_amdgcn_s_setprio(0); }
            __syncthreads();
        }
    }
#undef IN
#undef SEAM
#undef SEAM0
}

extern "C" void kernel_launch(void* const* d_in, const int* in_sizes, int n_in, void* d_out, int out_size, void* d_ws, size_t ws_size, hipStream_t stream) {
    static int grid = 0;
    if (grid == 0) {
        if (n_in != 15 || in_sizes[0] != MTOK * DM || out_size != MTOK * DM || ws_size < WS_END) {
            fprintf(stderr, "kernel_launch: unexpected shapes (n_in %d, in0 %d, out %d, ws %zu); nothing launched\n", n_in, n_in > 0 ? in_sizes[0] : -1, out_size, ws_size); grid = -1; return; }
        int dev = 0, cus = 0, per_cu = 0;
        if (hipGetDevice(&dev) != hipSuccess || hipDeviceGetAttribute(&cus, hipDeviceAttributeMultiprocessorCount, dev) != hipSuccess) { fprintf(stderr, "kernel_launch: device query failed\n"); grid = -1; return; }
        if (hipFuncSetAttribute((const void*)mk_fwd, hipFuncAttributeMaxDynamicSharedMemorySize, LDS_BYTES) != hipSuccess) { fprintf(stderr, "kernel_launch: hipFuncSetAttribute failed\n"); grid = -1; return; }
        if (hipOccupancyMaxActiveBlocksPerMultiprocessor(&per_cu, (const void*)mk_fwd, NWAVES * 64, LDS_BYTES) != hipSuccess || per_cu < 1) { fprintf(stderr, "kernel_launch: occupancy query says %d blocks per CU\n", per_cu); per_cu = 1; }
        (void)hipGetLastError();
        grid = cus;
        fprintf(stderr, "kernel_launch: %d CUs, occupancy query %d per CU, grid %d\n", cus, per_cu, grid);
    }
    if (grid < 0) return;
    (void)hipMemsetAsync((char*)d_ws + WS_CTL, 0, CTL_ZERO_BYTES, stream);
    Params p{};
    p.x = (const float*)d_in[0]; p.norm1_g = (const float*)d_in[1]; p.w_in = (const float*)d_in[2]; p.hg_norm_g = (const float*)d_in[3]; p.hg_lb = (const float*)d_in[4];
    p.q_norm_g = (const float*)d_in[5]; p.k_norm_g = (const float*)d_in[6]; p.w_a = (const float*)d_in[7]; p.w_b = (const float*)d_in[8]; p.w_out = (const float*)d_in[9];
    p.norm2_g = (const float*)d_in[10]; p.peer_wq = (const float*)d_in[11]; p.peer_sk = (const float*)d_in[12]; p.peer_u = (const float*)d_in[13]; p.peer_v = (const float*)d_in[14];
    p.out = (float*)d_out; p.ws = (unsigned char*)d_ws;
#if MK_FUSED
    p.ph_lo = 0; p.ph_hi = NPHASE;
    void* args[] = {&p};
    hipError_t e = hipLaunchCooperativeKernel((const void*)mk_fwd, dim3(grid), dim3(NWAVES * 64), args, LDS_BYTES, stream);
    if (e != hipSuccess) fprintf(stderr, "kernel_launch: cooperative launch failed: %s (grid %d)\n", hipGetErrorString(e), grid);
#else
    for (int ph = 0; ph < 7; ++ph) { p.ph_lo = ph; p.ph_hi = ph + 1; hipLaunchKernelGGL(mk_fwd, dim3(grid), dim3(NWAVES * 64), LDS_BYTES, stream, p); }
#endif
}
```

```cpp
#include <hip/hip_runtime.h>
#include <hip/hip_cooperative_groups.h>
#include <cstdio>
#include <cstdint>
#include <cmath>
namespace cg = cooperative_groups;
#ifndef MK_FUSED
#define MK_FUSED 1
#endif
namespace pg8 {
#define PG8_LAS __attribute__((address_space(3)))
typedef unsigned short bf16_t;
typedef short bf16x8 __attribute__((ext_vector_type(8)));
typedef float f32x4 __attribute__((ext_vector_type(4)));
typedef unsigned u32x4 __attribute__((ext_vector_type(4)));
constexpr int BM = 256, BK = 64, HALF = 128, HTB = HALF * BK * 2  , STAGE_BYTES = 8 * HTB, NXCD = 8, WGM = 8;

__host__ __device__ __forceinline__ int lds_byte(int r, int c) { const int st = (r >> 4) * 2 + (c >> 5), rr = r & 15, cc = c & 31, ob = rr * 64 + cc * 2; return st * 1024 + (ob ^ (((ob >> 9) & 1) << 5)); }
__host__ __device__ __forceinline__ void stage_rc(int b, int& R, int& C) { const int st = b / 1024, sb = b % 1024, swz = sb ^ (((sb >> 9) & 1) << 5); R = (st >> 1) * 16 + swz / 64; C = (st & 1) * 32 + (swz % 64) / 2; }
__host__ __device__ __forceinline__ int perm32(int rho) { const int n = rho >> 4, i = rho & 15; return 8 * (i >> 2) + 4 * n + (i & 3); }

struct Unit { int pm, pn; };
struct Gemm { const bf16_t* A; const bf16_t* Bt; int M, N, K; };

struct StaticOrder {
    int nM, nN, nwg, G, c;
    __host__ __device__ void init(int M, int N, int G_, int c_) { nM = M / BM; nN = N / BM; nwg = nM * nN; G = G_; c = c_; }
    __host__ __device__ bool next(int i, Unit& u) const {
        const long L = (long)i * G + c; if (L >= nwg) return false;
        int wgid = (int)L; { const int q = nwg / NXCD, r = nwg % NXCD, xcd = wgid % NXCD, off = wgid / NXCD; wgid = (xcd < r ? xcd * (q + 1) : r * (q + 1) + (xcd - r) * q) + off; }
        const int nig = WGM * nN, gid = wgid / nig, fm = gid * WGM, gsz = (nM - fm) < WGM ? (nM - fm) : WGM;
        u.pm = fm + ((wgid % nig) % gsz); u.pn = (wgid % nig) / gsz; return true;
    }
    __device__ __forceinline__ void a_ready(const Unit&) const {}
    __device__ __forceinline__ void done(const Unit&) const {}
};

__device__ __forceinline__ unsigned cvt_pk_bf16(float lo, float hi) { unsigned r; asm volatile("v_cvt_pk_bf16_f32 %0, %1, %2" : "=v"(r) : "v"(lo), "v"(hi)); return r; }
__device__ __forceinline__ void st_wt(void* p, u32x4 v) { asm volatile("global_store_dwordx4 %0, %1, off sc1\n\ts_nop 1" :: "v"(p), "v"(v) : "memory"); }
typedef float f32x2 __attribute__((ext_vector_type(2)));
__device__ __forceinline__ f32x2 gelu_pk(f32x2 v) {
    const f32x2 av = __builtin_elementwise_abs(v), d = av * 0.2316418882f + 1.0f;
    f32x2 t; t.x = __builtin_amdgcn_rcpf(d.x); t.y = __builtin_amdgcn_rcpf(d.y);
    f32x2 q = t * 0.5307027145f + (-0.7265760135f); q = q * t + 0.7107068705f; q = q * t + (-0.142248368f); q = q * t + 0.127414796f; q = q * t;
    const f32x2 s = (v * v) * (-0.72134752044f);
    f32x2 e; e.x = __builtin_amdgcn_exp2f(s.x); e.y = __builtin_amdgcn_exp2f(s.y);
    const f32x2 m = v * (q * e), r = v - m;
    f32x2 o; o.x = v.x < 0.f ? m.x : r.x; o.y = v.y < 0.f ? m.y : r.y; return o;
}

template <int ACT  > struct EpiBf16 {
    static constexpr bool PERM = true, AFTER_DRAIN = false; static_assert(ACT == 0 || ACT == 1, "EpiBf16: ACT is 0 (none) or 1 (gelu_pk)");
    bf16_t* O; int ldc; const float* bias; int split_cols; size_t split_stride; float scale0;
    __device__ __forceinline__ void operator()(const f32x4 (&acc)[2][2][4][2], const Unit& u, int wr, int wc, int fr, int fq) const {
        const int row0 = u.pm * BM + wr * 64 + fr; int colt = u.pn * BM; bf16_t* base = O;
        float sc = 1.f; if (split_cols) { const int t = colt / split_cols; base += (size_t)t * split_stride; colt -= t * split_cols; if (t == 0) sc = scale0; }
        const int col0 = colt + wc * 32 + 8 * fq, bcol0 = u.pn * BM + wc * 32 + 8 * fq;
        f32x4 bv[2][2];
#pragma unroll
        for (int bj = 0; bj < 2; ++bj)
#pragma unroll
            for (int n = 0; n < 2; ++n) bv[bj][n] = bias ? *(const f32x4*)(bias + bcol0 + bj * HALF + 4 * n) : (f32x4){0.f, 0.f, 0.f, 0.f};
#pragma unroll
        for (int ai = 0; ai < 2; ++ai)
#pragma unroll
            for (int m = 0; m < 4; ++m) { bf16_t* rowp = base + (size_t)(row0 + ai * HALF + m * 16) * ldc + col0;
#pragma unroll
                for (int bj = 0; bj < 2; ++bj) { f32x4 v0 = acc[ai][bj][m][0] + bv[bj][0], v1 = acc[ai][bj][m][1] + bv[bj][1];
                    if (ACT == 1) { f32x2 a = gelu_pk((f32x2){v0[0], v0[1]}), b = gelu_pk((f32x2){v0[2], v0[3]}), c = gelu_pk((f32x2){v1[0], v1[1]}), d = gelu_pk((f32x2){v1[2], v1[3]});
                        v0 = (f32x4){a.x, a.y, b.x, b.y}; v1 = (f32x4){c.x, c.y, d.x, d.y}; }
                    v0 = v0 * sc; v1 = v1 * sc; u32x4 w; w.x = cvt_pk_bf16(v0[0], v0[1]); w.y = cvt_pk_bf16(v0[2], v0[3]); w.z = cvt_pk_bf16(v1[0], v1[1]); w.w = cvt_pk_bf16(v1[2], v1[3]);
                    *(u32x4*)(rowp + bj * HALF) = w; } }
    }
};

__device__ __forceinline__ float bf2f(unsigned short b) { return __builtin_bit_cast(float, (unsigned)b << 16); }
__device__ __forceinline__ float bflo(unsigned w) { return __builtin_bit_cast(float, w << 16); }
__device__ __forceinline__ float bfhi(unsigned w) { return __builtin_bit_cast(float, w & 0xffff0000u); }
__device__ __forceinline__ float sigmoidf_(float v) { return __builtin_amdgcn_rcpf(1.0f + __expf(-v)); }
constexpr int PROJ_LD = 6400;
constexpr float NORM_EPS_ = 1e-6f;
constexpr float QSCALE = 0.125f * 1.4426950408889634f;

struct EpiProj {
    static constexpr bool PERM = true, AFTER_DRAIN = false;
    bf16_t* O; const float* lbl; const float* gq; const float* gk; const float* sxn; const float* sw; bf16_t* KIO;
    __device__ __forceinline__ void operator()(const f32x4 (&acc)[2][2][4][2], const Unit& u, int wr, int wc, int fr, int fq) const {
        const int pn = u.pn;
        int type;
        if (pn < 2) type = 1; else if (pn < 4) type = 2; else if (pn < 6) type = 0; else if (pn < 8) type = 3; else if (pn < 11) type = 4; else if (pn < 14) type = 5; else if (pn < 17) type = 0; else type = 1;
        const int row0 = u.pm * BM + wr * 64 + fr;
        const int colL0 = pn * BM + wc * 64 + 8 * fq;
        float aux[2][8];
#pragma unroll
        for (int bj = 0; bj < 2; ++bj)
#pragma unroll
            for (int e = 0; e < 8; ++e) aux[bj][e] = 1.0f;
        if (type == 2) {
#pragma unroll
            for (int bj = 0; bj < 2; ++bj)
#pragma unroll
                for (int e = 0; e < 8; ++e) { const int c = colL0 + 32 * bj + e - 512; aux[bj][e] = sigmoidf_(lbl[c] - lbl[512 + c]); }
        } else if (type == 4 || type == 5) {
            const float* g = (type == 4) ? gq : gk; const float sc = (type == 4) ? QSCALE : 1.0f;
#pragma unroll
            for (int bj = 0; bj < 2; ++bj)
#pragma unroll
                for (int e = 0; e < 8; ++e) aux[bj][e] = g[32 * bj + 8 * fq + e] * sc;
        }
        float swv[2][8];
#pragma unroll
        for (int bj = 0; bj < 2; ++bj)
#pragma unroll
            for (int e = 0; e < 8; ++e) swv[bj][e] = sw[pn * BM + bj * HALF + wc * 32 + 8 * fq + e];
        float carry[2][8];
#pragma unroll
        for (int bj = 0; bj < 2; ++bj)
#pragma unroll
            for (int e = 0; e < 8; ++e) carry[bj][e] = 0.f;
        float rscv[8];
#pragma unroll
        for (int q = 0; q < 8; ++q) rscv[q] = sxn[row0 + (q >> 2) * HALF + (q & 3) * 16];
        asm volatile("" ::: "memory");
#pragma unroll
        for (int ai = 0; ai < 2; ++ai)
#pragma unroll
            for (int m = 0; m < 4; ++m) {
                const float rsc = rscv[4 * ai + m];
                float v[2][8];
#pragma unroll
                for (int bj = 0; bj < 2; ++bj)
#pragma unroll
                    for (int n = 0; n < 2; ++n) { typedef int i32x4_ __attribute__((ext_vector_type(4))); const i32x4_ iv = __builtin_bit_cast(i32x4_, acc[ai][bj][m][n]);
#pragma unroll
                        for (int i = 0; i < 4; ++i) v[bj][4 * n + i] = (float)iv[i] * (rsc * swv[bj][4 * n + i]); }
                if (type == 1) {
#pragma unroll
                    for (int bj = 0; bj < 2; ++bj)
#pragma unroll
                        for (int e = 0; e < 8; ++e) v[bj][e] = sigmoidf_(v[bj][e]);
                } else if (type == 2) {
                    float ki[2][8];
#pragma unroll
                    for (int bj = 0; bj < 2; ++bj)
#pragma unroll
                        for (int e = 0; e < 8; ++e) { const float lb = aux[bj][e]; const float ex = fminf(__expf(-v[bj][e]), 1e30f), sg = __builtin_amdgcn_rcpf(1.0f + ex);
                            const float f = lb + (1.0f - lb) * sg, kk = (1.0f - lb) * (ex * sg);
                            float g = __builtin_amdgcn_logf(f);
                            g += __builtin_bit_cast(float, __builtin_amdgcn_update_dpp(0, __builtin_bit_cast(int, g), 0x111, 0xf, 0xf, true));
                            g += __builtin_bit_cast(float, __builtin_amdgcn_update_dpp(0, __builtin_bit_cast(int, g), 0x112, 0xf, 0xf, true));
                            g += __builtin_bit_cast(float, __builtin_amdgcn_update_dpp(0, __builtin_bit_cast(int, g), 0x114, 0xf, 0xf, true));
                            g += __builtin_bit_cast(float, __builtin_amdgcn_update_dpp(0, __builtin_bit_cast(int, g), 0x118, 0xf, 0xf, true));
                            if (m > 0) g += carry[bj][e];
                            if (m < 3) carry[bj][e] = __shfl(g, 16 * fq + 15);
                            v[bj][e] = __builtin_amdgcn_exp2f(g); ki[bj][e] = kk * __builtin_amdgcn_exp2f(-g); }
                    bf16_t* kp = KIO + (size_t)(row0 + ai * HALF + m * 16) * 512 + (colL0 - 512);
#pragma unroll
                    for (int bj = 0; bj < 2; ++bj) { u32x4 w; w.x = cvt_pk_bf16(ki[bj][0], ki[bj][1]); w.y = cvt_pk_bf16(ki[bj][2], ki[bj][3]); w.z = cvt_pk_bf16(ki[bj][4], ki[bj][5]); w.w = cvt_pk_bf16(ki[bj][6], ki[bj][7]);
                        st_wt(kp + 32 * bj, w); }
                } else if (type == 3) {
#pragma unroll
                    for (int bj = 0; bj < 2; ++bj)
#pragma unroll
                        for (int e = 0; e < 8; ++e) v[bj][e] = v[bj][e] * sigmoidf_(v[bj][e]);
                } else if (type >= 4) {
                    float ss = 0.f;
#pragma unroll
                    for (int bj = 0; bj < 2; ++bj)
#pragma unroll
                        for (int e = 0; e < 8; ++e) ss += v[bj][e] * v[bj][e];
                    ss += __shfl_xor(ss, 16); ss += __shfl_xor(ss, 32);
                    const float rs = rsqrtf(ss * (1.0f / 64.0f) + NORM_EPS_);
#pragma unroll
                    for (int bj = 0; bj < 2; ++bj)
#pragma unroll
                        for (int e = 0; e < 8; ++e) v[bj][e] = v[bj][e] * rs * aux[bj][e];
                }
                bf16_t* rowp = O + (size_t)(row0 + ai * HALF + m * 16) * PROJ_LD + colL0;
#pragma unroll
                for (int bj = 0; bj < 2; ++bj) { u32x4 w; w.x = cvt_pk_bf16(v[bj][0], v[bj][1]); w.y = cvt_pk_bf16(v[bj][2], v[bj][3]); w.z = cvt_pk_bf16(v[bj][4], v[bj][5]); w.w = cvt_pk_bf16(v[bj][6], v[bj][7]);
                    st_wt(rowp + 32 * bj, w); }
            }
    }
};

template <int SECOND> struct EpiGate {
    static constexpr bool PERM = true, AFTER_DRAIN = false;
    bf16_t* O; const bf16_t* gate;
    __device__ __forceinline__ void operator()(const f32x4 (&acc)[2][2][4][2], const Unit& u, int wr, int wc, int fr, int fq) const {
        const int row0 = u.pm * BM + wr * 64 + fr; const int col0 = u.pn * BM + wc * 32 + 8 * fq;
#pragma unroll
        for (int ai = 0; ai < 2; ++ai)
#pragma unroll
            for (int m = 0; m < 4; ++m) { const size_t r = (size_t)(row0 + ai * HALF + m * 16);
#pragma unroll
                for (int bj = 0; bj < 2; ++bj) { const int c = col0 + bj * HALF;
                    const u32x4 gw = *(const u32x4*)(gate + r * PROJ_LD + c);
                    float v[8];
#pragma unroll
                    for (int n = 0; n < 2; ++n)
#pragma unroll
                        for (int i = 0; i < 4; ++i) v[4 * n + i] = acc[ai][bj][m][n][i];
                    v[0] *= bflo(gw.x); v[1] *= bfhi(gw.x); v[2] *= bflo(gw.y); v[3] *= bfhi(gw.y); v[4] *= bflo(gw.z); v[5] *= bfhi(gw.z); v[6] *= bflo(gw.w); v[7] *= bfhi(gw.w);
                    if (SECOND) { const u32x4 tw = *(const u32x4*)(O + r * 1024 + c);
                        v[0] += bflo(tw.x); v[1] += bfhi(tw.x); v[2] += bflo(tw.y); v[3] += bfhi(tw.y); v[4] += bflo(tw.z); v[5] += bfhi(tw.z); v[6] += bflo(tw.w); v[7] += bfhi(tw.w); }
                    u32x4 w; w.x = cvt_pk_bf16(v[0], v[1]); w.y = cvt_pk_bf16(v[2], v[3]); w.z = cvt_pk_bf16(v[4], v[5]); w.w = cvt_pk_bf16(v[6], v[7]);
                    *(u32x4*)(O + r * 1024 + c) = w; asm volatile("" ::: "memory"); } }
    }
};

struct EpiResid {
    static constexpr bool PERM = true, AFTER_DRAIN = false;
    const float* X; bf16_t* X1B; float* sumsq;
    __device__ __forceinline__ void operator()(const f32x4 (&acc)[2][2][4][2], const Unit& u, int wr, int wc, int fr, int fq) const {
        const int row0 = u.pm * BM + wr * 64 + fr; const int col0 = u.pn * BM + wc * 32 + 8 * fq;
        f32x4 xv[2][8];
#define ER_LOAD(g_, buf_) do { _Pragma("unroll") for (int j = 0; j < 4; ++j) { const int ai = (g_) >> 1, m = 2 * ((g_) & 1) + (j >> 1), bj = j & 1; const size_t off = (size_t)(row0 + ai * HALF + m * 16) * 1024 + col0 + bj * HALF; \
            xv[buf_][2 * j] = *(const f32x4*)(X + off); xv[buf_][2 * j + 1] = *(const f32x4*)(X + off + 4); } } while (0)
        ER_LOAD(0, 0);
#pragma unroll
        for (int g = 0; g < 4; ++g) {
            if (g + 1 < 4) ER_LOAD(g + 1, (g + 1) & 1);
#pragma unroll
            for (int mm = 0; mm < 2; ++mm) { const int ai = g >> 1, m = 2 * (g & 1) + mm; const size_t r = (size_t)(row0 + ai * HALF + m * 16); float ss = 0.f;
#pragma unroll
                for (int bj = 0; bj < 2; ++bj) { const size_t off = r * 1024 + col0 + bj * HALF; const int j = 2 * mm + bj;
                    const f32x4 v0 = acc[ai][bj][m][0] + xv[g & 1][2 * j], v1 = acc[ai][bj][m][1] + xv[g & 1][2 * j + 1];
                    ss += (v0[0] * v0[0] + v0[1] * v0[1]) + (v0[2] * v0[2] + v0[3] * v0[3]) + (v1[0] * v1[0] + v1[1] * v1[1]) + (v1[2] * v1[2] + v1[3] * v1[3]);
                    u32x4 w; w.x = cvt_pk_bf16(v0[0], v0[1]); w.y = cvt_pk_bf16(v0[2], v0[3]); w.z = cvt_pk_bf16(v1[0], v1[1]); w.w = cvt_pk_bf16(v1[2], v1[3]);
                    *(u32x4*)(X1B + off) = w; }
                ss += __shfl_xor(ss, 16); ss += __shfl_xor(ss, 32);
                if (fq == 0) atomicAdd(sumsq + r, ss); }
            asm volatile("" ::: "memory");
        }
#undef ER_LOAD
    }
};

struct EpiRowScale {
    static constexpr bool PERM = true, AFTER_DRAIN = false;
    bf16_t* O; const float* sumsq;
    __device__ __forceinline__ void operator()(const f32x4 (&acc)[2][2][4][2], const Unit& u, int wr, int wc, int fr, int fq) const {
        const int row0 = u.pm * BM + wr * 64 + fr; const int col0 = u.pn * BM + wc * 32 + 8 * fq;
        float sq[8];
#pragma unroll
        for (int q = 0; q < 8; ++q) sq[q] = __hip_atomic_load(sumsq + (size_t)(row0 + (q >> 2) * HALF + (q & 3) * 16), __ATOMIC_RELAXED, __HIP_MEMORY_SCOPE_AGENT);
        asm volatile("" ::: "memory");
#pragma unroll
        for (int ai = 0; ai < 2; ++ai)
#pragma unroll
            for (int m = 0; m < 4; ++m) { const size_t r = (size_t)(row0 + ai * HALF + m * 16);
                const float rs = rsqrtf(sq[4 * ai + m] * (1.0f / 1024.0f) + NORM_EPS_);
#pragma unroll
                for (int bj = 0; bj < 2; ++bj) { const f32x4 v0 = acc[ai][bj][m][0] * rs, v1 = acc[ai][bj][m][1] * rs;
                    u32x4 w; w.x = cvt_pk_bf16(v0[0], v0[1]); w.y = cvt_pk_bf16(v0[2], v0[3]); w.z = cvt_pk_bf16(v1[0], v1[1]); w.w = cvt_pk_bf16(v1[2], v1[3]);
                    *(u32x4*)(O + r * 1024 + col0 + bj * HALF) = w; } }
    }
};
template <class Epi, class Sched, bool ALIGN_EPI = false, bool SP2 = false, bool I8 = false>
__device__ __forceinline__ void gemm_phase(PG8_LAS unsigned char* lds, const Gemm g, const Sched& S, const Epi& E, const int wid  ) {
    int lane; asm volatile("v_mbcnt_lo_u32_b32 %0, -1, 0\n\tv_mbcnt_hi_u32_b32 %0, -1, %0" : "=v"(lane));
    const int tid = wid * 64 + lane, wr = wid >> 2, wc = wid & 3, fr = lane & 15, fq = lane >> 4;
    const int K = g.K, nt = K / BK;
    unsigned voffA[2], voffB[2];
#pragma unroll
    for (int i = 0; i < 2; ++i) { int R, C; stage_rc(tid * 16 + i * 8192, R, C); const int Rb = Epi::PERM ? ((R & ~31) + perm32(R & 31)) : R;
        voffA[i] = (unsigned)(R * K + C) * 2u; voffB[i] = (unsigned)(Rb * K + C) * 2u; }
    const size_t kstep = (size_t)(BK * 2);
    const size_t hstep = (size_t)HALF * K * 2;
    const size_t tstep = 2 * hstep;
    const unsigned ldsw = (unsigned)wid * 1024u;
    const int aoff = lds_byte(wr * 64 + fr, fq * 8), boff = lds_byte(wc * 32 + fr, fq * 8);
#define PG8_SA(b, h) (((b) * 2 + (h)) * HTB)
#define PG8_SB(b, h) ((4 + (b) * 2 + (h)) * HTB)
#define PG8_STAGE(bufoff, gbase, voff) do { _Pragma("unroll") for (int _i = 0; _i < 2; ++_i) \
        __builtin_amdgcn_global_load_lds((const unsigned*)((const char*)(gbase) + (voff)[_i]), (PG8_LAS unsigned*)(lds + (bufoff) + ldsw + _i * 8192), 16, 0, 0); } while (0)
#define PG8_LDA(dst, b, h) do { _Pragma("unroll") for (int m = 0; m < 4; ++m) _Pragma("unroll") for (int k = 0; k < 2; ++k) dst[m][k] = *(const PG8_LAS bf16x8*)(lds + PG8_SA(b, h) + aoff + m * 2048 + k * 1024); } while (0)
#define PG8_LDB(dst, b, h) do { _Pragma("unroll") for (int n = 0; n < 2; ++n) _Pragma("unroll") for (int k = 0; k < 2; ++k) dst[n][k] = *(const PG8_LAS bf16x8*)(lds + PG8_SB(b, h) + boff + n * 2048 + k * 1024); } while (0)
#define PG8_MMA(ai, bj, At, Bt) do { __builtin_amdgcn_s_setprio(1); _Pragma("unroll") for (int m = 0; m < 4; ++m) _Pragma("unroll") for (int n = 0; n < 2; ++n) _Pragma("unroll") for (int k = 0; k < 2; ++k) \
        { if constexpr (I8) { typedef int i32x4_ __attribute__((ext_vector_type(4))); acc[ai][bj][m][n] = __builtin_bit_cast(f32x4, __builtin_amdgcn_mfma_i32_16x16x64_i8(__builtin_bit_cast(i32x4_, Bt[n][k]), __builtin_bit_cast(i32x4_, At[m][k]), __builtin_bit_cast(i32x4_, acc[ai][bj][m][n]), 0, 0, 0)); } \
          else acc[ai][bj][m][n] = __builtin_amdgcn_mfma_f32_16x16x32_bf16(Bt[n][k], At[m][k], acc[ai][bj][m][n], 0, 0, 0); } __builtin_amdgcn_s_setprio(0); } while (0)
#define PG8_WAIT_V(n) asm volatile("s_waitcnt vmcnt(" #n ")" ::: "memory")
#define PG8_WAIT_L(n) asm volatile("s_waitcnt lgkmcnt(" #n ")" ::: "memory")
#define PG8_BAR __builtin_amdgcn_s_barrier()
#define PG8_SCHED __builtin_amdgcn_sched_barrier(0)
    Unit cur, nxt; int ui = 0;
    if (!S.next(0, cur)) return;
    f32x4 acc[2][2][4][2];
#pragma unroll
    for (int a = 0; a < 2; ++a)
#pragma unroll
        for (int b = 0; b < 2; ++b)
#pragma unroll
            for (int m = 0; m < 4; ++m)
#pragma unroll
                for (int n = 0; n < 2; ++n) acc[a][b][m][n] = (f32x4){0.f, 0.f, 0.f, 0.f};
    bf16x8 At[4][2], B0[2][2], B1[2][2];
    const char* cA = (const char*)g.A + (size_t)cur.pm * tstep; const char* cB = (const char*)g.Bt + (size_t)cur.pn * tstep;
    S.a_ready(cur);
    if constexpr (SP2) {
        PG8_STAGE(PG8_SB(0, 0), cB, voffB); PG8_STAGE(PG8_SB(0, 1), cB + hstep, voffB); PG8_STAGE(PG8_SA(0, 0), cA, voffA); PG8_STAGE(PG8_SA(0, 1), cA + hstep, voffA);
        if (wr == 1) PG8_BAR;
        PG8_WAIT_V(2); PG8_BAR;
        PG8_STAGE(PG8_SB(1, 0), cB + kstep, voffB); PG8_STAGE(PG8_SA(1, 0), cA + kstep, voffA); PG8_STAGE(PG8_SB(1, 1), cB + hstep + kstep, voffB);
        PG8_WAIT_V(6); PG8_BAR;
    } else {
        PG8_STAGE(PG8_SB(0, 0), cB, voffB); PG8_STAGE(PG8_SA(0, 0), cA, voffA); PG8_STAGE(PG8_SB(0, 1), cB + hstep, voffB); PG8_STAGE(PG8_SA(0, 1), cA + hstep, voffA);
        if (wr == 1) PG8_BAR;
        PG8_WAIT_V(4); PG8_BAR;
        PG8_STAGE(PG8_SB(1, 0), cB + kstep, voffB); PG8_STAGE(PG8_SA(1, 0), cA + kstep, voffA); PG8_STAGE(PG8_SB(1, 1), cB + hstep + kstep, voffB);
        PG8_WAIT_V(6); PG8_BAR;
    }
    for (;;) {
        const bool has_next = S.next(ui + 1, nxt);
        const char* nA = has_next ? (const char*)g.A + (size_t)nxt.pm * tstep : cA; const char* nB = has_next ? (const char*)g.Bt + (size_t)nxt.pn * tstep : cB;
        for (int t = 0; t < nt; t += 2) {
            const bool last = (t == nt - 2);
            const char* a1 = cA + (size_t)(t + 1) * kstep;
            const char* a2 = last ? nA : cA + (size_t)(t + 2) * kstep; const char* b2 = last ? nB : cB + (size_t)(t + 2) * kstep;
            const char* a3 = a2 + kstep; const char* b3 = b2 + kstep;
            if (last && has_next) S.a_ready(nxt);
            if constexpr (SP2) {
            PG8_LDB(B0, 0, 0); PG8_LDB(B1, 0, 1); PG8_SCHED; PG8_LDA(At, 0, 0); PG8_STAGE(PG8_SA(1, 1), a1 + hstep, voffA);
            PG8_WAIT_V(8); PG8_WAIT_L(0); PG8_BAR; PG8_MMA(0, 0, At, B0); PG8_MMA(0, 1, At, B1); PG8_BAR; PG8_SCHED;
            PG8_LDA(At, 0, 1); PG8_STAGE(PG8_SB(0, 0), b2, voffB); PG8_STAGE(PG8_SB(0, 1), b2 + hstep, voffB); PG8_STAGE(PG8_SA(0, 0), a2, voffA);
            PG8_WAIT_V(8); PG8_WAIT_L(0); PG8_BAR; PG8_MMA(1, 0, At, B0); PG8_MMA(1, 1, At, B1); PG8_BAR; PG8_SCHED;
            PG8_LDB(B0, 1, 0); PG8_LDB(B1, 1, 1); PG8_SCHED; PG8_LDA(At, 1, 0); PG8_STAGE(PG8_SA(0, 1), a2 + hstep, voffA);
            PG8_WAIT_V(8); PG8_WAIT_L(0); PG8_BAR; PG8_MMA(0, 0, At, B0); PG8_MMA(0, 1, At, B1); PG8_BAR; PG8_SCHED;
            PG8_LDA(At, 1, 1); PG8_STAGE(PG8_SB(1, 0), b3, voffB); PG8_STAGE(PG8_SB(1, 1), b3 + hstep, voffB); PG8_STAGE(PG8_SA(1, 0), a3, voffA);
            PG8_WAIT_V(8); PG8_WAIT_L(0); PG8_BAR; PG8_MMA(1, 0, At, B0); PG8_MMA(1, 1, At, B1); PG8_BAR; PG8_SCHED;
            } else {
            PG8_LDB(B0, 0, 0); PG8_SCHED; PG8_LDA(At, 0, 0); PG8_STAGE(PG8_SA(1, 1), a1 + hstep, voffA);
            PG8_WAIT_L(8); PG8_BAR; PG8_WAIT_L(0); PG8_MMA(0, 0, At, B0); PG8_BAR; PG8_SCHED;
            PG8_LDB(B1, 0, 1); PG8_STAGE(PG8_SB(0, 0), b2, voffB);
            PG8_BAR; PG8_WAIT_L(0); PG8_MMA(0, 1, At, B1); PG8_BAR;
            PG8_LDA(At, 0, 1); PG8_STAGE(PG8_SA(0, 0), a2, voffA);
            PG8_BAR; PG8_WAIT_L(0); PG8_MMA(1, 0, At, B0); PG8_BAR; PG8_SCHED;
            PG8_STAGE(PG8_SB(0, 1), b2 + hstep, voffB);
            PG8_WAIT_V(6); PG8_BAR; PG8_MMA(1, 1, At, B1); PG8_BAR;
            PG8_LDB(B0, 1, 0); PG8_SCHED; PG8_LDA(At, 1, 0); PG8_STAGE(PG8_SA(0, 1), a2 + hstep, voffA);
            PG8_WAIT_L(8); PG8_BAR; PG8_WAIT_L(0); PG8_MMA(0, 0, At, B0); PG8_BAR; PG8_SCHED;
            PG8_LDB(B1, 1, 1); PG8_STAGE(PG8_SB(1, 0), b3, voffB);
            PG8_BAR; PG8_WAIT_L(0); PG8_MMA(0, 1, At, B1); PG8_BAR;
            PG8_LDA(At, 1, 1); PG8_STAGE(PG8_SA(1, 0), a3, voffA);
            PG8_BAR; PG8_WAIT_L(0); PG8_MMA(1, 0, At, B0); PG8_BAR; PG8_SCHED;
            PG8_STAGE(PG8_SB(1, 1), b3 + hstep, voffB);
            PG8_WAIT_V(6); PG8_BAR; PG8_MMA(1, 1, At, B1); PG8_BAR;
            }
        }
        if constexpr (ALIGN_EPI) { if (wr == 0) PG8_BAR; }
        if constexpr (!Epi::AFTER_DRAIN) { E(acc, cur, wr, wc, fr, fq); S.done(cur); }
        if (!has_next) break;
#pragma unroll
        for (int a = 0; a < 2; ++a)
#pragma unroll
            for (int b = 0; b < 2; ++b)
#pragma unroll
                for (int m = 0; m < 4; ++m)
#pragma unroll
                    for (int n = 0; n < 2; ++n) acc[a][b][m][n] = (f32x4){0.f, 0.f, 0.f, 0.f};
        cur = nxt; cA = nA; cB = nB; ++ui;
        if constexpr (ALIGN_EPI) { if (wr == 1) PG8_BAR; }
    }
    PG8_WAIT_V(0);
    if constexpr (!ALIGN_EPI) { if (wr == 0) PG8_BAR; }
    PG8_BAR;
    if constexpr (Epi::AFTER_DRAIN) { E.fused(acc, cur, wr, wc, fr, fq, lds, wid, lane); S.done(cur); }
#undef PG8_SA
#undef PG8_SB
#undef PG8_STAGE
#undef PG8_LDA
#undef PG8_LDB
#undef PG8_MMA
#undef PG8_WAIT_V
#undef PG8_WAIT_L
#undef PG8_BAR
#undef PG8_SCHED
}
}

#define GAS __attribute__((address_space(1)))
#define LAS __attribute__((address_space(3)))
typedef unsigned short bf16;
typedef unsigned v4u __attribute__((ext_vector_type(4)));
typedef float f32x4 __attribute__((ext_vector_type(4)));
typedef float f32x16 __attribute__((ext_vector_type(16)));
typedef short bf16x8 __attribute__((ext_vector_type(8)));
#define LDS_WAIT() asm volatile("s_waitcnt lgkmcnt(0)" ::: "memory")
#define VM_WAIT() asm volatile("s_waitcnt vmcnt(0)" ::: "memory")

constexpr int NWAVES = 8;
constexpr int BATCH = 16, SEQ = 2048, DM = 1024, MTOK = BATCH * SEQ, NIN = 6400;
constexpr int NEXP = 16384;
constexpr float EPS = 1e-6f;
constexpr size_t MiB = 1u << 20;
constexpr size_t WS_CTL = 0, CTL_ZERO_BYTES = 1 * MiB;
constexpr size_t WS_SUMSQ = 512 * 1024;
constexpr size_t WS_WIN = 1 * MiB, WS_WA = 14 * MiB, WS_WB = 15 * MiB, WS_WOUT = 16 * MiB, WS_WQ = 18 * MiB, WS_SK = 20 * MiB;
constexpr size_t WS_U = 24 * MiB, WS_V = 56 * MiB;
constexpr size_t WS_SXN = 22 * MiB, WS_SW = 22 * MiB + 262144;
constexpr size_t WS_CMAX = 65536;
constexpr size_t WS_SU = 21 * MiB;
constexpr size_t WS_PROJ = 88 * MiB;
constexpr size_t WS_X1F = 88 * MiB, WS_X1B = 216 * MiB, WS_Q = 280 * MiB;
constexpr size_t WS_END = 488 * MiB;
constexpr size_t OUT_XN = 0, OUT_MERGED = 0, OUT_KI = 32 * MiB, OUT_YA = 64 * MiB, OUT_YB = 96 * MiB;
constexpr int LDS_CTL = 155648, LDS_BYTES = LDS_CTL + 1024;

__device__ __forceinline__ unsigned pk2(float lo, float hi) { typedef __bf16 b2_ __attribute__((ext_vector_type(2))); typedef float f2_ __attribute__((ext_vector_type(2))); f2_ v = {lo, hi}; return __builtin_bit_cast(unsigned, __builtin_convertvector(v, b2_)); }
__device__ __forceinline__ unsigned f2bf(float f) { return pk2(f, 0.f) & 0xffffu; }
__device__ __forceinline__ float bf2f_(unsigned short b) { return __builtin_bit_cast(float, (unsigned)b << 16); }
__device__ __forceinline__ float wave_sum(float v) {
#pragma unroll
    for (int o = 1; o < 64; o <<= 1) v += __shfl_xor(v, o);
    return v;
}

__device__ __forceinline__ int fresh_lane() { int l; asm volatile("v_mbcnt_lo_u32_b32 %0, -1, 0\n\tv_mbcnt_hi_u32_b32 %0, -1, %0" : "=v"(l)); return l; }

#define XB_TMO      128
#define XB_XCNT(j)  (256  + 64 * (j))
#define XB_XSUB(j)  (1280 + 64 * (j))
#define XB_XGEN(j)  (2304 + 64 * (j))
#define XB_TOP      3328
#define XB_TOPGEN   3392
#define XCD_BAR_WORDS 3456
#define XB_SPIN_CAP (1u << 23)
__device__ __forceinline__ unsigned xb_ld(unsigned* p)              { return __hip_atomic_load(p, __ATOMIC_RELAXED, __HIP_MEMORY_SCOPE_AGENT); }
__device__ __forceinline__ unsigned xb_add(unsigned* p, unsigned v) { return __hip_atomic_fetch_add(p, v, __ATOMIC_RELAXED, __HIP_MEMORY_SCOPE_AGENT); }
__device__ __forceinline__ unsigned xb_xcc_id() { return (unsigned)__builtin_amdgcn_s_getreg((3 << 11) | 20) & 0xFu; }
#define XB_SPIN(cond, bar) do { unsigned _sp = 0; while (cond) { __builtin_amdgcn_s_sleep(1); \
    if ((++_sp & 255u) == 0u) { if (xb_ld(&(bar)[XB_TMO])) break; if (_sp > XB_SPIN_CAP) { atomicAdd(&(bar)[XB_TMO], 1u); break; } } } } while (0)
struct XcdBarrier { unsigned* bar; unsigned x; volatile LAS unsigned* st; };
__device__ __forceinline__ XcdBarrier xcd_barrier_post(unsigned* bar, volatile LAS unsigned* st, int tid) {
    XcdBarrier b; b.bar = bar; b.x = xb_xcc_id(); b.st = st;
    if (tid == 0) (void)xb_add(&bar[XB_XCNT(b.x)], 1u);
    return b;
}
__device__ __forceinline__ void xcd_barrier_complete(unsigned* bar, unsigned x, unsigned& nloc, unsigned& nx) {
    const unsigned G = gridDim.x;
    unsigned sum, cnt, mine, sp = 0u;
    for (;;) {
        sum = 0u; cnt = 0u; mine = 0u;
#pragma unroll
        for (unsigned j = 0; j < 16; ++j) { const unsigned c = xb_ld(&bar[XB_XCNT(j)]); sum += c; cnt += (c > 0u) ? 1u : 0u; mine = (j == x) ? c : mine; }
        if (sum == G) break;
        __builtin_amdgcn_s_sleep(1);
        if ((++sp & 255u) == 0u) { if (xb_ld(&bar[XB_TMO])) break; if (sp > XB_SPIN_CAP) { atomicAdd(&bar[XB_TMO], 1u); break; } }
    }
    nloc = mine > 0u ? mine : 1u; nx = cnt > 0u ? cnt : 1u;
}
__device__ __forceinline__ void xcd_barrier(const XcdBarrier& b, int tid) {
    asm volatile("s_waitcnt vmcnt(0)" ::: "memory");
    __syncthreads();
    if (tid == 0) {
        unsigned* bar = b.bar;
        __builtin_amdgcn_s_waitcnt(0);
        unsigned nloc = b.st[0], nx = b.st[1];
        if (nloc == 0u) { xcd_barrier_complete(bar, b.x, nloc, nx); b.st[0] = nloc; b.st[1] = nx; }
        const unsigned old = xb_add(&bar[XB_XSUB(b.x)], 1u);
        const unsigned gen = old / nloc;
        if (old + 1u == (gen + 1u) * nloc) {
            __builtin_amdgcn_fence(__ATOMIC_RELEASE, "agent");
            asm volatile("s_waitcnt vmcnt(0)" ::: "memory");
            const unsigned og = xb_add(&bar[XB_TOP], 1u);
            const unsigned tg = og / nx;
            if (og + 1u == (tg + 1u) * nx) xb_add(&bar[XB_TOPGEN], 1u);
            else XB_SPIN(xb_ld(&bar[XB_TOPGEN]) == tg, bar);
            __builtin_amdgcn_fence(__ATOMIC_ACQUIRE, "agent");
            xb_add(&bar[XB_XGEN(b.x)], 1u);
            asm volatile("s_waitcnt vmcnt(0)" ::: "memory");
        } else {
            XB_SPIN(xb_ld(&bar[XB_XGEN(b.x)]) == gen, bar);
            __builtin_amdgcn_fence(__ATOMIC_ACQUIRE, "agent");
            asm volatile("s_waitcnt vmcnt(0)" ::: "memory");
        }
    }
    __syncthreads();
}

struct Params {
    const float* x; const float* norm1_g; const float* w_in; const float* hg_norm_g; const float* hg_lb; const float* q_norm_g; const float* k_norm_g;
    const float* w_a; const float* w_b; const float* w_out; const float* norm2_g; const float* peer_wq; const float* peer_sk; const float* peer_u; const float* peer_v;
    float* out; unsigned char* ws; int ph_lo, ph_hi;
};

__device__ __forceinline__ void p0_transpose_item(const float* W, int K, int N, const float* gk, bool permute, bf16* WT, LAS float* scr, int item, int lane) {
    const int nblk = N / 32, kb = item / nblk, nb = item % nblk, k0 = 64 * kb, n0 = 32 * nb;
    { const int r8 = lane >> 3, c4 = (lane & 7) * 4; f32x4 w[8];
#pragma unroll
      for (int i = 0; i < 8; ++i) w[i] = *(const GAS f32x4*)(W + (size_t)(k0 + 8 * i + r8) * N + n0 + c4);
#pragma unroll
      for (int i = 0; i < 8; ++i) { const int kk = 8 * i + r8; const float g = gk ? gk[k0 + kk] : 1.0f; LAS float* d = scr + kk * 33 + c4; d[0] = w[i].x * g; d[1] = w[i].y * g; d[2] = w[i].z * g; d[3] = w[i].w * g; } }
    LDS_WAIT(); asm volatile("" ::: "memory");
    int prow0 = n0;
    if (permute) { const int tile = n0 >> 8, lc = n0 & 255, wc = lc >> 6, bj = (lc >> 5) & 1; prow0 = tile * 256 + 128 * bj + 32 * wc; }
    const int c = lane & 7;
#pragma unroll
    for (int j = 0; j < 4; ++j) { const int n = (lane >> 3) + 8 * j; const LAS float* s = scr + (8 * c) * 33 + n;
        v4u o; o.x = pk2(s[0 * 33], s[1 * 33]); o.y = pk2(s[2 * 33], s[3 * 33]); o.z = pk2(s[4 * 33], s[5 * 33]); o.w = pk2(s[6 * 33], s[7 * 33]);
        *(GAS v4u*)(WT + (size_t)(prow0 + n) * K + k0 + 8 * c) = o; }
    LDS_WAIT(); asm volatile("" ::: "memory");
}
template <bool SIGNED> __device__ __forceinline__ void row_quant8(const float* xrow, const float* gcol, unsigned char* orow, float* scale_out, int lane) {
    const GAS f32x4* xr = (const GAS f32x4*)xrow + 4 * lane;
    f32x4 v[4]; float m = 0.f;
#pragma unroll
    for (int j = 0; j < 4; ++j) { v[j] = xr[j]; if (gcol) v[j] = v[j] * ((const GAS f32x4*)gcol)[4 * lane + j]; m = fmaxf(m, fmaxf(fmaxf(fabsf(v[j].x), fabsf(v[j].y)), fmaxf(fabsf(v[j].z), fabsf(v[j].w)))); }
#pragma unroll
    for (int o = 1; o < 64; o <<= 1) m = fmaxf(m, __shfl_xor(m, o));
    const float inv = m > 0.f ? 127.0f / m : 0.f; const int off = SIGNED ? 0 : 128;
    v4u o; unsigned w[4];
#pragma unroll
    for (int j = 0; j < 4; ++j) { const int q0 = __float2int_rn(v[j].x * inv) + off, q1 = __float2int_rn(v[j].y * inv) + off, q2 = __float2int_rn(v[j].z * inv) + off, q3 = __float2int_rn(v[j].w * inv) + off;
        w[j] = (unsigned)(q0 & 255) | ((unsigned)(q1 & 255) << 8) | ((unsigned)(q2 & 255) << 16) | ((unsigned)(q3 & 255) << 24); }
    o.x = w[0]; o.y = w[1]; o.z = w[2]; o.w = w[3];
    *(GAS v4u*)(orow + 16 * lane) = o;
    if (lane == 0) *scale_out = m * (1.0f / 127.0f);
}
template <bool SIGNED> __device__ __forceinline__ void row_quant8_regs(const f32x4 (&v)[4], unsigned char* orow, float* scale_out, int lane) {
    float m = 0.f;
#pragma unroll
    for (int j = 0; j < 4; ++j) m = fmaxf(m, fmaxf(fmaxf(fabsf(v[j].x), fabsf(v[j].y)), fmaxf(fabsf(v[j].z), fabsf(v[j].w))));
#pragma unroll
    for (int o = 1; o < 64; o <<= 1) m = fmaxf(m, __shfl_xor(m, o));
    const float inv = m > 0.f ? 127.0f / m : 0.f; const int off = SIGNED ? 0 : 128;
    v4u o; unsigned w[4];
#pragma unroll
    for (int j = 0; j < 4; ++j) { const int q0 = __float2int_rn(v[j].x * inv) + off, q1 = __float2int_rn(v[j].y * inv) + off, q2 = __float2int_rn(v[j].z * inv) + off, q3 = __float2int_rn(v[j].w * inv) + off;
        w[j] = (unsigned)(q0 & 255) | ((unsigned)(q1 & 255) << 8) | ((unsigned)(q2 & 255) << 16) | ((unsigned)(q3 & 255) << 24); }
    o.x = w[0]; o.y = w[1]; o.z = w[2]; o.w = w[3];
    *(GAS v4u*)(orow + 16 * lane) = o;
    if (lane == 0) *scale_out = m * (1.0f / 127.0f);
}
__device__ __forceinline__ void quant_tables(const Params& P, int wi, int nw, int wave, int lane) {
    unsigned char* UQ = P.ws + WS_U; unsigned char* VQ = P.ws + WS_V; float* SUV = (float*)(P.ws + WS_SU);
    f32x4 gg[4];
#pragma unroll
    for (int j = 0; j < 4; ++j) gg[j] = ((const GAS f32x4*)P.norm2_g)[4 * lane + j];
    const int stride = nw * NWAVES;
    for (int e = wi * NWAVES + wave; e < NEXP; e += 2 * stride) {
        const int e2 = e + stride < NEXP ? e + stride : e;
        f32x4 ua[4], va[4], ub[4], vb[4];
#pragma unroll
        for (int j = 0; j < 4; ++j) { ua[j] = ((const GAS f32x4*)(P.peer_u + (size_t)e * DM))[4 * lane + j]; va[j] = ((const GAS f32x4*)(P.peer_v + (size_t)e * DM))[4 * lane + j];
            ub[j] = ((const GAS f32x4*)(P.peer_u + (size_t)e2 * DM))[4 * lane + j]; vb[j] = ((const GAS f32x4*)(P.peer_v + (size_t)e2 * DM))[4 * lane + j]; }
#pragma unroll
        for (int j = 0; j < 4; ++j) { ua[j] = ua[j] * gg[j]; ub[j] = ub[j] * gg[j]; }
        row_quant8_regs<true>(ua, UQ + (size_t)e * DM, SUV + 2 * e, lane); row_quant8_regs<true>(va, VQ + (size_t)e * DM, SUV + 2 * e + 1, lane);
        row_quant8_regs<true>(ub, UQ + (size_t)e2 * DM, SUV + 2 * e2, lane); row_quant8_regs<true>(vb, VQ + (size_t)e2 * DM, SUV + 2 * e2 + 1, lane);
    }
}
__device__ __forceinline__ void p0_colmax_item(const float* W, int N, const float* gk, unsigned* cmax, int item, int lane) {
    const int nblk = N / 32, kb = item / nblk, nb = item % nblk, k0 = 64 * kb, n0 = 32 * nb;
    const int r8 = lane >> 3, c4 = (lane & 7) * 4; f32x4 w[8];
#pragma unroll
    for (int i = 0; i < 8; ++i) w[i] = *(const GAS f32x4*)(W + (size_t)(k0 + 8 * i + r8) * N + n0 + c4);
    float m0 = 0.f, m1 = 0.f, m2 = 0.f, m3 = 0.f;
#pragma unroll
    for (int i = 0; i < 8; ++i) { const float g = gk[k0 + 8 * i + r8]; m0 = fmaxf(m0, fabsf(w[i].x * g)); m1 = fmaxf(m1, fabsf(w[i].y * g)); m2 = fmaxf(m2, fabsf(w[i].z * g)); m3 = fmaxf(m3, fabsf(w[i].w * g)); }
#pragma unroll
    for (int o = 8; o < 64; o <<= 1) { m0 = fmaxf(m0, __shfl_xor(m0, o)); m1 = fmaxf(m1, __shfl_xor(m1, o)); m2 = fmaxf(m2, __shfl_xor(m2, o)); m3 = fmaxf(m3, __shfl_xor(m3, o)); }
    if (lane < 8) { atomicMax(cmax + n0 + c4, __builtin_bit_cast(unsigned, m0)); atomicMax(cmax + n0 + c4 + 1, __builtin_bit_cast(unsigned, m1)); atomicMax(cmax + n0 + c4 + 2, __builtin_bit_cast(unsigned, m2)); atomicMax(cmax + n0 + c4 + 3, __builtin_bit_cast(unsigned, m3)); }
}
__device__ __forceinline__ void p0_quant_item(const float* W, int K, int N, const float* gk, const unsigned* cmax, unsigned char* WT8, float* sw, LAS float* scr, int item, int lane) {
    const int nblk = N / 32, kb = item / nblk, nb = item % nblk, k0 = 64 * kb, n0 = 32 * nb;
    const float cm = __builtin_bit_cast(float, __hip_atomic_load(cmax + n0 + (lane & 31), __ATOMIC_RELAXED, __HIP_MEMORY_SCOPE_AGENT)); const float inv = cm > 0.f ? 127.0f / cm : 0.f;
    { const int r8 = lane >> 3, c4 = (lane & 7) * 4; f32x4 w[8]; float iv[4];
#pragma unroll
      for (int i = 0; i < 8; ++i) w[i] = *(const GAS f32x4*)(W + (size_t)(k0 + 8 * i + r8) * N + n0 + c4);
#pragma unroll
      for (int j = 0; j < 4; ++j) { const float c = __builtin_bit_cast(float, __hip_atomic_load(cmax + n0 + c4 + j, __ATOMIC_RELAXED, __HIP_MEMORY_SCOPE_AGENT)); iv[j] = c > 0.f ? 127.0f / c : 0.f; }
#pragma unroll
      for (int i = 0; i < 8; ++i) { const int kk = 8 * i + r8; const float g = gk[k0 + kk]; LAS float* d = scr + kk * 33 + c4; d[0] = w[i].x * g * iv[0]; d[1] = w[i].y * g * iv[1]; d[2] = w[i].z * g * iv[2]; d[3] = w[i].w * g * iv[3]; } }
    (void)inv;
    LDS_WAIT(); asm volatile("" ::: "memory");
    const int tile = n0 >> 8, lc = n0 & 255, wc = lc >> 6, bj = (lc >> 5) & 1; const int prow0 = tile * 256 + 128 * bj + 32 * wc;
    if (kb == 0 && lane < 32) sw[prow0 + lane] = cm * (1.0f / 127.0f);
    const int n = lane >> 1, hf = lane & 1; const LAS float* sp = scr + (32 * hf) * 33 + n; unsigned w[8];
#pragma unroll
    for (int j = 0; j < 8; ++j) { const int q0 = __float2int_rn(sp[(4 * j) * 33]), q1 = __float2int_rn(sp[(4 * j + 1) * 33]), q2 = __float2int_rn(sp[(4 * j + 2) * 33]), q3 = __float2int_rn(sp[(4 * j + 3) * 33]);
        w[j] = (unsigned)(q0 & 255) | ((unsigned)(q1 & 255) << 8) | ((unsigned)(q2 & 255) << 16) | ((unsigned)(q3 & 255) << 24); }
    v4u o0, o1; o0.x = w[0]; o0.y = w[1]; o0.z = w[2]; o0.w = w[3]; o1.x = w[4]; o1.y = w[5]; o1.z = w[6]; o1.w = w[7];
    GAS v4u* dst = (GAS v4u*)(WT8 + (size_t)(prow0 + n) * K + k0 + 32 * hf); dst[0] = o0; dst[1] = o1;
    LDS_WAIT(); asm volatile("" ::: "memory");
}
__device__ __forceinline__ void row_quant_rms_regs(const f32x4 (&v)[4], unsigned char* orow, float* scale_out, int lane) {
    float m = 0.f, ss = 0.f;
#pragma unroll
    for (int j = 0; j < 4; ++j) { m = fmaxf(m, fmaxf(fmaxf(fabsf(v[j].x), fabsf(v[j].y)), fmaxf(fabsf(v[j].z), fabsf(v[j].w)))); ss += (v[j].x * v[j].x + v[j].y * v[j].y) + (v[j].z * v[j].z + v[j].w * v[j].w); }
#pragma unroll
    for (int o = 1; o < 64; o <<= 1) { m = fmaxf(m, __shfl_xor(m, o)); ss += __shfl_xor(ss, o); }
    const float inv = m > 0.f ? 127.0f / m : 0.f; unsigned w[4];
#pragma unroll
    for (int j = 0; j < 4; ++j) { const int q0 = __float2int_rn(v[j].x * inv), q1 = __float2int_rn(v[j].y * inv), q2 = __float2int_rn(v[j].z * inv), q3 = __float2int_rn(v[j].w * inv);
        w[j] = (unsigned)(q0 & 255) | ((unsigned)(q1 & 255) << 8) | ((unsigned)(q2 & 255) << 16) | ((unsigned)(q3 & 255) << 24); }
    v4u o; o.x = w[0]; o.y = w[1]; o.z = w[2]; o.w = w[3];
    *(GAS v4u*)(orow + 16 * lane) = o;
    if (lane == 0) *scale_out = rsqrtf(ss * (1.0f / DM) + EPS) * m * (1.0f / 127.0f);
}
__device__ __forceinline__ void p0_prologue_a(const Params& P, LAS unsigned char* lds, int wave, int lane, int part) {
    const int tid = wave * 64 + lane;
    LAS float* scr = (LAS float*)(lds + wave * 16384);
    const int gw = blockIdx.x * NWAVES + wave, NGW = gridDim.x * NWAVES;
    bf16* WA = (bf16*)(P.ws + WS_WA); bf16* WB = (bf16*)(P.ws + WS_WB); bf16* WOUT = (bf16*)(P.ws + WS_WOUT); bf16* WQ = (bf16*)(P.ws + WS_WQ);
    constexpr int I_IN = (1024 / 64) * (NIN / 32), I_A = (512 / 64) * (1024 / 32), I_B = (256 / 64) * (1024 / 32), I_O = (1024 / 64) * (1024 / 32), I_Q = I_O;
    constexpr int NITEMS = I_IN + I_A + I_B + I_O + I_Q;
    if (part == 0) { for (int it = gw; it < I_IN; it += NGW) p0_colmax_item(P.w_in, NIN, P.norm1_g, (unsigned*)(P.ws + WS_CMAX), it, lane); return; }
    for (int it = I_IN + gw; it < NITEMS; it += NGW) {
        int r = it - I_IN;
        if (r < I_A) { p0_transpose_item(P.w_a, 512, 1024, nullptr, false, WA, scr, r, lane); continue; } r -= I_A;
        if (r < I_B) { p0_transpose_item(P.w_b, 256, 1024, nullptr, false, WB, scr, r, lane); continue; } r -= I_B;
        if (r < I_O) { p0_transpose_item(P.w_out, 1024, 1024, nullptr, false, WOUT, scr, r, lane); continue; } r -= I_O;
        p0_transpose_item(P.peer_wq, 1024, 1024, P.norm2_g, false, WQ, scr, r, lane);
    }
    { bf16* SK = (bf16*)(P.ws + WS_SK); const int gt = blockIdx.x * (NWAVES * 64) + tid, NT = gridDim.x * NWAVES * 64;
      for (int i = gt; i < 8 * 2 * 128 * 64 / 2; i += NT) ((unsigned*)SK)[i] = pk2(P.peer_sk[2 * i], P.peer_sk[2 * i + 1]); }
    { unsigned char* XN8 = (unsigned char*)P.out + OUT_XN; float* sxn = (float*)(P.ws + WS_SXN);
      for (int m = gw; m < MTOK; m += 2 * NGW) { const int m2 = m + NGW < MTOK ? m + NGW : m;
          f32x4 va[4], vb[4];
#pragma unroll
          for (int j = 0; j < 4; ++j) { va[j] = ((const GAS f32x4*)(P.x + (size_t)m * DM))[4 * lane + j]; vb[j] = ((const GAS f32x4*)(P.x + (size_t)m2 * DM))[4 * lane + j]; }
          row_quant_rms_regs(va, XN8 + (size_t)m * DM, sxn + m, lane); row_quant_rms_regs(vb, XN8 + (size_t)m2 * DM, sxn + m2, lane); } }
}
__device__ __forceinline__ void p0_prologue_b(const Params& P, LAS unsigned char* lds, int wave, int lane) {
    LAS float* scr = (LAS float*)(lds + wave * 16384);
    const int gw = blockIdx.x * NWAVES + wave, NGW = gridDim.x * NWAVES;
    constexpr int I_IN = (1024 / 64) * (NIN / 32);
    for (int it = gw; it < I_IN; it += NGW) p0_quant_item(P.w_in, 1024, NIN, P.norm1_g, (const unsigned*)(P.ws + WS_CMAX), P.ws + WS_WIN, (float*)(P.ws + WS_SW), scr, it, lane);
}

__device__ __forceinline__ unsigned cvtpk(float lo, float hi) { typedef __bf16 b2 __attribute__((ext_vector_type(2))); typedef float f2 __attribute__((ext_vector_type(2))); f2 v = {lo, hi}; return __builtin_bit_cast(unsigned, __builtin_convertvector(v, b2)); }
typedef short s16x4 __attribute__((ext_vector_type(4)));
__device__ __forceinline__ s16x4 ds_tr16(const LAS unsigned char* p) { return __builtin_bit_cast(s16x4, __builtin_amdgcn_ds_read_tr16_b64_v4i16((LAS s16x4*)p)); }
__device__ __forceinline__ void hgrn_chunked_item(const Params& P, LAS unsigned char* lds, int item, int wave, int lane) {
    constexpr int QD_P = 272, TR_P = 320;
    constexpr int L_QD = 0, L_KI = 17408, L_KT = 34816, L_V = 55296, L_DEC = 75776, L_AP = 76288, L_OB = 82432;
    const int tid = wave * 64 + lane, b = item >> 2, h = item & 3;
    const int lrow = tid >> 3, lc = (tid & 7) * 16;
    const int l31 = lane & 31, hh = lane >> 5, jv = wave & 3, kh = wave >> 2;
    const bf16* base = (const bf16*)(P.ws + WS_PROJ) + (size_t)b * SEQ * NIN + h * 128;
    const bf16* kib = (const bf16*)((const unsigned char*)P.out + OUT_KI) + (size_t)b * SEQ * 512 + h * 128;
    bf16* YA = (bf16*)((unsigned char*)P.out + OUT_YA) + (size_t)b * SEQ * 512 + h * 128;
    float gn[16];
#pragma unroll
    for (int e = 0; e < 16; ++e) gn[e] = P.hg_norm_g[lc + e];
    f32x16 S[2];
    S[0] = f32x16{}; S[1] = f32x16{};
    v4u pq[2], pd[2], pk[2], pv[2], pg[2];
#define HG_LOAD(n_) do { const size_t ro_ = (size_t)((n_) * 64 + lrow); const bf16* r = base + ro_ * NIN + lc; const bf16* kr = kib + ro_ * 512 + lc; \
      pg[0] = *(const v4u*)(r + 1536); pg[1] = *(const v4u*)(r + 1544);   \
      pq[0] = *(const v4u*)r; pq[1] = *(const v4u*)(r + 8); pd[0] = *(const v4u*)(r + 512); pd[1] = *(const v4u*)(r + 520); pk[0] = *(const v4u*)kr; pk[1] = *(const v4u*)(kr + 8); \
      pv[0] = *(const v4u*)(r + 1024); pv[1] = *(const v4u*)(r + 1032); } while (0)
    HG_LOAD(0);
    const int tro = (4 * hh + ((lane & 15) >> 2)) * TR_P + (16 * ((lane >> 4) & 1) + 4 * (lane & 3)) * 2;
#pragma unroll 1
    for (int n = 0; n < SEQ / 64; ++n) {
        { const unsigned qw[8] = {pq[0].x, pq[0].y, pq[0].z, pq[0].w, pq[1].x, pq[1].y, pq[1].z, pq[1].w}, dw[8] = {pd[0].x, pd[0].y, pd[0].z, pd[0].w, pd[1].x, pd[1].y, pd[1].z, pd[1].w};
          unsigned w[8];
#pragma unroll
          for (int e = 0; e < 8; ++e) w[e] = pk2(pg8::bflo(qw[e]) * pg8::bflo(dw[e]), pg8::bfhi(qw[e]) * pg8::bfhi(dw[e]));
          v4u a0, a1; a0.x = w[0]; a0.y = w[1]; a0.z = w[2]; a0.w = w[3]; a1.x = w[4]; a1.y = w[5]; a1.z = w[6]; a1.w = w[7];
          *(LAS v4u*)(lds + L_QD + lrow * QD_P + lc * 2) = a0; *(LAS v4u*)(lds + L_QD + lrow * QD_P + lc * 2 + 16) = a1;
          if (lrow == 63) {
#pragma unroll
              for (int e4 = 0; e4 < 4; ++e4) *(LAS f32x4*)(lds + L_DEC + (lc + 4 * e4) * 4) = (f32x4){pg8::bflo(dw[2 * e4]), pg8::bfhi(dw[2 * e4]), pg8::bflo(dw[2 * e4 + 1]), pg8::bfhi(dw[2 * e4 + 1])}; } }
        *(LAS v4u*)(lds + L_KI + lrow * QD_P + lc * 2) = pk[0]; *(LAS v4u*)(lds + L_KI + lrow * QD_P + lc * 2 + 16) = pk[1];
        *(LAS v4u*)(lds + L_KT + lrow * TR_P + lc * 2) = pk[0]; *(LAS v4u*)(lds + L_KT + lrow * TR_P + lc * 2 + 16) = pk[1];
        *(LAS v4u*)(lds + L_V + lrow * TR_P + lc * 2) = pv[0]; *(LAS v4u*)(lds + L_V + lrow * TR_P + lc * 2 + 16) = pv[1];
        const v4u og0 = pg[0], og1 = pg[1];
        HG_LOAD(n + 1 < SEQ / 64 ? n + 1 : n);
        __syncthreads();
        if (wave < 3) {
            const int st = wave >> 1, ct = (wave + 1) >> 1;
            f32x16 a_ = f32x16{};
#pragma unroll
            for (int ks = 0; ks < 8; ++ks) { const bf16x8 af = *(const LAS bf16x8*)(lds + L_KI + (32 * st + l31) * QD_P + (16 * ks + 8 * hh) * 2), bfr = *(const LAS bf16x8*)(lds + L_QD + (32 * ct + l31) * QD_P + (16 * ks + 8 * hh) * 2);
                a_ = __builtin_amdgcn_mfma_f32_32x32x16_bf16(af, bfr, a_, 0, 0, 0); }
            if (st == ct) {
#pragma unroll
                for (int r = 0; r < 16; ++r) if ((r & 3) + 8 * (r >> 2) + 4 * hh > l31) a_[r] = 0.f; }
            v4u a0, a1;
            a0.x = cvtpk(a_[0], a_[1]); a0.y = cvtpk(a_[2], a_[3]); a0.z = cvtpk(a_[4], a_[5]); a0.w = cvtpk(a_[6], a_[7]);
            a1.x = cvtpk(a_[8], a_[9]); a1.y = cvtpk(a_[10], a_[11]); a1.z = cvtpk(a_[12], a_[13]); a1.w = cvtpk(a_[14], a_[15]);
            *(LAS v4u*)(lds + L_AP + wave * 2048 + lane * 16) = a0; *(LAS v4u*)(lds + L_AP + wave * 2048 + 1024 + lane * 16) = a1;
        }
        f32x16 oacc[2]; oacc[0] = f32x16{}; oacc[1] = f32x16{};
#pragma unroll
        for (int kl = 0; kl < 2; ++kl)
#pragma unroll
            for (int st = 0; st < 2; ++st) {
                v4u sb; sb.x = cvtpk(S[kl][8 * st + 0], S[kl][8 * st + 1]); sb.y = cvtpk(S[kl][8 * st + 2], S[kl][8 * st + 3]); sb.z = cvtpk(S[kl][8 * st + 4], S[kl][8 * st + 5]); sb.w = cvtpk(S[kl][8 * st + 6], S[kl][8 * st + 7]);
                typedef unsigned u2v __attribute__((ext_vector_type(2)));
#pragma unroll
                for (int rt = 0; rt < 2; ++rt) {
                    const LAS unsigned char* qp = lds + L_QD + (32 * rt + l31) * QD_P + (32 * (2 * kh + kl) + 16 * st + 4 * hh) * 2;
                    const u2v lo = *(const LAS u2v*)qp, hi = *(const LAS u2v*)(qp + 16);
                    v4u av; av.x = lo.x; av.y = lo.y; av.z = hi.x; av.w = hi.y;
                    oacc[rt] = __builtin_amdgcn_mfma_f32_32x32x16_bf16(__builtin_bit_cast(bf16x8, av), __builtin_bit_cast(bf16x8, sb), oacc[rt], 0, 0, 0); } }
        bf16x8 vf[4];
#pragma unroll
        for (int ks = 0; ks < 4; ++ks) { const LAS unsigned char* a1 = lds + L_V + tro + (16 * ks) * TR_P + (32 * jv) * 2; const s16x4 lo = ds_tr16(a1), hi = ds_tr16(a1 + 8 * TR_P);
            vf[ks] = (bf16x8){lo[0], lo[1], lo[2], lo[3], hi[0], hi[1], hi[2], hi[3]}; }
#pragma unroll
        for (int kl = 0; kl < 2; ++kl) {
            const int kt = 2 * kh + kl;
#pragma unroll
            for (int ks = 0; ks < 4; ++ks) { const LAS unsigned char* a1 = lds + L_KT + tro + (16 * ks) * TR_P + (32 * kt) * 2; const s16x4 lo = ds_tr16(a1), hi = ds_tr16(a1 + 8 * TR_P);
                const bf16x8 kf = {lo[0], lo[1], lo[2], lo[3], hi[0], hi[1], hi[2], hi[3]};
                S[kl] = __builtin_amdgcn_mfma_f32_32x32x16_bf16(kf, vf[ks], S[kl], 0, 0, 0); }
#pragma unroll
            for (int r4 = 0; r4 < 4; ++r4) { const f32x4 d = *(const LAS f32x4*)(lds + L_DEC + (32 * kt + 8 * r4 + 4 * hh) * 4);
                S[kl][4 * r4 + 0] *= d.x; S[kl][4 * r4 + 1] *= d.y; S[kl][4 * r4 + 2] *= d.z; S[kl][4 * r4 + 3] *= d.w; }
        }
        __syncthreads();
        if (kh == 0) {
            const v4u a0 = *(const LAS v4u*)(lds + L_AP + lane * 16), a1 = *(const LAS v4u*)(lds + L_AP + 1024 + lane * 16);
            oacc[0] = __builtin_amdgcn_mfma_f32_32x32x16_bf16(__builtin_bit_cast(bf16x8, a0), vf[0], oacc[0], 0, 0, 0);
            oacc[0] = __builtin_amdgcn_mfma_f32_32x32x16_bf16(__builtin_bit_cast(bf16x8, a1), vf[1], oacc[0], 0, 0, 0);
        } else {
#pragma unroll
            for (int st = 0; st < 2; ++st) { const v4u a0 = *(const LAS v4u*)(lds + L_AP + (1 + st) * 2048 + lane * 16), a1 = *(const LAS v4u*)(lds + L_AP + (1 + st) * 2048 + 1024 + lane * 16);
                oacc[1] = __builtin_amdgcn_mfma_f32_32x32x16_bf16(__builtin_bit_cast(bf16x8, a0), vf[2 * st], oacc[1], 0, 0, 0);
                oacc[1] = __builtin_amdgcn_mfma_f32_32x32x16_bf16(__builtin_bit_cast(bf16x8, a1), vf[2 * st + 1], oacc[1], 0, 0, 0); }
        }
#pragma unroll
        for (int rt = 0; rt < 2; ++rt)
#pragma unroll
            for (int r = 0; r < 16; ++r) ((LAS float*)(lds + L_OB + kh * 32768))[(32 * rt + (r & 3) + 8 * (r >> 2) + 4 * hh) * 128 + 32 * jv + l31] = oacc[rt][r];
        __syncthreads();
        {
            float o[16]; float ss = 0.f;
#pragma unroll
            for (int e4 = 0; e4 < 4; ++e4) { const f32x4 t = *(const LAS f32x4*)(lds + L_OB + (lrow * 128 + lc + 4 * e4) * 4) + *(const LAS f32x4*)(lds + L_OB + 32768 + (lrow * 128 + lc + 4 * e4) * 4);
                o[4 * e4] = t.x; o[4 * e4 + 1] = t.y; o[4 * e4 + 2] = t.z; o[4 * e4 + 3] = t.w; ss += (t.x * t.x + t.y * t.y) + (t.z * t.z + t.w * t.w); }
            ss += __shfl_xor(ss, 1); ss += __shfl_xor(ss, 2); ss += __shfl_xor(ss, 4);
            const float rs = rsqrtf(ss * (1.0f / 128.0f) + EPS);
            const unsigned gw[8] = {og0.x, og0.y, og0.z, og0.w, og1.x, og1.y, og1.z, og1.w};
            unsigned yw[8];
#pragma unroll
            for (int e = 0; e < 8; ++e) yw[e] = pk2(o[2 * e] * rs * gn[2 * e] * pg8::bflo(gw[e]), o[2 * e + 1] * rs * gn[2 * e + 1] * pg8::bfhi(gw[e]));
            bf16* yp = YA + (size_t)(n * 64 + lrow) * 512 + lc;
            v4u y0, y1; y0.x = yw[0]; y0.y = yw[1]; y0.z = yw[2]; y0.w = yw[3]; y1.x = yw[4]; y1.y = yw[5]; y1.z = yw[6]; y1.w = yw[7];
            *(v4u*)yp = y0; *(v4u*)(yp + 8) = y1;
        }
    }
#undef HG_LOAD
    __syncthreads();
}

constexpr int KB_P = 144;
constexpr int VB_P = 192;
template <int CG> __device__ __forceinline__ void attn_group(const bf16* base, LAS unsigned char* vbuf, int h, int r, int p0, int lane, float Mfix, f32x16 (&oT)[2], float& lsum) {
    constexpr int dil = (CG == 0) ? 1 : (CG == 1) ? 4 : 16, Lg = SEQ / dil, NT = 5;
    const int l31 = lane & 31, hh = lane >> 5;
    const int qcol = 2048 + (CG * 4 + h) * 64, kcol = qcol + 768, vcol = qcol + 1536;
    bf16x8 qf[4];
    { const bf16* qr = base + (size_t)(dil * (p0 + l31) + r) * NIN + qcol + 8 * hh;
#pragma unroll
      for (int ks = 0; ks < 4; ++ks) qf[ks] = *(const bf16x8*)(qr + 16 * ks); }
    const int Pq = p0 + l31, lim = Pq < 128 ? Pq : 128;
    const int kp0 = p0 - 128;
    const bool full = p0 >= 128;
    const int r8 = lane >> 3, ch = lane & 7;
    LAS unsigned char* kbuf = vbuf + 32 * VB_P;
    v4u k0[4], v0[4], k1[4], v1[4], k2[4], v2[4];
#define ATT_LOAD(KR, VR, t_) do { _Pragma("unroll") for (int c = 0; c < 4; ++c) { int pa = kp0 + 32 * (t_) + r8 + 8 * c; pa = pa < 0 ? 0 : (pa > Lg - 1 ? Lg - 1 : pa); \
        const bf16* rr = base + (size_t)(pa * dil + r) * NIN + 8 * ch; KR[c] = *(const v4u*)(rr + kcol); VR[c] = *(const v4u*)(rr + vcol); } } while (0)
    const LAS unsigned char* trp = vbuf + (4 * hh + ((lane & 15) >> 2)) * VB_P + (16 * ((lane >> 4) & 1) + 4 * (lane & 3)) * 2;
    const LAS unsigned char* kfp = kbuf + l31 * KB_P + 16 * hh;
#define ATT_TILE(KR, VR, t_, EDGE) do { const int kp = kp0 + 32 * (t_); \
        _Pragma("unroll") for (int c = 0; c < 4; ++c) { *(LAS v4u*)(kbuf + (r8 + 8 * c) * KB_P + 16 * ch) = KR[c]; *(LAS v4u*)(vbuf + (r8 + 8 * c) * VB_P + 16 * ch) = VR[c]; } \
        f32x16 sc = f32x16{}; \
        _Pragma("unroll") for (int ks = 0; ks < 4; ++ks) sc = __builtin_amdgcn_mfma_f32_32x32x16_bf16(*(const LAS bf16x8*)(kfp + 32 * ks), qf[ks], sc, 0, 0, 0); \
        float p[16]; \
        if ((EDGE) || !full) { const int dl = Pq - kp - 4 * hh; \
            _Pragma("unroll") for (int q = 0; q < 16; ++q) { const int d = dl - ((q & 3) + 8 * (q >> 2)); const float e = __builtin_amdgcn_exp2f(sc[q] - Mfix); p[q] = ((unsigned)d <= (unsigned)lim) ? e : 0.f; lsum += p[q]; } } \
        else { _Pragma("unroll") for (int q = 0; q < 16; ++q) { p[q] = __builtin_amdgcn_exp2f(sc[q] - Mfix); lsum += p[q]; } } \
        v4u pk0, pk1; \
        pk0.x = cvtpk(p[0], p[1]); pk0.y = cvtpk(p[2], p[3]); pk0.z = cvtpk(p[4], p[5]); pk0.w = cvtpk(p[6], p[7]); \
        pk1.x = cvtpk(p[8], p[9]); pk1.y = cvtpk(p[10], p[11]); pk1.z = cvtpk(p[12], p[13]); pk1.w = cvtpk(p[14], p[15]); \
        _Pragma("unroll") for (int dt = 0; dt < 2; ++dt) _Pragma("unroll") for (int ss = 0; ss < 2; ++ss) { const LAS unsigned char* a1 = trp + (16 * ss) * VB_P + (32 * dt) * 2; \
                const s16x4 lo = ds_tr16(a1), hi = ds_tr16(a1 + 8 * VB_P); \
                const bf16x8 vf = {lo[0], lo[1], lo[2], lo[3], hi[0], hi[1], hi[2], hi[3]}; \
                oT[dt] = __builtin_amdgcn_mfma_f32_32x32x16_bf16(vf, __builtin_bit_cast(bf16x8, ss == 0 ? pk0 : pk1), oT[dt], 0, 0, 0); } } while (0)
    ATT_LOAD(k0, v0, 0); ATT_LOAD(k1, v1, 1);
#pragma unroll 1
    for (int tile = 0; tile < NT; tile += 3) {
        ATT_LOAD(k2, v2, (tile + 2 < NT ? tile + 2 : NT - 1)); ATT_TILE(k0, v0, tile, tile == 0);
        ATT_LOAD(k0, v0, (tile + 3 < NT ? tile + 3 : NT - 1)); ATT_TILE(k1, v1, tile + 1, tile + 1 == NT - 1);
        ATT_LOAD(k1, v1, (tile + 4 < NT ? tile + 4 : NT - 1)); if (tile + 2 < NT) ATT_TILE(k2, v2, tile + 2, false);
    }
#undef ATT_TILE
#undef ATT_LOAD
}
constexpr int AT_O0 = 86016, AT_L0 = AT_O0 + 65536, AT_TSK = AT_L0 + 2048;
__device__ __forceinline__ void attn_wg_task(const Params& P, LAS unsigned char* lds, int task, int wave, int lane, float Mfix) {
    const int pt = task & 3, h = (task >> 2) & 3, b = task >> 4;
    const bf16* base = (const bf16*)(P.ws + WS_PROJ) + (size_t)b * SEQ * NIN;
    LAS unsigned char* vbuf = lds + wave * 10752;
    typedef unsigned u2v __attribute__((ext_vector_type(2)));
    const int l31 = lane & 31, hh = lane >> 5;
#define AT_CHUNK(p_, dt_, r4_) (lds + AT_O0 + (p_) * 128 + ((8 * (dt_) + 2 * (r4_) + hh + ((p_) >> 4) + (p_)) & 15) * 8)
#pragma unroll 1
    for (int i = 0; i < 2; ++i) {
        f32x16 oT[2]; oT[0] = f32x16{}; oT[1] = f32x16{}; float lsum = 0.f;
        const int pl = 64 * wave + 32 * i;
        attn_group<0>(base, vbuf, h, 0, 512 * pt + pl, lane, Mfix, oT, lsum);
        lsum += __shfl_xor(lsum, 32);
        const int p = pl + l31;
        if (hh == 0) ((LAS float*)(lds + AT_L0))[p] = lsum;
#pragma unroll
        for (int dt = 0; dt < 2; ++dt)
#pragma unroll
            for (int r4 = 0; r4 < 4; ++r4) { u2v w; w.x = cvtpk(oT[dt][4 * r4], oT[dt][4 * r4 + 1]); w.y = cvtpk(oT[dt][4 * r4 + 2], oT[dt][4 * r4 + 3]); *(LAS u2v*)AT_CHUNK(p, dt, r4) = w; }
    }
    __syncthreads();
#pragma unroll 1
    for (int i = 0; i < 2; ++i) {
        f32x16 oT[2]; oT[0] = f32x16{}; oT[1] = f32x16{}; float lsum = 0.f;
        const int pair = 2 * wave + i, c4 = pair & 3, tq = pair >> 2;
        attn_group<1>(base, vbuf, h, c4, 128 * pt + 32 * tq, lane, Mfix, oT, lsum);
        lsum += __shfl_xor(lsum, 32);
        const int p = 4 * (32 * tq + l31) + c4;
        if (hh == 0) ((LAS float*)(lds + AT_L0))[p] += lsum;
#pragma unroll
        for (int dt = 0; dt < 2; ++dt)
#pragma unroll
            for (int r4 = 0; r4 < 4; ++r4) { LAS u2v* cp = (LAS u2v*)AT_CHUNK(p, dt, r4); const u2v o0 = *cp;
                u2v w; w.x = cvtpk(oT[dt][4 * r4] + pg8::bflo(o0.x), oT[dt][4 * r4 + 1] + pg8::bfhi(o0.x)); w.y = cvtpk(oT[dt][4 * r4 + 2] + pg8::bflo(o0.y), oT[dt][4 * r4 + 3] + pg8::bfhi(o0.y)); *cp = w; }
    }
    __syncthreads();
#pragma unroll 1
    for (int i = 0; i < 2; ++i) {
        const int r16 = 2 * wave + i;
        f32x16 oT[2]; oT[0] = f32x16{}; oT[1] = f32x16{}; float lsum = 0.f;
        attn_group<2>(base, vbuf, h, r16, 32 * pt, lane, Mfix, oT, lsum);
        lsum += __shfl_xor(lsum, 32);
        const int p = 16 * l31 + r16;
        lsum += ((const LAS float*)(lds + AT_L0))[p];
        const float rl = 1.0f / lsum;
        bf16* yb = (bf16*)((unsigned char*)P.out + OUT_YB) + (size_t)(b * SEQ + 512 * pt + p) * 256 + h * 64;
#pragma unroll
        for (int dt = 0; dt < 2; ++dt)
#pragma unroll
            for (int r4 = 0; r4 < 4; ++r4) { const u2v o0 = *(const LAS u2v*)AT_CHUNK(p, dt, r4);
                u2v w; w.x = cvtpk((oT[dt][4 * r4] + pg8::bflo(o0.x)) * rl, (oT[dt][4 * r4 + 1] + pg8::bfhi(o0.x)) * rl); w.y = cvtpk((oT[dt][4 * r4 + 2] + pg8::bflo(o0.y)) * rl, (oT[dt][4 * r4 + 3] + pg8::bfhi(o0.y)) * rl);
                *(u2v*)(yb + 32 * dt + 8 * r4 + 4 * hh) = w; }
    }
#undef AT_CHUNK
    __syncthreads();
}

__host__ __device__ __forceinline__ unsigned f2key(float f) { const unsigned u = __builtin_bit_cast(unsigned, f); return (u & 0x80000000u) ? ~u : (u | 0x80000000u); }
__host__ __device__ __forceinline__ float key2f(unsigned k) { const unsigned u = (k & 0x80000000u) ? (k & 0x7fffffffu) : ~k; return __builtin_bit_cast(float, u); }
__device__ __forceinline__ unsigned fkmax(unsigned a, unsigned b) { unsigned r; asm("v_max_f32 %0, %1, %2" : "=v"(r) : "v"(a), "v"(b)); return r; }
__device__ __forceinline__ unsigned fkmin(unsigned a, unsigned b) { unsigned r; asm("v_min_f32 %0, %1, %2" : "=v"(r) : "v"(a), "v"(b)); return r; }
#define CE(K, a, b) do { const unsigned x_ = K[a], y_ = K[b]; K[a] = fkmax(x_, y_); K[b] = fkmin(x_, y_); } while (0)
#define BSORT16(K) do { CE(K,0,1); CE(K,3,2); CE(K,4,5); CE(K,7,6); CE(K,8,9); CE(K,11,10); CE(K,12,13); CE(K,15,14); CE(K,0,2); CE(K,1,3); CE(K,6,4); CE(K,7,5); CE(K,8,10); CE(K,9,11); CE(K,14,12); CE(K,15,13); CE(K,0,1); CE(K,2,3); CE(K,5,4); CE(K,7,6); CE(K,8,9); CE(K,10,11); CE(K,13,12); CE(K,15,14); CE(K,0,4); CE(K,1,5); CE(K,2,6); CE(K,3,7); CE(K,12,8); CE(K,13,9); CE(K,14,10); CE(K,15,11); CE(K,0,2); CE(K,1,3); CE(K,4,6); CE(K,5,7); CE(K,10,8); CE(K,11,9); CE(K,14,12); CE(K,15,13); CE(K,0,1); CE(K,2,3); CE(K,4,5); CE(K,6,7); CE(K,9,8); CE(K,11,10); CE(K,13,12); CE(K,15,14); CE(K,0,8); CE(K,1,9); CE(K,2,10); CE(K,3,11); CE(K,4,12); CE(K,5,13); CE(K,6,14); CE(K,7,15); CE(K,0,4); CE(K,1,5); CE(K,2,6); CE(K,3,7); CE(K,8,12); CE(K,9,13); CE(K,10,14); CE(K,11,15); CE(K,0,2); CE(K,1,3); CE(K,4,6); CE(K,5,7); CE(K,8,10); CE(K,9,11); CE(K,12,14); CE(K,13,15); CE(K,0,1); CE(K,2,3); CE(K,4,5); CE(K,6,7); CE(K,8,9); CE(K,10,11); CE(K,12,13); CE(K,14,15); } while (0)
#define BMERGE16(K) do { CE(K,0,8); CE(K,1,9); CE(K,2,10); CE(K,3,11); CE(K,4,12); CE(K,5,13); CE(K,6,14); CE(K,7,15); CE(K,0,4); CE(K,1,5); CE(K,2,6); CE(K,3,7); CE(K,8,12); CE(K,9,13); CE(K,10,14); CE(K,11,15); CE(K,0,2); CE(K,1,3); CE(K,4,6); CE(K,5,7); CE(K,8,10); CE(K,9,11); CE(K,12,14); CE(K,13,15); CE(K,0,1); CE(K,2,3); CE(K,4,5); CE(K,6,7); CE(K,8,9); CE(K,10,11); CE(K,12,13); CE(K,14,15); } while (0)
#define TOPMERGE16(A, B) do { _Pragma("unroll") for (int i_ = 0; i_ < 16; ++i_) A[i_] = fkmax(A[i_], B[15 - i_]); BMERGE16(A); } while (0)
template <int A, int B> struct PairIns {
    static __device__ __forceinline__ void run(const float (&s1)[16], const float (&s2)[16], unsigned (&K)[16]) {
        if constexpr ((A + 1) * (B + 1) <= 16) {
            unsigned x = (__builtin_bit_cast(unsigned, s1[A] + s2[B]) & ~255u) | (unsigned)((A << 4) | B);
#pragma unroll
            for (int i = (A + 1) * (B + 1) - 1; i < 16; ++i) { const unsigned a_ = K[i]; K[i] = fkmax(a_, x); x = fkmin(a_, x); }
            PairIns<A, B + 1>::run(s1, s2, K);
        } else if constexpr (B != 0) { PairIns<A + 1, 0>::run(s1, s2, K); }
    }
};
template <> struct PairIns<16, 0> { static __device__ __forceinline__ void run(const float (&)[16], const float (&)[16], unsigned (&)[16]) {} };

__device__ __forceinline__ float gelu_erf(float v) { return 0.5f * v * (1.0f + erff(v * 0.70710678118654752f)); }


typedef __bf16 bf16x2_t __attribute__((ext_vector_type(2)));
typedef float f32x2 __attribute__((ext_vector_type(2)));
constexpr int RSHIFT = 10, NR = NEXP >> RSHIFT;
constexpr int PL_BUF = 16384, PL_GATE = 8192, PL_WS = 32768, PL_WSB = 12288;

__device__ __forceinline__ float dot2u(unsigned x, unsigned w, float acc) {
    return __builtin_amdgcn_fdot2_f32_bf16(__builtin_bit_cast(bf16x2_t, x), __builtin_bit_cast(bf16x2_t, w), acc, false);
}
__device__ __forceinline__ float dot16_bf16(const unsigned (&x)[8], const v4u a, const v4u b) {
    float p = 0.f;
    p = dot2u(x[0], a.x, p); p = dot2u(x[1], a.y, p); p = dot2u(x[2], a.z, p); p = dot2u(x[3], a.w, p);
    p = dot2u(x[4], b.x, p); p = dot2u(x[5], b.y, p); p = dot2u(x[6], b.z, p); p = dot2u(x[7], b.w, p);
    return p;
}
__device__ __forceinline__ void rows_axpy2(float (&acc)[16], float& corr, float a0, float a1, const v4u w0, const v4u w1) {
    typedef _Float16 h2_ __attribute__((ext_vector_type(2)));
    const h2_ c = {(_Float16)__builtin_amdgcn_fmed3f(a0 * 4096.0f, -60000.0f, 60000.0f), (_Float16)__builtin_amdgcn_fmed3f(a1 * 4096.0f, -60000.0f, 60000.0f)};
    const h2_ one = {(_Float16)1.0f, (_Float16)1.0f};
    corr = __builtin_amdgcn_fdot2(c, one, corr, false);
    const unsigned x0[4] = {w0.x, w0.y, w0.z, w0.w}, x1[4] = {w1.x, w1.y, w1.z, w1.w};
#pragma unroll
    for (int j = 0; j < 4; ++j) {
        acc[4 * j + 0] = __builtin_amdgcn_fdot2(__builtin_bit_cast(h2_, __builtin_amdgcn_perm(x1[j], x0[j], 0x0c040c00u) | 0x64006400u), c, acc[4 * j + 0], false);
        acc[4 * j + 1] = __builtin_amdgcn_fdot2(__builtin_bit_cast(h2_, __builtin_amdgcn_perm(x1[j], x0[j], 0x0c050c01u) | 0x64006400u), c, acc[4 * j + 1], false);
        acc[4 * j + 2] = __builtin_amdgcn_fdot2(__builtin_bit_cast(h2_, __builtin_amdgcn_perm(x1[j], x0[j], 0x0c060c02u) | 0x64006400u), c, acc[4 * j + 2], false);
        acc[4 * j + 3] = __builtin_amdgcn_fdot2(__builtin_bit_cast(h2_, __builtin_amdgcn_perm(x1[j], x0[j], 0x0c070c03u) | 0x64006400u), c, acc[4 * j + 3], false); }
}
__device__ __forceinline__ void row_axpy1(f32x2 (&acc)[8], float a, const v4u w) {
    const unsigned ww[4] = {w.x, w.y, w.z, w.w};
#pragma unroll
    for (int j = 0; j < 4; ++j) { const f32x2 lo = {(float)(ww[j] & 0xffu), (float)((ww[j] >> 8) & 0xffu)}, hi = {(float)((ww[j] >> 16) & 0xffu), (float)(ww[j] >> 24)};
        acc[2 * j] = lo * a + acc[2 * j]; acc[2 * j + 1] = hi * a + acc[2 * j + 1]; }
}
typedef int i32x4 __attribute__((ext_vector_type(4)));

constexpr int GL_SHS = 0, GL_XQ = 2048, GL_CNT = 6144, GL_RM = 8192, GL_SA = 10240;
__device__ __forceinline__ void peer_gather_u(const Params& P, LAS unsigned char* lds, int tok0, int wave, int lane, int parity) {
    const LAS unsigned short* idxs = (const LAS unsigned short*)(lds + parity * PL_BUF); const LAS _Float16* gates = (const LAS _Float16*)(lds + parity * PL_BUF + PL_GATE);
    LAS unsigned char* wsb = lds + PL_WS + wave * PL_WSB;
    LAS int* srm = (LAS int*)(wsb + GL_RM); LAS float* shs = (LAS float*)(wsb + GL_SHS); LAS float* sa = (LAS float*)(wsb + GL_SA);
    LAS int* cnt = (LAS int*)(wsb + GL_CNT); LAS int* start = cnt + 64;
    const unsigned char* UQ = P.ws + WS_U; const f32x2* SUV = (const f32x2*)(P.ws + WS_SU);
    const bf16* X1B = (const bf16*)(P.ws + WS_X1B); const float* sumsq = (const float*)(P.ws + WS_SUMSQ);
    float sx[4];
#pragma unroll
    for (int tk = 0; tk < 4; ++tk) { const size_t t = (size_t)(tok0 + wave * 4 + tk); const float r2 = rsqrtf(sumsq[t] * (1.0f / DM) + EPS);
        const v4u xa = *(const v4u*)(X1B + t * DM + lane * 16), xb = *(const v4u*)(X1B + t * DM + lane * 16 + 8); f32x4 x[4]; float m = 0.f;
        x[0] = (f32x4){pg8::bflo(xa.x), pg8::bfhi(xa.x), pg8::bflo(xa.y), pg8::bfhi(xa.y)} * r2; x[1] = (f32x4){pg8::bflo(xa.z), pg8::bfhi(xa.z), pg8::bflo(xa.w), pg8::bfhi(xa.w)} * r2;
        x[2] = (f32x4){pg8::bflo(xb.x), pg8::bfhi(xb.x), pg8::bflo(xb.y), pg8::bfhi(xb.y)} * r2; x[3] = (f32x4){pg8::bflo(xb.z), pg8::bfhi(xb.z), pg8::bflo(xb.w), pg8::bfhi(xb.w)} * r2;
#pragma unroll
        for (int j = 0; j < 4; ++j) m = fmaxf(m, fmaxf(fmaxf(fabsf(x[j].x), fabsf(x[j].y)), fmaxf(fabsf(x[j].z), fabsf(x[j].w))));
#pragma unroll
        for (int o = 1; o < 64; o <<= 1) m = fmaxf(m, __shfl_xor(m, o));
        const float inv = m > 0.f ? 127.0f / m : 0.f; sx[tk] = m * (1.0f / 127.0f); unsigned w[4];
#pragma unroll
        for (int j = 0; j < 4; ++j) { const int q0 = __float2int_rn(x[j].x * inv), q1 = __float2int_rn(x[j].y * inv), q2 = __float2int_rn(x[j].z * inv), q3 = __float2int_rn(x[j].w * inv);
            w[j] = (unsigned)(q0 & 255) | ((unsigned)(q1 & 255) << 8) | ((unsigned)(q2 & 255) << 16) | ((unsigned)(q3 & 255) << 24); }
        v4u xw_; xw_.x = w[0]; xw_.y = w[1]; xw_.z = w[2]; xw_.w = w[3]; *(LAS v4u*)(wsb + GL_XQ + tk * 1024 + lane * 16) = xw_; }
    { int ee[8], sl[8]; float gg[8];
#pragma unroll
      for (int tk = 0; tk < 4; ++tk) { const int tl = wave * 4 + tk;
          ee[2 * tk] = idxs[tl * 128 + lane]; ee[2 * tk + 1] = idxs[tl * 128 + 64 + lane]; gg[2 * tk] = (float)gates[tl * 128 + lane]; gg[2 * tk + 1] = (float)gates[tl * 128 + 64 + lane]; }
      cnt[lane] = 0;
      LDS_WAIT(); asm volatile("" ::: "memory");
#pragma unroll
      for (int i = 0; i < 8; ++i) sl[i] = __hip_atomic_fetch_add(cnt + ((ee[i] >> RSHIFT) * 4 + (i >> 1)), 1, __ATOMIC_RELAXED, __HIP_MEMORY_SCOPE_WORKGROUP);
      LDS_WAIT(); asm volatile("" ::: "memory");
      { const int c = cnt[lane]; int inc = c;
#pragma unroll
        for (int o = 1; o < 64; o <<= 1) { const int t = __shfl_up(inc, o); if (lane >= o) inc += t; }
        start[lane] = inc - c; }
      LDS_WAIT(); asm volatile("" ::: "memory");
#pragma unroll
      for (int i = 0; i < 8; ++i) { const int pos = start[(ee[i] >> RSHIFT) * 4 + (i >> 1)] + sl[i]; const f32x2 sc2 = SUV[ee[i]]; srm[pos] = ee[i] | ((i >> 1) << 14); sa[pos] = gg[i] * sc2.y; shs[pos] = sc2.x * sx[i >> 1]; }
      LDS_WAIT(); asm volatile("" ::: "memory"); }
    {
        const int lu = fresh_lane(); const unsigned ulo = (unsigned)lu * 16u;
        const LAS unsigned char* xql = wsb + GL_XQ + lu * 16;
        const bool hh = (lu & 32) != 0, b4 = (lu & 16) != 0, b3 = (lu & 8) != 0;
        v4u rA[8], rB[8];
#define U_LOAD(R, pos_) do { const i32x4 e0_ = *(const LAS i32x4*)(srm + (pos_)) & 0x3fff, e1_ = *(const LAS i32x4*)(srm + (pos_) + 4) & 0x3fff; \
        R[0] = *(const v4u*)(UQ + (((unsigned)e0_[0] << 10) + ulo)); R[1] = *(const v4u*)(UQ + (((unsigned)e0_[1] << 10) + ulo)); R[2] = *(const v4u*)(UQ + (((unsigned)e0_[2] << 10) + ulo)); R[3] = *(const v4u*)(UQ + (((unsigned)e0_[3] << 10) + ulo)); \
        R[4] = *(const v4u*)(UQ + (((unsigned)e1_[0] << 10) + ulo)); R[5] = *(const v4u*)(UQ + (((unsigned)e1_[1] << 10) + ulo)); R[6] = *(const v4u*)(UQ + (((unsigned)e1_[2] << 10) + ulo)); R[7] = *(const v4u*)(UQ + (((unsigned)e1_[3] << 10) + ulo)); } while (0)
#define U_DOT1(R, k_, ev_) do { const v4u xs_ = *(const LAS v4u*)(xql + (((ev_) >> 4) & 0xc00)); \
        const int p0_ = __builtin_amdgcn_sdot4((int)R[k_].x, (int)xs_.x, 0, false), p1_ = __builtin_amdgcn_sdot4((int)R[k_].y, (int)xs_.y, 0, false); \
        pd_[k_] = __builtin_amdgcn_sdot4((int)R[k_].z, (int)xs_.z, p0_, false) + __builtin_amdgcn_sdot4((int)R[k_].w, (int)xs_.w, p1_, false); } while (0)
#define U_COMP(R, pos_) do { int pd_[8]; \
        { const i32x4 t0v_ = *(const LAS i32x4*)(srm + (pos_)), t1v_ = *(const LAS i32x4*)(srm + (pos_) + 4); \
          U_DOT1(R, 0, t0v_[0]); U_DOT1(R, 1, t0v_[1]); U_DOT1(R, 2, t0v_[2]); U_DOT1(R, 3, t0v_[3]); U_DOT1(R, 4, t1v_[0]); U_DOT1(R, 5, t1v_[1]); U_DOT1(R, 6, t1v_[2]); U_DOT1(R, 7, t1v_[3]); } \
        typedef unsigned u2s_ __attribute__((ext_vector_type(2))); \
        const u2s_ w0_ = __builtin_amdgcn_permlane32_swap((unsigned)pd_[0], (unsigned)pd_[4], false, false), w1_ = __builtin_amdgcn_permlane32_swap((unsigned)pd_[1], (unsigned)pd_[5], false, false); \
        const u2s_ w2_ = __builtin_amdgcn_permlane32_swap((unsigned)pd_[2], (unsigned)pd_[6], false, false), w3_ = __builtin_amdgcn_permlane32_swap((unsigned)pd_[3], (unsigned)pd_[7], false, false); \
        const int k0_ = (int)(w0_.x + w0_.y), k1_ = (int)(w1_.x + w1_.y), k2_ = (int)(w2_.x + w2_.y), k3_ = (int)(w3_.x + w3_.y);     \
        const u2s_ y0_ = __builtin_amdgcn_permlane16_swap((unsigned)k0_, (unsigned)k2_, false, false), y1_ = __builtin_amdgcn_permlane16_swap((unsigned)k1_, (unsigned)k3_, false, false); \
        const int m0_ = (int)(y0_.x + y0_.y), m1_ = (int)(y1_.x + y1_.y);                  \
        int kk_ = b3 ? m1_ : m0_; const int tt_ = b3 ? m0_ : m1_; \
        kk_ += __builtin_amdgcn_update_dpp(0, tt_, 0x128, 0xf, 0xf, false);            \
        kk_ += __builtin_amdgcn_update_dpp(0, kk_, 0x141, 0xf, 0xf, false);            \
        kk_ += __builtin_amdgcn_update_dpp(0, kk_, 0xB1, 0xf, 0xf, false);             \
        kk_ += __builtin_amdgcn_update_dpp(0, kk_, 0x4E, 0xf, 0xf, false);             \
        if ((lu & 7) == 0) { const int p_ = (pos_) + (lu >> 3); const float hid_ = (float)kk_ * shs[p_]; sa[p_] = gelu_erf(hid_) * sa[p_]; } } while (0)
        U_LOAD(rA, 0);
#pragma unroll 1
        for (int m = 0; m < 64; m += 2) {
            U_LOAD(rB, 8 * m + 8);  U_COMP(rA, 8 * m);
            U_LOAD(rA, (m + 2 < 64 ? 8 * m + 16 : 0));  U_COMP(rB, 8 * m + 8);
        }
#undef U_LOAD
#undef U_DOT1
#undef U_COMP
    }
    LDS_WAIT(); asm volatile("" ::: "memory");
}
__device__ __forceinline__ void peer_gather_v(const Params& P, LAS unsigned char* lds, int tok0, int wave) {
    typedef int i32x4_ __attribute__((ext_vector_type(4)));
    LAS unsigned char* wsb = lds + PL_WS + wave * PL_WSB;
    LAS int* srm = (LAS int*)(wsb + GL_RM); LAS float* sa = (LAS float*)(wsb + GL_SA);
    const unsigned char* VQ = P.ws + WS_V; const bf16* X1B = (const bf16*)(P.ws + WS_X1B);
    const int lv = fresh_lane(); const unsigned vlo = (unsigned)lv * 16u;
    float amax[4] = {0.f, 0.f, 0.f, 0.f};
#pragma unroll
    for (int i = 0; i < 8; ++i) { const int p = lv + 64 * i; const float av = fabsf(sa[p]); const int tk = (srm[p] >> 14) & 3;
        amax[0] = fmaxf(amax[0], tk == 0 ? av : 0.f); amax[1] = fmaxf(amax[1], tk == 1 ? av : 0.f); amax[2] = fmaxf(amax[2], tk == 2 ? av : 0.f); amax[3] = fmaxf(amax[3], tk == 3 ? av : 0.f); }
#pragma unroll
    for (int o = 1; o < 64; o <<= 1) { amax[0] = fmaxf(amax[0], __shfl_xor(amax[0], o)); amax[1] = fmaxf(amax[1], __shfl_xor(amax[1], o)); amax[2] = fmaxf(amax[2], __shfl_xor(amax[2], o)); amax[3] = fmaxf(amax[3], __shfl_xor(amax[3], o)); }
    { float inv[4];
#pragma unroll
      for (int t = 0; t < 4; ++t) inv[t] = amax[t] > 0.f ? 127.0f / amax[t] : 0.f;
#pragma unroll
      for (int i = 0; i < 8; ++i) { const int p = lv + 64 * i; const int tk = (srm[p] >> 14) & 3; const float iv = tk == 0 ? inv[0] : tk == 1 ? inv[1] : tk == 2 ? inv[2] : inv[3];
          const int q = __float2int_rn(sa[p] * iv); ((LAS int*)sa)[p] = (q & 255) | (tk << 8); } }
    LDS_WAIT(); asm volatile("" ::: "memory");
    i32x4_ acc[16];
#pragma unroll
    for (int j = 0; j < 16; ++j) acc[j] = (i32x4_){0, 0, 0, 0};
    {
        const int li = lv & 3;
        v4u rA[8], rB[8], rC[8];
#define V_LOAD(R, pos_) do { const i32x4 e0_ = *(const LAS i32x4*)(srm + (pos_)) & 0x3fff, e1_ = *(const LAS i32x4*)(srm + (pos_) + 4) & 0x3fff; \
        R[0] = *(const v4u*)(VQ + (((unsigned)e0_[0] << 10) + vlo)); R[1] = *(const v4u*)(VQ + (((unsigned)e0_[1] << 10) + vlo)); R[2] = *(const v4u*)(VQ + (((unsigned)e0_[2] << 10) + vlo)); R[3] = *(const v4u*)(VQ + (((unsigned)e0_[3] << 10) + vlo)); \
        R[4] = *(const v4u*)(VQ + (((unsigned)e1_[0] << 10) + vlo)); R[5] = *(const v4u*)(VQ + (((unsigned)e1_[1] << 10) + vlo)); R[6] = *(const v4u*)(VQ + (((unsigned)e1_[2] << 10) + vlo)); R[7] = *(const v4u*)(VQ + (((unsigned)e1_[3] << 10) + vlo)); } while (0)
#define V_QUAD(r0_, r1_, r2_, r3_, aop_, j_) do { \
        const unsigned l01_ = __builtin_amdgcn_perm(r1_, r0_, 0x05010400u), h01_ = __builtin_amdgcn_perm(r1_, r0_, 0x07030602u); \
        const unsigned l23_ = __builtin_amdgcn_perm(r3_, r2_, 0x05010400u), h23_ = __builtin_amdgcn_perm(r3_, r2_, 0x07030602u); \
        acc[4 * (j_) + 0] = __builtin_amdgcn_mfma_i32_4x4x4i8((int)(aop_), (int)__builtin_amdgcn_perm(l23_, l01_, 0x05040100u), acc[4 * (j_) + 0], 0, 0, 0); \
        acc[4 * (j_) + 1] = __builtin_amdgcn_mfma_i32_4x4x4i8((int)(aop_), (int)__builtin_amdgcn_perm(l23_, l01_, 0x07060302u), acc[4 * (j_) + 1], 0, 0, 0); \
        acc[4 * (j_) + 2] = __builtin_amdgcn_mfma_i32_4x4x4i8((int)(aop_), (int)__builtin_amdgcn_perm(h23_, h01_, 0x05040100u), acc[4 * (j_) + 2], 0, 0, 0); \
        acc[4 * (j_) + 3] = __builtin_amdgcn_mfma_i32_4x4x4i8((int)(aop_), (int)__builtin_amdgcn_perm(h23_, h01_, 0x07060302u), acc[4 * (j_) + 3], 0, 0, 0); } while (0)
#define V_AOP(c0_, c1_, c2_, c3_) (((((c0_) >> 8) == li) ? ((unsigned)(c0_) & 255u) : 0u) | ((((c1_) >> 8) == li) ? (((unsigned)(c1_) & 255u) << 8) : 0u) | ((((c2_) >> 8) == li) ? (((unsigned)(c2_) & 255u) << 16) : 0u) | ((((c3_) >> 8) == li) ? (((unsigned)(c3_) & 255u) << 24) : 0u))
#define V_COMP(R, pos_) do { const i32x4 c0_ = *(const LAS i32x4*)((const LAS int*)sa + (pos_)), c1_ = *(const LAS i32x4*)((const LAS int*)sa + (pos_) + 4); \
        const unsigned a0_ = V_AOP(c0_[0], c0_[1], c0_[2], c0_[3]), a1_ = V_AOP(c1_[0], c1_[1], c1_[2], c1_[3]); \
        V_QUAD(R[0].x, R[1].x, R[2].x, R[3].x, a0_, 0); V_QUAD(R[0].y, R[1].y, R[2].y, R[3].y, a0_, 1); V_QUAD(R[0].z, R[1].z, R[2].z, R[3].z, a0_, 2); V_QUAD(R[0].w, R[1].w, R[2].w, R[3].w, a0_, 3); \
        V_QUAD(R[4].x, R[5].x, R[6].x, R[7].x, a1_, 0); V_QUAD(R[4].y, R[5].y, R[6].y, R[7].y, a1_, 1); V_QUAD(R[4].z, R[5].z, R[6].z, R[7].z, a1_, 2); V_QUAD(R[4].w, R[5].w, R[6].w, R[7].w, a1_, 3); } while (0)
        V_LOAD(rA, 0); V_LOAD(rB, 8);
#pragma unroll 1
        for (int m = 0; m < 63; m += 3) {
            V_LOAD(rC, 8 * m + 16);  V_COMP(rA, 8 * m);
            V_LOAD(rA, 8 * m + 24);  V_COMP(rB, 8 * m + 8);
            V_LOAD(rB, (m + 4 < 64 ? 8 * m + 32 : 0));  V_COMP(rC, 8 * m + 16);
        }
        V_COMP(rA, 8 * 63);
#undef V_LOAD
#undef V_QUAD
#undef V_AOP
#undef V_COMP
    }
    const int le = fresh_lane();
#pragma unroll
    for (int tk = 0; tk < 4; ++tk) { const size_t t = (size_t)(tok0 + wave * 4 + tk); const float sc = amax[tk] * (1.0f / 127.0f);
        const v4u xa = *(const v4u*)(X1B + t * DM + le * 16), xb = *(const v4u*)(X1B + t * DM + le * 16 + 8); float* orow = P.out + t * DM + le * 16;
        const unsigned xw[8] = {xa.x, xa.y, xa.z, xa.w, xb.x, xb.y, xb.z, xb.w};
#pragma unroll
        for (int j = 0; j < 4; ++j) *(f32x4*)(orow + 4 * j) = (f32x4){pg8::bflo(xw[2 * j]) + sc * (float)acc[4 * j][tk], pg8::bfhi(xw[2 * j]) + sc * (float)acc[4 * j + 1][tk], pg8::bflo(xw[2 * j + 1]) + sc * (float)acc[4 * j + 2][tk], pg8::bfhi(xw[2 * j + 1]) + sc * (float)acc[4 * j + 3][tk]}; }
}

__device__ __forceinline__ void topk_part(const Params& P, LAS unsigned char* lds, int item, int wave, int parity) {
    const int lane = fresh_lane();
    const int tok0 = item * 32, hh = lane >> 5, l31 = lane & 31;
    LAS unsigned short* idxs = (LAS unsigned short*)(lds + parity * PL_BUF);
    LAS _Float16* gates = (LAS _Float16*)(lds + parity * PL_BUF + PL_GATE);
    const bf16* Q = (const bf16*)(P.ws + WS_Q); const bf16* SK = (const bf16*)(P.ws + WS_SK);
    unsigned L0[16], L1[16];
#pragma unroll
    for (int p = 0; p < 2; ++p) {
        f32x16 acc[4];
        { LAS unsigned char* tb = lds + PL_WS + wave * PL_WSB;
          const int r8 = lane >> 3, ch = lane & 7;
          v4u tq[4], t0[4], t1[4];
#pragma unroll
          for (int c = 0; c < 4; ++c) tq[c] = *(const v4u*)(Q + (size_t)(tok0 + r8 + 8 * c) * DM + wave * 128 + p * 64 + 8 * ch);
          const bf16* skp = SK + (size_t)((wave * 2 + p) * 128 + r8) * 64 + 8 * ch;
#pragma unroll
          for (int c = 0; c < 4; ++c) t0[c] = *(const v4u*)(skp + (size_t)(8 * c) * 64);
#pragma unroll
          for (int c = 0; c < 4; ++c) *(LAS v4u*)(tb + (r8 + 8 * c) * 144 + 16 * ch) = tq[c];
          bf16x8 bq[4];
#pragma unroll
          for (int ks = 0; ks < 4; ++ks) bq[ks] = *(const LAS bf16x8*)(tb + l31 * 144 + 32 * ks + 16 * hh);
#define TK_TILE(TC, TN, nt_) do { \
          _Pragma("unroll") for (int c = 0; c < 4; ++c) *(LAS v4u*)(tb + (r8 + 8 * c) * 144 + 16 * ch) = TC[c]; \
          if ((nt_) + 1 < 4) { _Pragma("unroll") for (int c = 0; c < 4; ++c) TN[c] = *(const v4u*)(skp + (size_t)(32 * ((nt_) + 1) + 8 * c) * 64); } \
          acc[nt_] = f32x16{}; \
          _Pragma("unroll") for (int ks = 0; ks < 4; ++ks) acc[nt_] = __builtin_amdgcn_mfma_f32_32x32x16_bf16(*(const LAS bf16x8*)(tb + l31 * 144 + 32 * ks + 16 * hh), bq[ks], acc[nt_], 0, 0, 0); } while (0)
          TK_TILE(t0, t1, 0); TK_TILE(t1, t0, 1); TK_TILE(t0, t1, 2); TK_TILE(t1, t0, 3);
#undef TK_TILE
        }
        unsigned G0[16], G1[16], G2[16], G3[16];
#pragma unroll
        for (int r = 0; r < 16; ++r) { const unsigned n = (unsigned)((r & 3) + 8 * (r >> 2)) + 4u * (unsigned)hh;
            const float a0_ = acc[0][r], a1_ = acc[1][r], a2_ = acc[2][r], a3_ = acc[3][r];
            G0[r] = (__builtin_bit_cast(unsigned, a0_) & ~127u) | n; G1[r] = (__builtin_bit_cast(unsigned, a1_) & ~127u) | (n + 32u); G2[r] = (__builtin_bit_cast(unsigned, a2_) & ~127u) | (n + 64u); G3[r] = (__builtin_bit_cast(unsigned, a3_) & ~127u) | (n + 96u); }
        BSORT16(G0); BSORT16(G1); BSORT16(G2); BSORT16(G3);
        TOPMERGE16(G0, G1); TOPMERGE16(G2, G3); TOPMERGE16(G0, G2);
#pragma unroll
        for (int i = 0; i < 16; ++i) { if (p == 0) L0[i] = G0[i]; else L1[i] = G0[i]; }
        __builtin_amdgcn_sched_barrier(0);
    }
    {
        unsigned O0[16], O1[16];
#pragma unroll
        for (int i = 0; i < 16; ++i) { O0[i] = (unsigned)__shfl_xor((int)L0[i], 32); O1[i] = (unsigned)__shfl_xor((int)L1[i], 32); }
        TOPMERGE16(L0, O0); TOPMERGE16(L1, O1);
    }
    {
        float s1[16], s2[16]; unsigned K[16];
        LAS int* tab = (LAS int*)(lds + PL_WS + wave * PL_WSB);
#pragma unroll
        for (int i = 0; i < 16; ++i) { s1[i] = __builtin_bit_cast(float, L0[i] & ~127u); s2[i] = __builtin_bit_cast(float, L1[i] & ~127u); tab[i * 64 + lane] = (int)(L0[i] & 127u); tab[1024 + i * 64 + lane] = (int)(L1[i] & 127u); K[i] = 0xff800000u; }
        PairIns<0, 0>::run(s1, s2, K);
        float e[16], sum = 0.f; const float v0 = __builtin_bit_cast(float, K[0] & ~255u);
#pragma unroll
        for (int i = 0; i < 16; ++i) { e[i] = __expf(__builtin_bit_cast(float, K[i] & ~255u) - v0); sum += e[i]; }
        const float rs = 1.0f / sum;
        LDS_WAIT();
        if (hh == 0) {
#pragma unroll
            for (int i = 0; i < 16; ++i) { const int a_ = (int)((K[i] >> 4) & 15u), b_ = (int)(K[i] & 15u);
                idxs[l31 * 128 + wave * 16 + i] = (unsigned short)(tab[a_ * 64 + lane] * 128 + tab[1024 + b_ * 64 + lane]); gates[l31 * 128 + wave * 16 + i] = (_Float16)(e[i] * rs); }
        }
    }
}

constexpr int NPHASE = 8;
__global__ void __launch_bounds__(NWAVES * 64, 2) mk_fwd(Params P) {
    extern __shared__ __attribute__((aligned(16))) unsigned char lds_raw[];
    LAS unsigned char* lds = (LAS unsigned char*)lds_raw;
    const int wave = __builtin_amdgcn_readfirstlane((int)threadIdx.x >> 6);
    const int G = gridDim.x;
    unsigned char* ws = P.ws;
#if MK_FUSED
    { const int l0 = fresh_lane(); for (int u = wave * 64 + l0; u < (LDS_BYTES - LDS_CTL) / 4; u += NWAVES * 64) ((LAS unsigned*)(lds + LDS_CTL))[u] = 0u; }
    __syncthreads();
    const XcdBarrier xbar = xcd_barrier_post((unsigned*)(ws + WS_CTL) + 4096, (volatile LAS unsigned*)(lds + LDS_CTL + 320) + 8, wave * 64 + fresh_lane());
#define SEAM0() cg::this_grid().sync()
#define SEAM() xcd_barrier(xbar, wave * 64 + fresh_lane())
#else
#define SEAM0() do {} while (0)
#define SEAM() do {} while (0)
#endif
#ifndef PHASE_MASK
#define PHASE_MASK 0xff
#endif
#define IN(k) (((PHASE_MASK >> (k)) & 1) && P.ph_lo <= (k) && (k) < P.ph_hi)
    bf16* XN = (bf16*)((unsigned char*)P.out + OUT_XN); bf16* MERGED = (bf16*)((unsigned char*)P.out + OUT_MERGED);
    bf16* YA = (bf16*)((unsigned char*)P.out + OUT_YA); bf16* YB = (bf16*)((unsigned char*)P.out + OUT_YB);
    bf16* PROJ = (bf16*)(ws + WS_PROJ);
    float* sumsq = (float*)(ws + WS_SUMSQ);

    if (IN(0)) {
        unsigned* sb = (unsigned*)(ws + WS_CTL) + 12000;
        p0_prologue_a(P, lds, wave, fresh_lane(), 0);
#if MK_FUSED
        asm volatile("s_waitcnt vmcnt(0)" ::: "memory"); __syncthreads();
        if (wave == 0 && fresh_lane() == 0) { __builtin_amdgcn_fence(__ATOMIC_RELEASE, "agent"); asm volatile("s_waitcnt vmcnt(0)" ::: "memory"); (void)__hip_atomic_fetch_add(sb, 1u, __ATOMIC_RELAXED, __HIP_MEMORY_SCOPE_AGENT); }
#endif
        p0_prologue_a(P, lds, wave, fresh_lane(), 1);
#if MK_FUSED
        if (wave == 0 && fresh_lane() == 0) { unsigned sp = 0; while (__hip_atomic_load(sb, __ATOMIC_RELAXED, __HIP_MEMORY_SCOPE_AGENT) < (unsigned)G) { __builtin_amdgcn_s_sleep(2); if (++sp > (1u << 22)) break; }
            __builtin_amdgcn_fence(__ATOMIC_ACQUIRE, "agent"); asm volatile("s_waitcnt vmcnt(0)" ::: "memory"); }
        __syncthreads();
#endif
        p0_prologue_b(P, lds, wave, fresh_lane()); SEAM0(); }
    if (IN(1)) {
        pg8::Gemm g{XN, (const bf16*)(ws + WS_WIN), MTOK, NIN, DM / 2};
        pg8::StaticOrder S; S.init(MTOK, NIN, G, (int)blockIdx.x);
        pg8::EpiProj E{PROJ, P.hg_lb, P.q_norm_g, P.k_norm_g, (const float*)(ws + WS_SXN), (const float*)(ws + WS_SW), (bf16*)((unsigned char*)P.out + OUT_KI)};
        pg8::gemm_phase<pg8::EpiProj, pg8::StaticOrder, true, true, true>(lds, g, S, E, wave);
        { const int nunits = (MTOK / 256) * (NIN / 256), rem = nunits % G;
          const int lq = fresh_lane();
          if (rem == 0) quant_tables(P, (int)blockIdx.x, G, wave, lq); else if ((int)blockIdx.x >= rem) quant_tables(P, (int)blockIdx.x - rem, G - rem, wave, lq); }
        SEAM();
    }
    if (IN(2)) {
        const int lane2 = fresh_lane();
        const int nh = (G >= 128) ? 64 : 0;
        if (nh) { if ((int)blockIdx.x < nh) hgrn_chunked_item(P, lds, (int)blockIdx.x, wave, lane2); }
        else { for (int it = (int)blockIdx.x; it < BATCH * 4; it += G) hgrn_chunked_item(P, lds, it, wave, lane2); }
        {
            float mq = fabsf(P.q_norm_g[lane2]), mk = fabsf(P.k_norm_g[lane2]);
#pragma unroll
            for (int o = 1; o < 64; o <<= 1) { mq = fmaxf(mq, __shfl_xor(mq, o)); mk = fmaxf(mk, __shfl_xor(mk, o)); }
            const float Mfix = 8.0f * 1.4426950408889634f * 1.02f * mq * mk;
            unsigned* ctr = (unsigned*)(ws + WS_CTL) + 8192;
            for (;;) { if (wave == 0 && lane2 == 0) *(volatile LAS unsigned*)(lds + AT_TSK) = __hip_atomic_fetch_add(ctr, 1u, __ATOMIC_RELAXED, __HIP_MEMORY_SCOPE_AGENT);
                __syncthreads();
                const int task = __builtin_amdgcn_readfirstlane((int)*(volatile LAS unsigned*)(lds + AT_TSK)); if (task >= BATCH * 4 * 4) break;
                attn_wg_task(P, lds, task, wave, lane2, Mfix); }
        }
        SEAM();
    }
    if (IN(3)) {
        { pg8::Gemm g{YA, (const bf16*)(ws + WS_WA), MTOK, DM, 512}; pg8::StaticOrder S; S.init(MTOK, DM, G, (int)blockIdx.x);
          pg8::EpiGate<0> E{MERGED, PROJ + 4352};
          pg8::gemm_phase<pg8::EpiGate<0>, pg8::StaticOrder, true, true>(lds, g, S, E, wave); }
        VM_WAIT(); __syncthreads();
        { pg8::Gemm g{YB, (const bf16*)(ws + WS_WB), MTOK, DM, 256}; pg8::StaticOrder S; S.init(MTOK, DM, G, (int)blockIdx.x);
          pg8::EpiGate<1> E{MERGED, PROJ + 5376};
          pg8::gemm_phase<pg8::EpiGate<1>, pg8::StaticOrder, true, true>(lds, g, S, E, wave); }
        SEAM();
    }
    if (IN(4)) {
        pg8::Gemm g{MERGED, (const bf16*)(ws + WS_WOUT), MTOK, DM, DM}; pg8::StaticOrder S; S.init(MTOK, DM, G, (int)blockIdx.x);
        pg8::EpiResid E{P.x, (bf16*)(ws + WS_X1B), sumsq};
        pg8::gemm_phase<pg8::EpiResid, pg8::StaticOrder, true, true>(lds, g, S, E, wave);
        SEAM();
    }
    if (IN(5)) {
        pg8::Gemm g{(const bf16*)(ws + WS_X1B), (const bf16*)(ws + WS_WQ), MTOK, DM, DM}; pg8::StaticOrder S; S.init(MTOK, DM, G, (int)blockIdx.x);
        pg8::EpiRowScale E{(bf16*)(ws + WS_Q), sumsq};
        pg8::gemm_phase<pg8::EpiRowScale, pg8::StaticOrder, true, true>(lds, g, S, E, wave);
        SEAM();
    }
    if (IN(6)) {
        const int nit = (MTOK / 32 - (int)blockIdx.x + G - 1) / G;
        if (nit > 0) topk_part(P, lds, (int)blockIdx.x, wave, 0);
        __syncthreads();
#pragma unroll 1
        for (int k = 0; k < nit; ++k) {
            const int item = (int)blockIdx.x + k * G;
            peer_gather_u(P, lds, item * 32, wave, fresh_lane(), k & 1);
            if (wave < 4) { __builtin_amdgcn_s_setprio(2); peer_gather_v(P, lds, item * 32, wave); __builtin_amdgcn_s_setprio(0); if (k + 1 < nit) topk_part(P, lds, item + G, wave, (k + 1) & 1); }
            else { if (k + 1 < nit) topk_part(P, lds, item + G, wave, (k + 1) & 1); __builtin_amdgcn_s_setprio(2); peer_gather_v(P, lds, item * 32, wave); __builtin_amdgcn_s_setprio(0); }
            __syncthreads();
        }
    }
#undef IN
#undef SEAM
#undef SEAM0
}

extern "C" void kernel_launch(void* const* d_in, const int* in_sizes, int n_in, void* d_out, int out_size, void* d_ws, size_t ws_size, hipStream_t stream) {
    static int grid = 0;
    if (grid == 0) {
        if (n_in != 15 || in_sizes[0] != MTOK * DM || out_size != MTOK * DM || ws_size < WS_END) {
            fprintf(stderr, "kernel_launch: unexpected shapes (n_in %d, in0 %d, out %d, ws %zu); nothing launched\n", n_in, n_in > 0 ? in_sizes[0] : -1, out_size, ws_size); grid = -1; return; }
        int dev = 0, cus = 0, per_cu = 0;
        if (hipGetDevice(&dev) != hipSuccess || hipDeviceGetAttribute(&cus, hipDeviceAttributeMultiprocessorCount, dev) != hipSuccess) { fprintf(stderr, "kernel_launch: device query failed\n"); grid = -1; return; }
        if (hipFuncSetAttribute((const void*)mk_fwd, hipFuncAttributeMaxDynamicSharedMemorySize, LDS_BYTES) != hipSuccess) { fprintf(stderr, "kernel_launch: hipFuncSetAttribute failed\n"); grid = -1; return; }
        if (hipOccupancyMaxActiveBlocksPerMultiprocessor(&per_cu, (const void*)mk_fwd, NWAVES * 64, LDS_BYTES) != hipSuccess || per_cu < 1) { fprintf(stderr, "kernel_launch: occupancy query says %d blocks per CU\n", per_cu); per_cu = 1; }
        (void)hipGetLastError();
        grid = cus;
        fprintf(stderr, "kernel_launch: %d CUs, occupancy query %d per CU, grid %d\n", cus, per_cu, grid);
    }
    if (grid < 0) return;
    (void)hipMemsetAsync((char*)d_ws + WS_CTL, 0, CTL_ZERO_BYTES, stream);
    Params p{};
    p.x = (const float*)d_in[0]; p.norm1_g = (const float*)d_in[1]; p.w_in = (const float*)d_in[2]; p.hg_norm_g = (const float*)d_in[3]; p.hg_lb = (const float*)d_in[4];
    p.q_norm_g = (const float*)d_in[5]; p.k_norm_g = (const float*)d_in[6]; p.w_a = (const float*)d_in[7]; p.w_b = (const float*)d_in[8]; p.w_out = (const float*)d_in[9];
    p.norm2_g = (const float*)d_in[10]; p.peer_wq = (const float*)d_in[11]; p.peer_sk = (const float*)d_in[12]; p.peer_u = (const float*)d_in[13]; p.peer_v = (const float*)d_in[14];
    p.out = (float*)d_out; p.ws = (unsigned char*)d_ws;
#if MK_FUSED
    p.ph_lo = 0; p.ph_hi = NPHASE;
    void* args[] = {&p};
    hipError_t e = hipLaunchCooperativeKernel((const void*)mk_fwd, dim3(grid), dim3(NWAVES * 64), args, LDS_BYTES, stream);
    if (e != hipSuccess) fprintf(stderr, "kernel_launch: cooperative launch failed: %s (grid %d)\n", hipGetErrorString(e), grid);
#else
    for (int ph = 0; ph < 7; ++ph) { p.ph_lo = ph; p.ph_hi = ph + 1; hipLaunchKernelGGL(mk_fwd, dim3(grid), dim3(NWAVES * 64), LDS_BYTES, stream, p); }
#endif
}
```

```cpp
#include <hip/hip_runtime.h>
#include <hip/hip_cooperative_groups.h>
#include <cstdio>
#include <cstdint>
#include <cmath>
namespace cg = cooperative_groups;
#ifndef MK_FUSED
#define MK_FUSED 1
#endif
namespace pg8 {
#define PG8_LAS __attribute__((address_space(3)))
typedef unsigned short bf16_t;
typedef short bf16x8 __attribute__((ext_vector_type(8)));
typedef float f32x4 __attribute__((ext_vector_type(4)));
typedef unsigned u32x4 __attribute__((ext_vector_type(4)));
constexpr int BM = 256, BK = 64, HALF = 128, HTB = HALF * BK * 2  , STAGE_BYTES = 8 * HTB, NXCD = 8, WGM = 8;

__host__ __device__ __forceinline__ int lds_byte(int r, int c) { const int st = (r >> 4) * 2 + (c >> 5), rr = r & 15, cc = c & 31, ob = rr * 64 + cc * 2; return st * 1024 + (ob ^ (((ob >> 9) & 1) << 5)); }
__host__ __device__ __forceinline__ void stage_rc(int b, int& R, int& C) { const int st = b / 1024, sb = b % 1024, swz = sb ^ (((sb >> 9) & 1) << 5); R = (st >> 1) * 16 + swz / 64; C = (st & 1) * 32 + (swz % 64) / 2; }
__host__ __device__ __forceinline__ int perm32(int rho) { const int n = rho >> 4, i = rho & 15; return 8 * (i >> 2) + 4 * n + (i & 3); }

struct Unit { int pm, pn; };
struct Gemm { const bf16_t* A; const bf16_t* Bt; int M, N, K; };

struct StaticOrder {
    int nM, nN, nwg, G, c;
    __host__ __device__ void init(int M, int N, int G_, int c_) { nM = M / BM; nN = N / BM; nwg = nM * nN; G = G_; c = c_; }
    __host__ __device__ bool next(int i, Unit& u) const {
        const long L = (long)i * G + c; if (L >= nwg) return false;
        int wgid = (int)L; { const int q = nwg / NXCD, r = nwg % NXCD, xcd = wgid % NXCD, off = wgid / NXCD; wgid = (xcd < r ? xcd * (q + 1) : r * (q + 1) + (xcd - r) * q) + off; }
        const int nig = WGM * nN, gid = wgid / nig, fm = gid * WGM, gsz = (nM - fm) < WGM ? (nM - fm) : WGM;
        u.pm = fm + ((wgid % nig) % gsz); u.pn = (wgid % nig) / gsz; return true;
    }
    __device__ __forceinline__ void a_ready(const Unit&) const {}
    __device__ __forceinline__ void done(const Unit&) const {}
};

__device__ __forceinline__ unsigned cvt_pk_bf16(float lo, float hi) { unsigned r; asm volatile("v_cvt_pk_bf16_f32 %0, %1, %2" : "=v"(r) : "v"(lo), "v"(hi)); return r; }
typedef float f32x2 __attribute__((ext_vector_type(2)));
__device__ __forceinline__ f32x2 gelu_pk(f32x2 v) {
    const f32x2 av = __builtin_elementwise_abs(v), d = av * 0.2316418882f + 1.0f;
    f32x2 t; t.x = __builtin_amdgcn_rcpf(d.x); t.y = __builtin_amdgcn_rcpf(d.y);
    f32x2 q = t * 0.5307027145f + (-0.7265760135f); q = q * t + 0.7107068705f; q = q * t + (-0.142248368f); q = q * t + 0.127414796f; q = q * t;
    const f32x2 s = (v * v) * (-0.72134752044f);
    f32x2 e; e.x = __builtin_amdgcn_exp2f(s.x); e.y = __builtin_amdgcn_exp2f(s.y);
    const f32x2 m = v * (q * e), r = v - m;
    f32x2 o; o.x = v.x < 0.f ? m.x : r.x; o.y = v.y < 0.f ? m.y : r.y; return o;
}

template <int ACT  > struct EpiBf16 {
    static constexpr bool PERM = true, AFTER_DRAIN = false; static_assert(ACT == 0 || ACT == 1, "EpiBf16: ACT is 0 (none) or 1 (gelu_pk)");
    bf16_t* O; int ldc; const float* bias; int split_cols; size_t split_stride; float scale0;
    __device__ __forceinline__ void operator()(const f32x4 (&acc)[2][2][4][2], const Unit& u, int wr, int wc, int fr, int fq) const {
        const int row0 = u.pm * BM + wr * 64 + fr; int colt = u.pn * BM; bf16_t* base = O;
        float sc = 1.f; if (split_cols) { const int t = colt / split_cols; base += (size_t)t * split_stride; colt -= t * split_cols; if (t == 0) sc = scale0; }
        const int col0 = colt + wc * 32 + 8 * fq, bcol0 = u.pn * BM + wc * 32 + 8 * fq;
        f32x4 bv[2][2];
#pragma unroll
        for (int bj = 0; bj < 2; ++bj)
#pragma unroll
            for (int n = 0; n < 2; ++n) bv[bj][n] = bias ? *(const f32x4*)(bias + bcol0 + bj * HALF + 4 * n) : (f32x4){0.f, 0.f, 0.f, 0.f};
#pragma unroll
        for (int ai = 0; ai < 2; ++ai)
#pragma unroll
            for (int m = 0; m < 4; ++m) { bf16_t* rowp = base + (size_t)(row0 + ai * HALF + m * 16) * ldc + col0;
#pragma unroll
                for (int bj = 0; bj < 2; ++bj) { f32x4 v0 = acc[ai][bj][m][0] + bv[bj][0], v1 = acc[ai][bj][m][1] + bv[bj][1];
                    if (ACT == 1) { f32x2 a = gelu_pk((f32x2){v0[0], v0[1]}), b = gelu_pk((f32x2){v0[2], v0[3]}), c = gelu_pk((f32x2){v1[0], v1[1]}), d = gelu_pk((f32x2){v1[2], v1[3]});
                        v0 = (f32x4){a.x, a.y, b.x, b.y}; v1 = (f32x4){c.x, c.y, d.x, d.y}; }
                    v0 = v0 * sc; v1 = v1 * sc; u32x4 w; w.x = cvt_pk_bf16(v0[0], v0[1]); w.y = cvt_pk_bf16(v0[2], v0[3]); w.z = cvt_pk_bf16(v1[0], v1[1]); w.w = cvt_pk_bf16(v1[2], v1[3]);
                    *(u32x4*)(rowp + bj * HALF) = w; } }
    }
};

__device__ __forceinline__ float bf2f(unsigned short b) { return __builtin_bit_cast(float, (unsigned)b << 16); }
__device__ __forceinline__ float bflo(unsigned w) { return __builtin_bit_cast(float, w << 16); }
__device__ __forceinline__ float bfhi(unsigned w) { return __builtin_bit_cast(float, w & 0xffff0000u); }
__device__ __forceinline__ float sigmoidf_(float v) { return __builtin_amdgcn_rcpf(1.0f + __expf(-v)); }
constexpr int PROJ_LD = 6400;
constexpr float NORM_EPS_ = 1e-6f;
constexpr float QSCALE = 0.125f * 1.4426950408889634f;

struct EpiProj {
    static constexpr bool PERM = true, AFTER_DRAIN = false;
    bf16_t* O; const float* lbl; const float* gq; const float* gk; const float* sxn; const float* sw; bf16_t* KIO;
    __device__ __forceinline__ void operator()(const f32x4 (&acc)[2][2][4][2], const Unit& u, int wr, int wc, int fr, int fq) const {
        const int pn = u.pn;
        int type;
        if (pn < 2) type = 1; else if (pn < 4) type = 2; else if (pn < 6) type = 0; else if (pn < 8) type = 3; else if (pn < 11) type = 4; else if (pn < 14) type = 5; else if (pn < 17) type = 0; else type = 1;
        const int row0 = u.pm * BM + wr * 64 + fr;
        const int colL0 = pn * BM + wc * 64 + 8 * fq;
        float aux[2][8];
#pragma unroll
        for (int bj = 0; bj < 2; ++bj)
#pragma unroll
            for (int e = 0; e < 8; ++e) aux[bj][e] = 1.0f;
        if (type == 2) {
#pragma unroll
            for (int bj = 0; bj < 2; ++bj)
#pragma unroll
                for (int e = 0; e < 8; ++e) { const int c = colL0 + 32 * bj + e - 512; aux[bj][e] = sigmoidf_(lbl[c] - lbl[512 + c]); }
        } else if (type == 4 || type == 5) {
            const float* g = (type == 4) ? gq : gk; const float sc = (type == 4) ? QSCALE : 1.0f;
#pragma unroll
            for (int bj = 0; bj < 2; ++bj)
#pragma unroll
                for (int e = 0; e < 8; ++e) aux[bj][e] = g[32 * bj + 8 * fq + e] * sc;
        }
        float swv[2][8];
#pragma unroll
        for (int bj = 0; bj < 2; ++bj)
#pragma unroll
            for (int e = 0; e < 8; ++e) swv[bj][e] = sw[pn * BM + bj * HALF + wc * 32 + 8 * fq + e];
        float carry[2][8];
#pragma unroll
        for (int bj = 0; bj < 2; ++bj)
#pragma unroll
            for (int e = 0; e < 8; ++e) carry[bj][e] = 0.f;
        float rscv[8];
#pragma unroll
        for (int q = 0; q < 8; ++q) rscv[q] = sxn[row0 + (q >> 2) * HALF + (q & 3) * 16];
        asm volatile("" ::: "memory");
#pragma unroll
        for (int ai = 0; ai < 2; ++ai)
#pragma unroll
            for (int m = 0; m < 4; ++m) {
                const float rsc = rscv[4 * ai + m];
                float v[2][8];
#pragma unroll
                for (int bj = 0; bj < 2; ++bj)
#pragma unroll
                    for (int n = 0; n < 2; ++n) { typedef int i32x4_ __attribute__((ext_vector_type(4))); const i32x4_ iv = __builtin_bit_cast(i32x4_, acc[ai][bj][m][n]);
#pragma unroll
                        for (int i = 0; i < 4; ++i) v[bj][4 * n + i] = (float)iv[i] * (rsc * swv[bj][4 * n + i]); }
                if (type == 1) {
#pragma unroll
                    for (int bj = 0; bj < 2; ++bj)
#pragma unroll
                        for (int e = 0; e < 8; ++e) v[bj][e] = sigmoidf_(v[bj][e]);
                } else if (type == 2) {
                    float ki[2][8];
#pragma unroll
                    for (int bj = 0; bj < 2; ++bj)
#pragma unroll
                        for (int e = 0; e < 8; ++e) { const float lb = aux[bj][e]; const float ex = fminf(__expf(-v[bj][e]), 1e30f), sg = __builtin_amdgcn_rcpf(1.0f + ex);
                            const float f = lb + (1.0f - lb) * sg, kk = (1.0f - lb) * (ex * sg);
                            float g = __builtin_amdgcn_logf(f);
                            g += __builtin_bit_cast(float, __builtin_amdgcn_update_dpp(0, __builtin_bit_cast(int, g), 0x111, 0xf, 0xf, true));
                            g += __builtin_bit_cast(float, __builtin_amdgcn_update_dpp(0, __builtin_bit_cast(int, g), 0x112, 0xf, 0xf, true));
                            g += __builtin_bit_cast(float, __builtin_amdgcn_update_dpp(0, __builtin_bit_cast(int, g), 0x114, 0xf, 0xf, true));
                            g += __builtin_bit_cast(float, __builtin_amdgcn_update_dpp(0, __builtin_bit_cast(int, g), 0x118, 0xf, 0xf, true));
                            if (m > 0) g += carry[bj][e];
                            if (m < 3) carry[bj][e] = __shfl(g, 16 * fq + 15);
                            v[bj][e] = __builtin_amdgcn_exp2f(g); ki[bj][e] = kk * __builtin_amdgcn_exp2f(-g); }
                    bf16_t* kp = KIO + (size_t)(row0 + ai * HALF + m * 16) * 512 + (colL0 - 512);
#pragma unroll
                    for (int bj = 0; bj < 2; ++bj) { u32x4 w; w.x = cvt_pk_bf16(ki[bj][0], ki[bj][1]); w.y = cvt_pk_bf16(ki[bj][2], ki[bj][3]); w.z = cvt_pk_bf16(ki[bj][4], ki[bj][5]); w.w = cvt_pk_bf16(ki[bj][6], ki[bj][7]);
                        *(u32x4*)(kp + 32 * bj) = w; }
                } else if (type == 3) {
#pragma unroll
                    for (int bj = 0; bj < 2; ++bj)
#pragma unroll
                        for (int e = 0; e < 8; ++e) v[bj][e] = v[bj][e] * sigmoidf_(v[bj][e]);
                } else if (type >= 4) {
                    float ss = 0.f;
#pragma unroll
                    for (int bj = 0; bj < 2; ++bj)
#pragma unroll
                        for (int e = 0; e < 8; ++e) ss += v[bj][e] * v[bj][e];
                    ss += __shfl_xor(ss, 16); ss += __shfl_xor(ss, 32);
                    const float rs = rsqrtf(ss * (1.0f / 64.0f) + NORM_EPS_);
#pragma unroll
                    for (int bj = 0; bj < 2; ++bj)
#pragma unroll
                        for (int e = 0; e < 8; ++e) v[bj][e] = v[bj][e] * rs * aux[bj][e];
                }
                bf16_t* rowp = O + (size_t)(row0 + ai * HALF + m * 16) * PROJ_LD + colL0;
#pragma unroll
                for (int bj = 0; bj < 2; ++bj) { u32x4 w; w.x = cvt_pk_bf16(v[bj][0], v[bj][1]); w.y = cvt_pk_bf16(v[bj][2], v[bj][3]); w.z = cvt_pk_bf16(v[bj][4], v[bj][5]); w.w = cvt_pk_bf16(v[bj][6], v[bj][7]);
                    *(u32x4*)(rowp + 32 * bj) = w; }
            }
    }
};

template <int SECOND> struct EpiGate {
    static constexpr bool PERM = true, AFTER_DRAIN = false;
    bf16_t* O; const bf16_t* gate;
    __device__ __forceinline__ void operator()(const f32x4 (&acc)[2][2][4][2], const Unit& u, int wr, int wc, int fr, int fq) const {
        const int row0 = u.pm * BM + wr * 64 + fr; const int col0 = u.pn * BM + wc * 32 + 8 * fq;
#pragma unroll
        for (int ai = 0; ai < 2; ++ai)
#pragma unroll
            for (int m = 0; m < 4; ++m) { const size_t r = (size_t)(row0 + ai * HALF + m * 16);
#pragma unroll
                for (int bj = 0; bj < 2; ++bj) { const int c = col0 + bj * HALF;
                    const u32x4 gw = *(const u32x4*)(gate + r * PROJ_LD + c);
                    float v[8];
#pragma unroll
                    for (int n = 0; n < 2; ++n)
#pragma unroll
                        for (int i = 0; i < 4; ++i) v[4 * n + i] = acc[ai][bj][m][n][i];
                    v[0] *= bflo(gw.x); v[1] *= bfhi(gw.x); v[2] *= bflo(gw.y); v[3] *= bfhi(gw.y); v[4] *= bflo(gw.z); v[5] *= bfhi(gw.z); v[6] *= bflo(gw.w); v[7] *= bfhi(gw.w);
                    if (SECOND) { const u32x4 tw = *(const u32x4*)(O + r * 1024 + c);
                        v[0] += bflo(tw.x); v[1] += bfhi(tw.x); v[2] += bflo(tw.y); v[3] += bfhi(tw.y); v[4] += bflo(tw.z); v[5] += bfhi(tw.z); v[6] += bflo(tw.w); v[7] += bfhi(tw.w); }
                    u32x4 w; w.x = cvt_pk_bf16(v[0], v[1]); w.y = cvt_pk_bf16(v[2], v[3]); w.z = cvt_pk_bf16(v[4], v[5]); w.w = cvt_pk_bf16(v[6], v[7]);
                    *(u32x4*)(O + r * 1024 + c) = w; asm volatile("" ::: "memory"); } }
    }
};

struct EpiResid {
    static constexpr bool PERM = true, AFTER_DRAIN = false;
    const float* X; bf16_t* X1B; float* sumsq;
    __device__ __forceinline__ void operator()(const f32x4 (&acc)[2][2][4][2], const Unit& u, int wr, int wc, int fr, int fq) const {
        const int row0 = u.pm * BM + wr * 64 + fr; const int col0 = u.pn * BM + wc * 32 + 8 * fq;
        f32x4 xv[2][8];
#define ER_LOAD(g_, buf_) do { _Pragma("unroll") for (int j = 0; j < 4; ++j) { const int ai = (g_) >> 1, m = 2 * ((g_) & 1) + (j >> 1), bj = j & 1; const size_t off = (size_t)(row0 + ai * HALF + m * 16) * 1024 + col0 + bj * HALF; \
            xv[buf_][2 * j] = *(const f32x4*)(X + off); xv[buf_][2 * j + 1] = *(const f32x4*)(X + off + 4); } } while (0)
        ER_LOAD(0, 0);
#pragma unroll
        for (int g = 0; g < 4; ++g) {
            if (g + 1 < 4) ER_LOAD(g + 1, (g + 1) & 1);
#pragma unroll
            for (int mm = 0; mm < 2; ++mm) { const int ai = g >> 1, m = 2 * (g & 1) + mm; const size_t r = (size_t)(row0 + ai * HALF + m * 16); float ss = 0.f;
#pragma unroll
                for (int bj = 0; bj < 2; ++bj) { const size_t off = r * 1024 + col0 + bj * HALF; const int j = 2 * mm + bj;
                    const f32x4 v0 = acc[ai][bj][m][0] + xv[g & 1][2 * j], v1 = acc[ai][bj][m][1] + xv[g & 1][2 * j + 1];
                    ss += (v0[0] * v0[0] + v0[1] * v0[1]) + (v0[2] * v0[2] + v0[3] * v0[3]) + (v1[0] * v1[0] + v1[1] * v1[1]) + (v1[2] * v1[2] + v1[3] * v1[3]);
                    u32x4 w; w.x = cvt_pk_bf16(v0[0], v0[1]); w.y = cvt_pk_bf16(v0[2], v0[3]); w.z = cvt_pk_bf16(v1[0], v1[1]); w.w = cvt_pk_bf16(v1[2], v1[3]);
                    *(u32x4*)(X1B + off) = w; }
                ss += __shfl_xor(ss, 16); ss += __shfl_xor(ss, 32);
                if (fq == 0) atomicAdd(sumsq + r, ss); }
            asm volatile("" ::: "memory");
        }
#undef ER_LOAD
    }
};

struct EpiRowScale {
    static constexpr bool PERM = true, AFTER_DRAIN = false;
    bf16_t* O; const float* sumsq;
    __device__ __forceinline__ void operator()(const f32x4 (&acc)[2][2][4][2], const Unit& u, int wr, int wc, int fr, int fq) const {
        const int row0 = u.pm * BM + wr * 64 + fr; const int col0 = u.pn * BM + wc * 32 + 8 * fq;
        float sq[8];
#pragma unroll
        for (int q = 0; q < 8; ++q) sq[q] = __hip_atomic_load(sumsq + (size_t)(row0 + (q >> 2) * HALF + (q & 3) * 16), __ATOMIC_RELAXED, __HIP_MEMORY_SCOPE_AGENT);
        asm volatile("" ::: "memory");
#pragma unroll
        for (int ai = 0; ai < 2; ++ai)
#pragma unroll
            for (int m = 0; m < 4; ++m) { const size_t r = (size_t)(row0 + ai * HALF + m * 16);
                const float rs = rsqrtf(sq[4 * ai + m] * (1.0f / 1024.0f) + NORM_EPS_);
#pragma unroll
                for (int bj = 0; bj < 2; ++bj) { const f32x4 v0 = acc[ai][bj][m][0] * rs, v1 = acc[ai][bj][m][1] * rs;
                    u32x4 w; w.x = cvt_pk_bf16(v0[0], v0[1]); w.y = cvt_pk_bf16(v0[2], v0[3]); w.z = cvt_pk_bf16(v1[0], v1[1]); w.w = cvt_pk_bf16(v1[2], v1[3]);
                    *(u32x4*)(O + r * 1024 + col0 + bj * HALF) = w; } }
    }
};
template <class Epi, class Sched, bool ALIGN_EPI = false, bool SP2 = false, bool I8 = false>
__device__ __forceinline__ void gemm_phase(PG8_LAS unsigned char* lds, const Gemm g, const Sched& S, const Epi& E, const int wid  ) {
    int lane; asm volatile("v_mbcnt_lo_u32_b32 %0, -1, 0\n\tv_mbcnt_hi_u32_b32 %0, -1, %0" : "=v"(lane));
    const int tid = wid * 64 + lane, wr = wid >> 2, wc = wid & 3, fr = lane & 15, fq = lane >> 4;
    const int K = g.K, nt = K / BK;
    unsigned voffA[2], voffB[2];
#pragma unroll
    for (int i = 0; i < 2; ++i) { int R, C; stage_rc(tid * 16 + i * 8192, R, C); const int Rb = Epi::PERM ? ((R & ~31) + perm32(R & 31)) : R;
        voffA[i] = (unsigned)(R * K + C) * 2u; voffB[i] = (unsigned)(Rb * K + C) * 2u; }
    const size_t kstep = (size_t)(BK * 2);
    const size_t hstep = (size_t)HALF * K * 2;
    const size_t tstep = 2 * hstep;
    const unsigned ldsw = (unsigned)wid * 1024u;
    const int aoff = lds_byte(wr * 64 + fr, fq * 8), boff = lds_byte(wc * 32 + fr, fq * 8);
#define PG8_SA(b, h) (((b) * 2 + (h)) * HTB)
#define PG8_SB(b, h) ((4 + (b) * 2 + (h)) * HTB)
#define PG8_STAGE(bufoff, gbase, voff) do { _Pragma("unroll") for (int _i = 0; _i < 2; ++_i) \
        __builtin_amdgcn_global_load_lds((const unsigned*)((const char*)(gbase) + (voff)[_i]), (PG8_LAS unsigned*)(lds + (bufoff) + ldsw + _i * 8192), 16, 0, 0); } while (0)
#define PG8_LDA(dst, b, h) do { _Pragma("unroll") for (int m = 0; m < 4; ++m) _Pragma("unroll") for (int k = 0; k < 2; ++k) dst[m][k] = *(const PG8_LAS bf16x8*)(lds + PG8_SA(b, h) + aoff + m * 2048 + k * 1024); } while (0)
#define PG8_LDB(dst, b, h) do { _Pragma("unroll") for (int n = 0; n < 2; ++n) _Pragma("unroll") for (int k = 0; k < 2; ++k) dst[n][k] = *(const PG8_LAS bf16x8*)(lds + PG8_SB(b, h) + boff + n * 2048 + k * 1024); } while (0)
#define PG8_MMA(ai, bj, At, Bt) do { __builtin_amdgcn_s_setprio(1); _Pragma("unroll") for (int m = 0; m < 4; ++m) _Pragma("unroll") for (int n = 0; n < 2; ++n) _Pragma("unroll") for (int k = 0; k < 2; ++k) \
        { if constexpr (I8) { typedef int i32x4_ __attribute__((ext_vector_type(4))); acc[ai][bj][m][n] = __builtin_bit_cast(f32x4, __builtin_amdgcn_mfma_i32_16x16x64_i8(__builtin_bit_cast(i32x4_, Bt[n][k]), __builtin_bit_cast(i32x4_, At[m][k]), __builtin_bit_cast(i32x4_, acc[ai][bj][m][n]), 0, 0, 0)); } \
          else acc[ai][bj][m][n] = __builtin_amdgcn_mfma_f32_16x16x32_bf16(Bt[n][k], At[m][k], acc[ai][bj][m][n], 0, 0, 0); } __builtin_amdgcn_s_setprio(0); } while (0)
#define PG8_WAIT_V(n) asm volatile("s_waitcnt vmcnt(" #n ")" ::: "memory")
#define PG8_WAIT_L(n) asm volatile("s_waitcnt lgkmcnt(" #n ")" ::: "memory")
#define PG8_BAR __builtin_amdgcn_s_barrier()
#define PG8_SCHED __builtin_amdgcn_sched_barrier(0)
    Unit cur, nxt; int ui = 0;
    if (!S.next(0, cur)) return;
    f32x4 acc[2][2][4][2];
#pragma unroll
    for (int a = 0; a < 2; ++a)
#pragma unroll
        for (int b = 0; b < 2; ++b)
#pragma unroll
            for (int m = 0; m < 4; ++m)
#pragma unroll
                for (int n = 0; n < 2; ++n) acc[a][b][m][n] = (f32x4){0.f, 0.f, 0.f, 0.f};
    bf16x8 At[4][2], B0[2][2], B1[2][2];
    const char* cA = (const char*)g.A + (size_t)cur.pm * tstep; const char* cB = (const char*)g.Bt + (size_t)cur.pn * tstep;
    S.a_ready(cur);
    if constexpr (SP2) {
        PG8_STAGE(PG8_SB(0, 0), cB, voffB); PG8_STAGE(PG8_SB(0, 1), cB + hstep, voffB); PG8_STAGE(PG8_SA(0, 0), cA, voffA); PG8_STAGE(PG8_SA(0, 1), cA + hstep, voffA);
        if (wr == 1) PG8_BAR;
        PG8_WAIT_V(2); PG8_BAR;
        PG8_STAGE(PG8_SB(1, 0), cB + kstep, voffB); PG8_STAGE(PG8_SA(1, 0), cA + kstep, voffA); PG8_STAGE(PG8_SB(1, 1), cB + hstep + kstep, voffB);
        PG8_WAIT_V(6); PG8_BAR;
    } else {
        PG8_STAGE(PG8_SB(0, 0), cB, voffB); PG8_STAGE(PG8_SA(0, 0), cA, voffA); PG8_STAGE(PG8_SB(0, 1), cB + hstep, voffB); PG8_STAGE(PG8_SA(0, 1), cA + hstep, voffA);
        if (wr == 1) PG8_BAR;
        PG8_WAIT_V(4); PG8_BAR;
        PG8_STAGE(PG8_SB(1, 0), cB + kstep, voffB); PG8_STAGE(PG8_SA(1, 0), cA + kstep, voffA); PG8_STAGE(PG8_SB(1, 1), cB + hstep + kstep, voffB);
        PG8_WAIT_V(6); PG8_BAR;
    }
    for (;;) {
        const bool has_next = S.next(ui + 1, nxt);
        const char* nA = has_next ? (const char*)g.A + (size_t)nxt.pm * tstep : cA; const char* nB = has_next ? (const char*)g.Bt + (size_t)nxt.pn * tstep : cB;
        for (int t = 0; t < nt; t += 2) {
            const bool last = (t == nt - 2);
            const char* a1 = cA + (size_t)(t + 1) * kstep;
            const char* a2 = last ? nA : cA + (size_t)(t + 2) * kstep; const char* b2 = last ? nB : cB + (size_t)(t + 2) * kstep;
            const char* a3 = a2 + kstep; const char* b3 = b2 + kstep;
            if (last && has_next) S.a_ready(nxt);
            if constexpr (SP2) {
            PG8_LDB(B0, 0, 0); PG8_LDB(B1, 0, 1); PG8_SCHED; PG8_LDA(At, 0, 0); PG8_STAGE(PG8_SA(1, 1), a1 + hstep, voffA);
            PG8_WAIT_V(8); PG8_WAIT_L(0); PG8_BAR; PG8_MMA(0, 0, At, B0); PG8_MMA(0, 1, At, B1); PG8_BAR; PG8_SCHED;
            PG8_LDA(At, 0, 1); PG8_STAGE(PG8_SB(0, 0), b2, voffB); PG8_STAGE(PG8_SB(0, 1), b2 + hstep, voffB); PG8_STAGE(PG8_SA(0, 0), a2, voffA);
            PG8_WAIT_V(8); PG8_WAIT_L(0); PG8_BAR; PG8_MMA(1, 0, At, B0); PG8_MMA(1, 1, At, B1); PG8_BAR; PG8_SCHED;
            PG8_LDB(B0, 1, 0); PG8_LDB(B1, 1, 1); PG8_SCHED; PG8_LDA(At, 1, 0); PG8_STAGE(PG8_SA(0, 1), a2 + hstep, voffA);
            PG8_WAIT_V(8); PG8_WAIT_L(0); PG8_BAR; PG8_MMA(0, 0, At, B0); PG8_MMA(0, 1, At, B1); PG8_BAR; PG8_SCHED;
            PG8_LDA(At, 1, 1); PG8_STAGE(PG8_SB(1, 0), b3, voffB); PG8_STAGE(PG8_SB(1, 1), b3 + hstep, voffB); PG8_STAGE(PG8_SA(1, 0), a3, voffA);
            PG8_WAIT_V(8); PG8_WAIT_L(0); PG8_BAR; PG8_MMA(1, 0, At, B0); PG8_MMA(1, 1, At, B1); PG8_BAR; PG8_SCHED;
            } else {
            PG8_LDB(B0, 0, 0); PG8_SCHED; PG8_LDA(At, 0, 0); PG8_STAGE(PG8_SA(1, 1), a1 + hstep, voffA);
            PG8_WAIT_L(8); PG8_BAR; PG8_WAIT_L(0); PG8_MMA(0, 0, At, B0); PG8_BAR; PG8_SCHED;
            PG8_LDB(B1, 0, 1); PG8_STAGE(PG8_SB(0, 0), b2, voffB);
            PG8_BAR; PG8_WAIT_L(0); PG8_MMA(0, 1, At, B1); PG8_BAR;
            PG8_LDA(At, 0, 1); PG8_STAGE(PG8_SA(0, 0), a2, voffA);
            PG8_BAR; PG8_WAIT_L(0); PG8_MMA(1, 0, At, B0); PG8_BAR; PG8_SCHED;
            PG8_STAGE(PG8_SB(0, 1), b2 + hstep, voffB);
            PG8_WAIT_V(6); PG8_BAR; PG8_MMA(1, 1, At, B1); PG8_BAR;
            PG8_LDB(B0, 1, 0); PG8_SCHED; PG8_LDA(At, 1, 0); PG8_STAGE(PG8_SA(0, 1), a2 + hstep, voffA);
            PG8_WAIT_L(8); PG8_BAR; PG8_WAIT_L(0); PG8_MMA(0, 0, At, B0); PG8_BAR; PG8_SCHED;
            PG8_LDB(B1, 1, 1); PG8_STAGE(PG8_SB(1, 0), b3, voffB);
            PG8_BAR; PG8_WAIT_L(0); PG8_MMA(0, 1, At, B1); PG8_BAR;
            PG8_LDA(At, 1, 1); PG8_STAGE(PG8_SA(1, 0), a3, voffA);
            PG8_BAR; PG8_WAIT_L(0); PG8_MMA(1, 0, At, B0); PG8_BAR; PG8_SCHED;
            PG8_STAGE(PG8_SB(1, 1), b3 + hstep, voffB);
            PG8_WAIT_V(6); PG8_BAR; PG8_MMA(1, 1, At, B1); PG8_BAR;
            }
        }
        if constexpr (ALIGN_EPI) { if (wr == 0) PG8_BAR; }
        if constexpr (!Epi::AFTER_DRAIN) { E(acc, cur, wr, wc, fr, fq); S.done(cur); }
        if (!has_next) break;
#pragma unroll
        for (int a = 0; a < 2; ++a)
#pragma unroll
            for (int b = 0; b < 2; ++b)
#pragma unroll
                for (int m = 0; m < 4; ++m)
#pragma unroll
                    for (int n = 0; n < 2; ++n) acc[a][b][m][n] = (f32x4){0.f, 0.f, 0.f, 0.f};
        cur = nxt; cA = nA; cB = nB; ++ui;
        if constexpr (ALIGN_EPI) { if (wr == 1) PG8_BAR; }
    }
    PG8_WAIT_V(0);
    if constexpr (!ALIGN_EPI) { if (wr == 0) PG8_BAR; }
    PG8_BAR;
    if constexpr (Epi::AFTER_DRAIN) { E.fused(acc, cur, wr, wc, fr, fq, lds, wid, lane); S.done(cur); }
#undef PG8_SA
#undef PG8_SB
#undef PG8_STAGE
#undef PG8_LDA
#undef PG8_LDB
#undef PG8_MMA
#undef PG8_WAIT_V
#undef PG8_WAIT_L
#undef PG8_BAR
#undef PG8_SCHED
}
}

#define GAS __attribute__((address_space(1)))
#define LAS __attribute__((address_space(3)))
typedef unsigned short bf16;
typedef unsigned v4u __attribute__((ext_vector_type(4)));
typedef float f32x4 __attribute__((ext_vector_type(4)));
typedef float f32x16 __attribute__((ext_vector_type(16)));
typedef short bf16x8 __attribute__((ext_vector_type(8)));
#define LDS_WAIT() asm volatile("s_waitcnt lgkmcnt(0)" ::: "memory")
#define VM_WAIT() asm volatile("s_waitcnt vmcnt(0)" ::: "memory")

constexpr int NWAVES = 8;
constexpr int BATCH = 16, SEQ = 2048, DM = 1024, MTOK = BATCH * SEQ, NIN = 6400;
constexpr int NEXP = 16384;
constexpr float EPS = 1e-6f;
constexpr size_t MiB = 1u << 20;
constexpr size_t WS_CTL = 0, CTL_ZERO_BYTES = 1 * MiB;
constexpr size_t WS_SUMSQ = 512 * 1024;
constexpr size_t WS_WIN = 1 * MiB, WS_WA = 14 * MiB, WS_WB = 15 * MiB, WS_WOUT = 16 * MiB, WS_WQ = 18 * MiB, WS_SK = 20 * MiB;
constexpr size_t WS_U = 24 * MiB, WS_V = 56 * MiB;
constexpr size_t WS_SXN = 22 * MiB, WS_SW = 22 * MiB + 262144;
constexpr size_t WS_CMAX = 65536;
constexpr size_t WS_SU = 21 * MiB;
constexpr size_t WS_PROJ = 88 * MiB;
constexpr size_t WS_X1F = 88 * MiB, WS_X1B = 216 * MiB, WS_Q = 280 * MiB;
constexpr size_t WS_END = 488 * MiB;
constexpr size_t OUT_XN = 0, OUT_MERGED = 0, OUT_KI = 32 * MiB, OUT_YA = 64 * MiB, OUT_YB = 96 * MiB;
constexpr int LDS_CTL = 155648, LDS_BYTES = LDS_CTL + 1024;

__device__ __forceinline__ unsigned pk2(float lo, float hi) { typedef __bf16 b2_ __attribute__((ext_vector_type(2))); typedef float f2_ __attribute__((ext_vector_type(2))); f2_ v = {lo, hi}; return __builtin_bit_cast(unsigned, __builtin_convertvector(v, b2_)); }
__device__ __forceinline__ unsigned f2bf(float f) { return pk2(f, 0.f) & 0xffffu; }
__device__ __forceinline__ float bf2f_(unsigned short b) { return __builtin_bit_cast(float, (unsigned)b << 16); }
__device__ __forceinline__ float wave_sum(float v) {
#pragma unroll
    for (int o = 1; o < 64; o <<= 1) v += __shfl_xor(v, o);
    return v;
}

__device__ __forceinline__ int fresh_lane() { int l; asm volatile("v_mbcnt_lo_u32_b32 %0, -1, 0\n\tv_mbcnt_hi_u32_b32 %0, -1, %0" : "=v"(l)); return l; }

#define XB_TMO      128
#define XB_XCNT(j)  (256  + 64 * (j))
#define XB_XSUB(j)  (1280 + 64 * (j))
#define XB_XGEN(j)  (2304 + 64 * (j))
#define XB_TOP      3328
#define XB_TOPGEN   3392
#define XCD_BAR_WORDS 3456
#define XB_SPIN_CAP (1u << 23)
__device__ __forceinline__ unsigned xb_ld(unsigned* p)              { return __hip_atomic_load(p, __ATOMIC_RELAXED, __HIP_MEMORY_SCOPE_AGENT); }
__device__ __forceinline__ unsigned xb_add(unsigned* p, unsigned v) { return __hip_atomic_fetch_add(p, v, __ATOMIC_RELAXED, __HIP_MEMORY_SCOPE_AGENT); }
__device__ __forceinline__ unsigned xb_xcc_id() { return (unsigned)__builtin_amdgcn_s_getreg((3 << 11) | 20) & 0xFu; }
#define XB_SPIN(cond, bar) do { unsigned _sp = 0; while (cond) { __builtin_amdgcn_s_sleep(1); \
    if ((++_sp & 255u) == 0u) { if (xb_ld(&(bar)[XB_TMO])) break; if (_sp > XB_SPIN_CAP) { atomicAdd(&(bar)[XB_TMO], 1u); break; } } } } while (0)
struct XcdBarrier { unsigned* bar; unsigned x; volatile LAS unsigned* st; };
__device__ __forceinline__ XcdBarrier xcd_barrier_post(unsigned* bar, volatile LAS unsigned* st, int tid) {
    XcdBarrier b; b.bar = bar; b.x = xb_xcc_id(); b.st = st;
    if (tid == 0) (void)xb_add(&bar[XB_XCNT(b.x)], 1u);
    return b;
}
__device__ __forceinline__ void xcd_barrier_complete(unsigned* bar, unsigned x, unsigned& nloc, unsigned& nx) {
    const unsigned G = gridDim.x;
    unsigned sum, cnt, mine, sp = 0u;
    for (;;) {
        sum = 0u; cnt = 0u; mine = 0u;
#pragma unroll
        for (unsigned j = 0; j < 16; ++j) { const unsigned c = xb_ld(&bar[XB_XCNT(j)]); sum += c; cnt += (c > 0u) ? 1u : 0u; mine = (j == x) ? c : mine; }
        if (sum == G) break;
        __builtin_amdgcn_s_sleep(1);
        if ((++sp & 255u) == 0u) { if (xb_ld(&bar[XB_TMO])) break; if (sp > XB_SPIN_CAP) { atomicAdd(&bar[XB_TMO], 1u); break; } }
    }
    nloc = mine > 0u ? mine : 1u; nx = cnt > 0u ? cnt : 1u;
}
__device__ __forceinline__ void xcd_barrier(const XcdBarrier& b, int tid) {
    asm volatile("s_waitcnt vmcnt(0)" ::: "memory");
    __syncthreads();
    if (tid == 0) {
        unsigned* bar = b.bar;
        __builtin_amdgcn_s_waitcnt(0);
        unsigned nloc = b.st[0], nx = b.st[1];
        if (nloc == 0u) { xcd_barrier_complete(bar, b.x, nloc, nx); b.st[0] = nloc; b.st[1] = nx; }
        const unsigned old = xb_add(&bar[XB_XSUB(b.x)], 1u);
        const unsigned gen = old / nloc;
        if (old + 1u == (gen + 1u) * nloc) {
            __builtin_amdgcn_fence(__ATOMIC_RELEASE, "agent");
            asm volatile("s_waitcnt vmcnt(0)" ::: "memory");
            const unsigned og = xb_add(&bar[XB_TOP], 1u);
            const unsigned tg = og / nx;
            if (og + 1u == (tg + 1u) * nx) xb_add(&bar[XB_TOPGEN], 1u);
            else XB_SPIN(xb_ld(&bar[XB_TOPGEN]) == tg, bar);
            __builtin_amdgcn_fence(__ATOMIC_ACQUIRE, "agent");
            xb_add(&bar[XB_XGEN(b.x)], 1u);
            asm volatile("s_waitcnt vmcnt(0)" ::: "memory");
        } else {
            XB_SPIN(xb_ld(&bar[XB_XGEN(b.x)]) == gen, bar);
            __builtin_amdgcn_fence(__ATOMIC_ACQUIRE, "agent");
            asm volatile("s_waitcnt vmcnt(0)" ::: "memory");
        }
    }
    __syncthreads();
}

struct Params {
    const float* x; const float* norm1_g; const float* w_in; const float* hg_norm_g; const float* hg_lb; const float* q_norm_g; const float* k_norm_g;
    const float* w_a; const float* w_b; const float* w_out; const float* norm2_g; const float* peer_wq; const float* peer_sk; const float* peer_u; const float* peer_v;
    float* out; unsigned char* ws; int ph_lo, ph_hi;
};

__device__ __forceinline__ void p0_transpose_item(const float* W, int K, int N, const float* gk, bool permute, bf16* WT, LAS float* scr, int item, int lane) {
    const int nblk = N / 32, kb = item / nblk, nb = item % nblk, k0 = 64 * kb, n0 = 32 * nb;
    { const int r8 = lane >> 3, c4 = (lane & 7) * 4; f32x4 w[8];
#pragma unroll
      for (int i = 0; i < 8; ++i) w[i] = *(const GAS f32x4*)(W + (size_t)(k0 + 8 * i + r8) * N + n0 + c4);
#pragma unroll
      for (int i = 0; i < 8; ++i) { const int kk = 8 * i + r8; const float g = gk ? gk[k0 + kk] : 1.0f; LAS float* d = scr + kk * 33 + c4; d[0] = w[i].x * g; d[1] = w[i].y * g; d[2] = w[i].z * g; d[3] = w[i].w * g; } }
    LDS_WAIT(); asm volatile("" ::: "memory");
    int prow0 = n0;
    if (permute) { const int tile = n0 >> 8, lc = n0 & 255, wc = lc >> 6, bj = (lc >> 5) & 1; prow0 = tile * 256 + 128 * bj + 32 * wc; }
    const int c = lane & 7;
#pragma unroll
    for (int j = 0; j < 4; ++j) { const int n = (lane >> 3) + 8 * j; const LAS float* s = scr + (8 * c) * 33 + n;
        v4u o; o.x = pk2(s[0 * 33], s[1 * 33]); o.y = pk2(s[2 * 33], s[3 * 33]); o.z = pk2(s[4 * 33], s[5 * 33]); o.w = pk2(s[6 * 33], s[7 * 33]);
        *(GAS v4u*)(WT + (size_t)(prow0 + n) * K + k0 + 8 * c) = o; }
    LDS_WAIT(); asm volatile("" ::: "memory");
}
template <bool SIGNED> __device__ __forceinline__ void row_quant8(const float* xrow, const float* gcol, unsigned char* orow, float* scale_out, int lane) {
    const GAS f32x4* xr = (const GAS f32x4*)xrow + 4 * lane;
    f32x4 v[4]; float m = 0.f;
#pragma unroll
    for (int j = 0; j < 4; ++j) { v[j] = xr[j]; if (gcol) v[j] = v[j] * ((const GAS f32x4*)gcol)[4 * lane + j]; m = fmaxf(m, fmaxf(fmaxf(fabsf(v[j].x), fabsf(v[j].y)), fmaxf(fabsf(v[j].z), fabsf(v[j].w)))); }
#pragma unroll
    for (int o = 1; o < 64; o <<= 1) m = fmaxf(m, __shfl_xor(m, o));
    const float inv = m > 0.f ? 127.0f / m : 0.f; const int off = SIGNED ? 0 : 128;
    v4u o; unsigned w[4];
#pragma unroll
    for (int j = 0; j < 4; ++j) { const int q0 = __float2int_rn(v[j].x * inv) + off, q1 = __float2int_rn(v[j].y * inv) + off, q2 = __float2int_rn(v[j].z * inv) + off, q3 = __float2int_rn(v[j].w * inv) + off;
        w[j] = (unsigned)(q0 & 255) | ((unsigned)(q1 & 255) << 8) | ((unsigned)(q2 & 255) << 16) | ((unsigned)(q3 & 255) << 24); }
    o.x = w[0]; o.y = w[1]; o.z = w[2]; o.w = w[3];
    *(GAS v4u*)(orow + 16 * lane) = o;
    if (lane == 0) *scale_out = m * (1.0f / 127.0f);
}
template <bool SIGNED> __device__ __forceinline__ void row_quant8_regs(const f32x4 (&v)[4], unsigned char* orow, float* scale_out, int lane) {
    float m = 0.f;
#pragma unroll
    for (int j = 0; j < 4; ++j) m = fmaxf(m, fmaxf(fmaxf(fabsf(v[j].x), fabsf(v[j].y)), fmaxf(fabsf(v[j].z), fabsf(v[j].w))));
#pragma unroll
    for (int o = 1; o < 64; o <<= 1) m = fmaxf(m, __shfl_xor(m, o));
    const float inv = m > 0.f ? 127.0f / m : 0.f; const int off = SIGNED ? 0 : 128;
    v4u o; unsigned w[4];
#pragma unroll
    for (int j = 0; j < 4; ++j) { const int q0 = __float2int_rn(v[j].x * inv) + off, q1 = __float2int_rn(v[j].y * inv) + off, q2 = __float2int_rn(v[j].z * inv) + off, q3 = __float2int_rn(v[j].w * inv) + off;
        w[j] = (unsigned)(q0 & 255) | ((unsigned)(q1 & 255) << 8) | ((unsigned)(q2 & 255) << 16) | ((unsigned)(q3 & 255) << 24); }
    o.x = w[0]; o.y = w[1]; o.z = w[2]; o.w = w[3];
    *(GAS v4u*)(orow + 16 * lane) = o;
    if (lane == 0) *scale_out = m * (1.0f / 127.0f);
}
__device__ __forceinline__ void quant_tables(const Params& P, int wi, int nw, int wave, int lane) {
    unsigned char* UQ = P.ws + WS_U; unsigned char* VQ = P.ws + WS_V; float* SUV = (float*)(P.ws + WS_SU);
    f32x4 gg[4];
#pragma unroll
    for (int j = 0; j < 4; ++j) gg[j] = ((const GAS f32x4*)P.norm2_g)[4 * lane + j];
    const int stride = nw * NWAVES;
    for (int e = wi * NWAVES + wave; e < NEXP; e += 2 * stride) {
        const int e2 = e + stride < NEXP ? e + stride : e;
        f32x4 ua[4], va[4], ub[4], vb[4];
#pragma unroll
        for (int j = 0; j < 4; ++j) { ua[j] = ((const GAS f32x4*)(P.peer_u + (size_t)e * DM))[4 * lane + j]; va[j] = ((const GAS f32x4*)(P.peer_v + (size_t)e * DM))[4 * lane + j];
            ub[j] = ((const GAS f32x4*)(P.peer_u + (size_t)e2 * DM))[4 * lane + j]; vb[j] = ((const GAS f32x4*)(P.peer_v + (size_t)e2 * DM))[4 * lane + j]; }
#pragma unroll
        for (int j = 0; j < 4; ++j) { ua[j] = ua[j] * gg[j]; ub[j] = ub[j] * gg[j]; }
        row_quant8_regs<true>(ua, UQ + (size_t)e * DM, SUV + 2 * e, lane); row_quant8_regs<true>(va, VQ + (size_t)e * DM, SUV + 2 * e + 1, lane);
        row_quant8_regs<true>(ub, UQ + (size_t)e2 * DM, SUV + 2 * e2, lane); row_quant8_regs<true>(vb, VQ + (size_t)e2 * DM, SUV + 2 * e2 + 1, lane);
    }
}
__device__ __forceinline__ void p0_colmax_item(const float* W, int N, const float* gk, unsigned* cmax, int item, int lane) {
    const int nblk = N / 32, kb = item / nblk, nb = item % nblk, k0 = 64 * kb, n0 = 32 * nb;
    const int r8 = lane >> 3, c4 = (lane & 7) * 4; f32x4 w[8];
#pragma unroll
    for (int i = 0; i < 8; ++i) w[i] = *(const GAS f32x4*)(W + (size_t)(k0 + 8 * i + r8) * N + n0 + c4);
    float m0 = 0.f, m1 = 0.f, m2 = 0.f, m3 = 0.f;
#pragma unroll
    for (int i = 0; i < 8; ++i) { const float g = gk[k0 + 8 * i + r8]; m0 = fmaxf(m0, fabsf(w[i].x * g)); m1 = fmaxf(m1, fabsf(w[i].y * g)); m2 = fmaxf(m2, fabsf(w[i].z * g)); m3 = fmaxf(m3, fabsf(w[i].w * g)); }
#pragma unroll
    for (int o = 8; o < 64; o <<= 1) { m0 = fmaxf(m0, __shfl_xor(m0, o)); m1 = fmaxf(m1, __shfl_xor(m1, o)); m2 = fmaxf(m2, __shfl_xor(m2, o)); m3 = fmaxf(m3, __shfl_xor(m3, o)); }
    if (lane < 8) { atomicMax(cmax + n0 + c4, __builtin_bit_cast(unsigned, m0)); atomicMax(cmax + n0 + c4 + 1, __builtin_bit_cast(unsigned, m1)); atomicMax(cmax + n0 + c4 + 2, __builtin_bit_cast(unsigned, m2)); atomicMax(cmax + n0 + c4 + 3, __builtin_bit_cast(unsigned, m3)); }
}
__device__ __forceinline__ void p0_quant_item(const float* W, int K, int N, const float* gk, const unsigned* cmax, unsigned char* WT8, float* sw, LAS float* scr, int item, int lane) {
    const int nblk = N / 32, kb = item / nblk, nb = item % nblk, k0 = 64 * kb, n0 = 32 * nb;
    const float cm = __builtin_bit_cast(float, __hip_atomic_load(cmax + n0 + (lane & 31), __ATOMIC_RELAXED, __HIP_MEMORY_SCOPE_AGENT)); const float inv = cm > 0.f ? 127.0f / cm : 0.f;
    { const int r8 = lane >> 3, c4 = (lane & 7) * 4; f32x4 w[8]; float iv[4];
#pragma unroll
      for (int i = 0; i < 8; ++i) w[i] = *(const GAS f32x4*)(W + (size_t)(k0 + 8 * i + r8) * N + n0 + c4);
#pragma unroll
      for (int j = 0; j < 4; ++j) { const float c = __builtin_bit_cast(float, __hip_atomic_load(cmax + n0 + c4 + j, __ATOMIC_RELAXED, __HIP_MEMORY_SCOPE_AGENT)); iv[j] = c > 0.f ? 127.0f / c : 0.f; }
#pragma unroll
      for (int i = 0; i < 8; ++i) { const int kk = 8 * i + r8; const float g = gk[k0 + kk]; LAS float* d = scr + kk * 33 + c4; d[0] = w[i].x * g * iv[0]; d[1] = w[i].y * g * iv[1]; d[2] = w[i].z * g * iv[2]; d[3] = w[i].w * g * iv[3]; } }
    (void)inv;
    LDS_WAIT(); asm volatile("" ::: "memory");
    const int tile = n0 >> 8, lc = n0 & 255, wc = lc >> 6, bj = (lc >> 5) & 1; const int prow0 = tile * 256 + 128 * bj + 32 * wc;
    if (kb == 0 && lane < 32) sw[prow0 + lane] = cm * (1.0f / 127.0f);
    const int n = lane >> 1, hf = lane & 1; const LAS float* sp = scr + (32 * hf) * 33 + n; unsigned w[8];
#pragma unroll
    for (int j = 0; j < 8; ++j) { const int q0 = __float2int_rn(sp[(4 * j) * 33]), q1 = __float2int_rn(sp[(4 * j + 1) * 33]), q2 = __float2int_rn(sp[(4 * j + 2) * 33]), q3 = __float2int_rn(sp[(4 * j + 3) * 33]);
        w[j] = (unsigned)(q0 & 255) | ((unsigned)(q1 & 255) << 8) | ((unsigned)(q2 & 255) << 16) | ((unsigned)(q3 & 255) << 24); }
    v4u o0, o1; o0.x = w[0]; o0.y = w[1]; o0.z = w[2]; o0.w = w[3]; o1.x = w[4]; o1.y = w[5]; o1.z = w[6]; o1.w = w[7];
    GAS v4u* dst = (GAS v4u*)(WT8 + (size_t)(prow0 + n) * K + k0 + 32 * hf); dst[0] = o0; dst[1] = o1;
    LDS_WAIT(); asm volatile("" ::: "memory");
}
__device__ __forceinline__ void row_quant_rms_regs(const f32x4 (&v)[4], unsigned char* orow, float* scale_out, int lane) {
    float m = 0.f, ss = 0.f;
#pragma unroll
    for (int j = 0; j < 4; ++j) { m = fmaxf(m, fmaxf(fmaxf(fabsf(v[j].x), fabsf(v[j].y)), fmaxf(fabsf(v[j].z), fabsf(v[j].w)))); ss += (v[j].x * v[j].x + v[j].y * v[j].y) + (v[j].z * v[j].z + v[j].w * v[j].w); }
#pragma unroll
    for (int o = 1; o < 64; o <<= 1) { m = fmaxf(m, __shfl_xor(m, o)); ss += __shfl_xor(ss, o); }
    const float inv = m > 0.f ? 127.0f / m : 0.f; unsigned w[4];
#pragma unroll
    for (int j = 0; j < 4; ++j) { const int q0 = __float2int_rn(v[j].x * inv), q1 = __float2int_rn(v[j].y * inv), q2 = __float2int_rn(v[j].z * inv), q3 = __float2int_rn(v[j].w * inv);
        w[j] = (unsigned)(q0 & 255) | ((unsigned)(q1 & 255) << 8) | ((unsigned)(q2 & 255) << 16) | ((unsigned)(q3 & 255) << 24); }
    v4u o; o.x = w[0]; o.y = w[1]; o.z = w[2]; o.w = w[3];
    *(GAS v4u*)(orow + 16 * lane) = o;
    if (lane == 0) *scale_out = rsqrtf(ss * (1.0f / DM) + EPS) * m * (1.0f / 127.0f);
}
__device__ __forceinline__ void p0_prologue_a(const Params& P, LAS unsigned char* lds, int wave, int lane, int part) {
    const int tid = wave * 64 + lane;
    LAS float* scr = (LAS float*)(lds + wave * 16384);
    const int gw = blockIdx.x * NWAVES + wave, NGW = gridDim.x * NWAVES;
    bf16* WA = (bf16*)(P.ws + WS_WA); bf16* WB = (bf16*)(P.ws + WS_WB); bf16* WOUT = (bf16*)(P.ws + WS_WOUT); bf16* WQ = (bf16*)(P.ws + WS_WQ);
    constexpr int I_IN = (1024 / 64) * (NIN / 32), I_A = (512 / 64) * (1024 / 32), I_B = (256 / 64) * (1024 / 32), I_O = (1024 / 64) * (1024 / 32), I_Q = I_O;
    constexpr int NITEMS = I_IN + I_A + I_B + I_O + I_Q;
    if (part == 0) { for (int it = gw; it < I_IN; it += NGW) p0_colmax_item(P.w_in, NIN, P.norm1_g, (unsigned*)(P.ws + WS_CMAX), it, lane); return; }
    for (int it = I_IN + gw; it < NITEMS; it += NGW) {
        int r = it - I_IN;
        if (r < I_A) { p0_transpose_item(P.w_a, 512, 1024, nullptr, false, WA, scr, r, lane); continue; } r -= I_A;
        if (r < I_B) { p0_transpose_item(P.w_b, 256, 1024, nullptr, false, WB, scr, r, lane); continue; } r -= I_B;
        if (r < I_O) { p0_transpose_item(P.w_out, 1024, 1024, nullptr, false, WOUT, scr, r, lane); continue; } r -= I_O;
        p0_transpose_item(P.peer_wq, 1024, 1024, P.norm2_g, false, WQ, scr, r, lane);
    }
    { bf16* SK = (bf16*)(P.ws + WS_SK); const int gt = blockIdx.x * (NWAVES * 64) + tid, NT = gridDim.x * NWAVES * 64;
      for (int i = gt; i < 8 * 2 * 128 * 64 / 2; i += NT) ((unsigned*)SK)[i] = pk2(P.peer_sk[2 * i], P.peer_sk[2 * i + 1]); }
    { unsigned char* XN8 = (unsigned char*)P.out + OUT_XN; float* sxn = (float*)(P.ws + WS_SXN);
      for (int m = gw; m < MTOK; m += 2 * NGW) { const int m2 = m + NGW < MTOK ? m + NGW : m;
          f32x4 va[4], vb[4];
#pragma unroll
          for (int j = 0; j < 4; ++j) { va[j] = ((const GAS f32x4*)(P.x + (size_t)m * DM))[4 * lane + j]; vb[j] = ((const GAS f32x4*)(P.x + (size_t)m2 * DM))[4 * lane + j]; }
          row_quant_rms_regs(va, XN8 + (size_t)m * DM, sxn + m, lane); row_quant_rms_regs(vb, XN8 + (size_t)m2 * DM, sxn + m2, lane); } }
}
__device__ __forceinline__ void p0_prologue_b(const Params& P, LAS unsigned char* lds, int wave, int lane) {
    LAS float* scr = (LAS float*)(lds + wave * 16384);
    const int gw = blockIdx.x * NWAVES + wave, NGW = gridDim.x * NWAVES;
    constexpr int I_IN = (1024 / 64) * (NIN / 32);
    for (int it = gw; it < I_IN; it += NGW) p0_quant_item(P.w_in, 1024, NIN, P.norm1_g, (const unsigned*)(P.ws + WS_CMAX), P.ws + WS_WIN, (float*)(P.ws + WS_SW), scr, it, lane);
}

__device__ __forceinline__ unsigned cvtpk(float lo, float hi) { typedef __bf16 b2 __attribute__((ext_vector_type(2))); typedef float f2 __attribute__((ext_vector_type(2))); f2 v = {lo, hi}; return __builtin_bit_cast(unsigned, __builtin_convertvector(v, b2)); }
typedef short s16x4 __attribute__((ext_vector_type(4)));
__device__ __forceinline__ s16x4 ds_tr16(const LAS unsigned char* p) { return __builtin_bit_cast(s16x4, __builtin_amdgcn_ds_read_tr16_b64_v4i16((LAS s16x4*)p)); }
__device__ __forceinline__ void hgrn_chunked_item(const Params& P, LAS unsigned char* lds, int item, int wave, int lane) {
    constexpr int QD_P = 272, TR_P = 320;
    constexpr int L_QD = 0, L_KI = 17408, L_KT = 34816, L_V = 55296, L_DEC = 75776, L_AP = 76288, L_OB = 82432;
    const int tid = wave * 64 + lane, b = item >> 2, h = item & 3;
    const int lrow = tid >> 3, lc = (tid & 7) * 16;
    const int l31 = lane & 31, hh = lane >> 5, jv = wave & 3, kh = wave >> 2;
    const bf16* base = (const bf16*)(P.ws + WS_PROJ) + (size_t)b * SEQ * NIN + h * 128;
    const bf16* kib = (const bf16*)((const unsigned char*)P.out + OUT_KI) + (size_t)b * SEQ * 512 + h * 128;
    bf16* YA = (bf16*)((unsigned char*)P.out + OUT_YA) + (size_t)b * SEQ * 512 + h * 128;
    float gn[16];
#pragma unroll
    for (int e = 0; e < 16; ++e) gn[e] = P.hg_norm_g[lc + e];
    f32x16 S[2];
    S[0] = f32x16{}; S[1] = f32x16{};
    v4u pq[2], pd[2], pk[2], pv[2], pg[2];
#define HG_LOAD(n_) do { const size_t ro_ = (size_t)((n_) * 64 + lrow); const bf16* r = base + ro_ * NIN + lc; const bf16* kr = kib + ro_ * 512 + lc; \
      pg[0] = *(const v4u*)(r + 1536); pg[1] = *(const v4u*)(r + 1544);   \
      pq[0] = *(const v4u*)r; pq[1] = *(const v4u*)(r + 8); pd[0] = *(const v4u*)(r + 512); pd[1] = *(const v4u*)(r + 520); pk[0] = *(const v4u*)kr; pk[1] = *(const v4u*)(kr + 8); \
      pv[0] = *(const v4u*)(r + 1024); pv[1] = *(const v4u*)(r + 1032); } while (0)
    HG_LOAD(0);
    const int tro = (4 * hh + ((lane & 15) >> 2)) * TR_P + (16 * ((lane >> 4) & 1) + 4 * (lane & 3)) * 2;
#pragma unroll 1
    for (int n = 0; n < SEQ / 64; ++n) {
        { const unsigned qw[8] = {pq[0].x, pq[0].y, pq[0].z, pq[0].w, pq[1].x, pq[1].y, pq[1].z, pq[1].w}, dw[8] = {pd[0].x, pd[0].y, pd[0].z, pd[0].w, pd[1].x, pd[1].y, pd[1].z, pd[1].w};
          unsigned w[8];
#pragma unroll
          for (int e = 0; e < 8; ++e) w[e] = pk2(pg8::bflo(qw[e]) * pg8::bflo(dw[e]), pg8::bfhi(qw[e]) * pg8::bfhi(dw[e]));
          v4u a0, a1; a0.x = w[0]; a0.y = w[1]; a0.z = w[2]; a0.w = w[3]; a1.x = w[4]; a1.y = w[5]; a1.z = w[6]; a1.w = w[7];
          *(LAS v4u*)(lds + L_QD + lrow * QD_P + lc * 2) = a0; *(LAS v4u*)(lds + L_QD + lrow * QD_P + lc * 2 + 16) = a1;
          if (lrow == 63) {
#pragma unroll
              for (int e4 = 0; e4 < 4; ++e4) *(LAS f32x4*)(lds + L_DEC + (lc + 4 * e4) * 4) = (f32x4){pg8::bflo(dw[2 * e4]), pg8::bfhi(dw[2 * e4]), pg8::bflo(dw[2 * e4 + 1]), pg8::bfhi(dw[2 * e4 + 1])}; } }
        *(LAS v4u*)(lds + L_KI + lrow * QD_P + lc * 2) = pk[0]; *(LAS v4u*)(lds + L_KI + lrow * QD_P + lc * 2 + 16) = pk[1];
        *(LAS v4u*)(lds + L_KT + lrow * TR_P + lc * 2) = pk[0]; *(LAS v4u*)(lds + L_KT + lrow * TR_P + lc * 2 + 16) = pk[1];
        *(LAS v4u*)(lds + L_V + lrow * TR_P + lc * 2) = pv[0]; *(LAS v4u*)(lds + L_V + lrow * TR_P + lc * 2 + 16) = pv[1];
        const v4u og0 = pg[0], og1 = pg[1];
        HG_LOAD(n + 1 < SEQ / 64 ? n + 1 : n);
        __syncthreads();
        if (wave < 3) {
            const int st = wave >> 1, ct = (wave + 1) >> 1;
            f32x16 a_ = f32x16{};
#pragma unroll
            for (int ks = 0; ks < 8; ++ks) { const bf16x8 af = *(const LAS bf16x8*)(lds + L_KI + (32 * st + l31) * QD_P + (16 * ks + 8 * hh) * 2), bfr = *(const LAS bf16x8*)(lds + L_QD + (32 * ct + l31) * QD_P + (16 * ks + 8 * hh) * 2);
                a_ = __builtin_amdgcn_mfma_f32_32x32x16_bf16(af, bfr, a_, 0, 0, 0); }
            if (st == ct) {
#pragma unroll
                for (int r = 0; r < 16; ++r) if ((r & 3) + 8 * (r >> 2) + 4 * hh > l31) a_[r] = 0.f; }
            v4u a0, a1;
            a0.x = cvtpk(a_[0], a_[1]); a0.y = cvtpk(a_[2], a_[3]); a0.z = cvtpk(a_[4], a_[5]); a0.w = cvtpk(a_[6], a_[7]);
            a1.x = cvtpk(a_[8], a_[9]); a1.y = cvtpk(a_[10], a_[11]); a1.z = cvtpk(a_[12], a_[13]); a1.w = cvtpk(a_[14], a_[15]);
            *(LAS v4u*)(lds + L_AP + wave * 2048 + lane * 16) = a0; *(LAS v4u*)(lds + L_AP + wave * 2048 + 1024 + lane * 16) = a1;
        }
        f32x16 oacc[2]; oacc[0] = f32x16{}; oacc[1] = f32x16{};
#pragma unroll
        for (int kl = 0; kl < 2; ++kl)
#pragma unroll
            for (int st = 0; st < 2; ++st) {
                v4u sb; sb.x = cvtpk(S[kl][8 * st + 0], S[kl][8 * st + 1]); sb.y = cvtpk(S[kl][8 * st + 2], S[kl][8 * st + 3]); sb.z = cvtpk(S[kl][8 * st + 4], S[kl][8 * st + 5]); sb.w = cvtpk(S[kl][8 * st + 6], S[kl][8 * st + 7]);
                typedef unsigned u2v __attribute__((ext_vector_type(2)));
#pragma unroll
                for (int rt = 0; rt < 2; ++rt) {
                    const LAS unsigned char* qp = lds + L_QD + (32 * rt + l31) * QD_P + (32 * (2 * kh + kl) + 16 * st + 4 * hh) * 2;
                    const u2v lo = *(const LAS u2v*)qp, hi = *(const LAS u2v*)(qp + 16);
                    v4u av; av.x = lo.x; av.y = lo.y; av.z = hi.x; av.w = hi.y;
                    oacc[rt] = __builtin_amdgcn_mfma_f32_32x32x16_bf16(__builtin_bit_cast(bf16x8, av), __builtin_bit_cast(bf16x8, sb), oacc[rt], 0, 0, 0); } }
        bf16x8 vf[4];
#pragma unroll
        for (int ks = 0; ks < 4; ++ks) { const LAS unsigned char* a1 = lds + L_V + tro + (16 * ks) * TR_P + (32 * jv) * 2; const s16x4 lo = ds_tr16(a1), hi = ds_tr16(a1 + 8 * TR_P);
            vf[ks] = (bf16x8){lo[0], lo[1], lo[2], lo[3], hi[0], hi[1], hi[2], hi[3]}; }
#pragma unroll
        for (int kl = 0; kl < 2; ++kl) {
            const int kt = 2 * kh + kl;
#pragma unroll
            for (int ks = 0; ks < 4; ++ks) { const LAS unsigned char* a1 = lds + L_KT + tro + (16 * ks) * TR_P + (32 * kt) * 2; const s16x4 lo = ds_tr16(a1), hi = ds_tr16(a1 + 8 * TR_P);
                const bf16x8 kf = {lo[0], lo[1], lo[2], lo[3], hi[0], hi[1], hi[2], hi[3]};
                S[kl] = __builtin_amdgcn_mfma_f32_32x32x16_bf16(kf, vf[ks], S[kl], 0, 0, 0); }
#pragma unroll
            for (int r4 = 0; r4 < 4; ++r4) { const f32x4 d = *(const LAS f32x4*)(lds + L_DEC + (32 * kt + 8 * r4 + 4 * hh) * 4);
                S[kl][4 * r4 + 0] *= d.x; S[kl][4 * r4 + 1] *= d.y; S[kl][4 * r4 + 2] *= d.z; S[kl][4 * r4 + 3] *= d.w; }
        }
        __syncthreads();
        if (kh == 0) {
            const v4u a0 = *(const LAS v4u*)(lds + L_AP + lane * 16), a1 = *(const LAS v4u*)(lds + L_AP + 1024 + lane * 16);
            oacc[0] = __builtin_amdgcn_mfma_f32_32x32x16_bf16(__builtin_bit_cast(bf16x8, a0), vf[0], oacc[0], 0, 0, 0);
            oacc[0] = __builtin_amdgcn_mfma_f32_32x32x16_bf16(__builtin_bit_cast(bf16x8, a1), vf[1], oacc[0], 0, 0, 0);
        } else {
#pragma unroll
            for (int st = 0; st < 2; ++st) { const v4u a0 = *(const LAS v4u*)(lds + L_AP + (1 + st) * 2048 + lane * 16), a1 = *(const LAS v4u*)(lds + L_AP + (1 + st) * 2048 + 1024 + lane * 16);
                oacc[1] = __builtin_amdgcn_mfma_f32_32x32x16_bf16(__builtin_bit_cast(bf16x8, a0), vf[2 * st], oacc[1], 0, 0, 0);
                oacc[1] = __builtin_amdgcn_mfma_f32_32x32x16_bf16(__builtin_bit_cast(bf16x8, a1), vf[2 * st + 1], oacc[1], 0, 0, 0); }
        }
#pragma unroll
        for (int rt = 0; rt < 2; ++rt)
#pragma unroll
            for (int r = 0; r < 16; ++r) ((LAS float*)(lds + L_OB + kh * 32768))[(32 * rt + (r & 3) + 8 * (r >> 2) + 4 * hh) * 128 + 32 * jv + l31] = oacc[rt][r];
        __syncthreads();
        {
            float o[16]; float ss = 0.f;
#pragma unroll
            for (int e4 = 0; e4 < 4; ++e4) { const f32x4 t = *(const LAS f32x4*)(lds + L_OB + (lrow * 128 + lc + 4 * e4) * 4) + *(const LAS f32x4*)(lds + L_OB + 32768 + (lrow * 128 + lc + 4 * e4) * 4);
                o[4 * e4] = t.x; o[4 * e4 + 1] = t.y; o[4 * e4 + 2] = t.z; o[4 * e4 + 3] = t.w; ss += (t.x * t.x + t.y * t.y) + (t.z * t.z + t.w * t.w); }
            ss += __shfl_xor(ss, 1); ss += __shfl_xor(ss, 2); ss += __shfl_xor(ss, 4);
            const float rs = rsqrtf(ss * (1.0f / 128.0f) + EPS);
            const unsigned gw[8] = {og0.x, og0.y, og0.z, og0.w, og1.x, og1.y, og1.z, og1.w};
            unsigned yw[8];
#pragma unroll
            for (int e = 0; e < 8; ++e) yw[e] = pk2(o[2 * e] * rs * gn[2 * e] * pg8::bflo(gw[e]), o[2 * e + 1] * rs * gn[2 * e + 1] * pg8::bfhi(gw[e]));
            bf16* yp = YA + (size_t)(n * 64 + lrow) * 512 + lc;
            v4u y0, y1; y0.x = yw[0]; y0.y = yw[1]; y0.z = yw[2]; y0.w = yw[3]; y1.x = yw[4]; y1.y = yw[5]; y1.z = yw[6]; y1.w = yw[7];
            *(v4u*)yp = y0; *(v4u*)(yp + 8) = y1;
        }
    }
#undef HG_LOAD
    __syncthreads();
}

constexpr int KB_P = 144;
constexpr int VB_P = 192;
template <int CG> __device__ __forceinline__ void attn_group(const bf16* base, LAS unsigned char* vbuf, int h, int r, int p0, int lane, float Mfix, f32x16 (&oT)[2], float& lsum) {
    constexpr int dil = (CG == 0) ? 1 : (CG == 1) ? 4 : 16, Lg = SEQ / dil, NT = 5;
    const int l31 = lane & 31, hh = lane >> 5;
    const int qcol = 2048 + (CG * 4 + h) * 64, kcol = qcol + 768, vcol = qcol + 1536;
    bf16x8 qf[4];
    { const bf16* qr = base + (size_t)(dil * (p0 + l31) + r) * NIN + qcol + 8 * hh;
#pragma unroll
      for (int ks = 0; ks < 4; ++ks) qf[ks] = *(const bf16x8*)(qr + 16 * ks); }
    const int Pq = p0 + l31, lim = Pq < 128 ? Pq : 128;
    const int kp0 = p0 - 128;
    const bool full = p0 >= 128;
    const int r8 = lane >> 3, ch = lane & 7;
    LAS unsigned char* kbuf = vbuf + 32 * VB_P;
    v4u k0[4], v0[4], k1[4], v1[4], k2[4], v2[4];
#define ATT_LOAD(KR, VR, t_) do { _Pragma("unroll") for (int c = 0; c < 4; ++c) { int pa = kp0 + 32 * (t_) + r8 + 8 * c; pa = pa < 0 ? 0 : (pa > Lg - 1 ? Lg - 1 : pa); \
        const bf16* rr = base + (size_t)(pa * dil + r) * NIN + 8 * ch; KR[c] = *(const v4u*)(rr + kcol); VR[c] = *(const v4u*)(rr + vcol); } } while (0)
    const LAS unsigned char* trp = vbuf + (4 * hh + ((lane & 15) >> 2)) * VB_P + (16 * ((lane >> 4) & 1) + 4 * (lane & 3)) * 2;
    const LAS unsigned char* kfp = kbuf + l31 * KB_P + 16 * hh;
#define ATT_TILE(KR, VR, t_, EDGE) do { const int kp = kp0 + 32 * (t_); \
        _Pragma("unroll") for (int c = 0; c < 4; ++c) { *(LAS v4u*)(kbuf + (r8 + 8 * c) * KB_P + 16 * ch) = KR[c]; *(LAS v4u*)(vbuf + (r8 + 8 * c) * VB_P + 16 * ch) = VR[c]; } \
        f32x16 sc = f32x16{}; \
        _Pragma("unroll") for (int ks = 0; ks < 4; ++ks) sc = __builtin_amdgcn_mfma_f32_32x32x16_bf16(*(const LAS bf16x8*)(kfp + 32 * ks), qf[ks], sc, 0, 0, 0); \
        float p[16]; \
        if ((EDGE) || !full) { const int dl = Pq - kp - 4 * hh; \
            _Pragma("unroll") for (int q = 0; q < 16; ++q) { const int d = dl - ((q & 3) + 8 * (q >> 2)); const float e = __builtin_amdgcn_exp2f(sc[q] - Mfix); p[q] = ((unsigned)d <= (unsigned)lim) ? e : 0.f; lsum += p[q]; } } \
        else { _Pragma("unroll") for (int q = 0; q < 16; ++q) { p[q] = __builtin_amdgcn_exp2f(sc[q] - Mfix); lsum += p[q]; } } \
        v4u pk0, pk1; \
        pk0.x = cvtpk(p[0], p[1]); pk0.y = cvtpk(p[2], p[3]); pk0.z = cvtpk(p[4], p[5]); pk0.w = cvtpk(p[6], p[7]); \
        pk1.x = cvtpk(p[8], p[9]); pk1.y = cvtpk(p[10], p[11]); pk1.z = cvtpk(p[12], p[13]); pk1.w = cvtpk(p[14], p[15]); \
        _Pragma("unroll") for (int dt = 0; dt < 2; ++dt) _Pragma("unroll") for (int ss = 0; ss < 2; ++ss) { const LAS unsigned char* a1 = trp + (16 * ss) * VB_P + (32 * dt) * 2; \
                const s16x4 lo = ds_tr16(a1), hi = ds_tr16(a1 + 8 * VB_P); \
                const bf16x8 vf = {lo[0], lo[1], lo[2], lo[3], hi[0], hi[1], hi[2], hi[3]}; \
                oT[dt] = __builtin_amdgcn_mfma_f32_32x32x16_bf16(vf, __builtin_bit_cast(bf16x8, ss == 0 ? pk0 : pk1), oT[dt], 0, 0, 0); } } while (0)
    ATT_LOAD(k0, v0, 0); ATT_LOAD(k1, v1, 1);
#pragma unroll 1
    for (int tile = 0; tile < NT; tile += 3) {
        ATT_LOAD(k2, v2, (tile + 2 < NT ? tile + 2 : NT - 1)); ATT_TILE(k0, v0, tile, tile == 0);
        ATT_LOAD(k0, v0, (tile + 3 < NT ? tile + 3 : NT - 1)); ATT_TILE(k1, v1, tile + 1, tile + 1 == NT - 1);
        ATT_LOAD(k1, v1, (tile + 4 < NT ? tile + 4 : NT - 1)); if (tile + 2 < NT) ATT_TILE(k2, v2, tile + 2, false);
    }
#undef ATT_TILE
#undef ATT_LOAD
}
constexpr int AT_O0 = 86016, AT_L0 = AT_O0 + 65536, AT_TSK = AT_L0 + 2048;
__device__ __forceinline__ void attn_wg_task(const Params& P, LAS unsigned char* lds, int task, int wave, int lane, float Mfix) {
    const int pt = task & 3, h = (task >> 2) & 3, b = task >> 4;
    const bf16* base = (const bf16*)(P.ws + WS_PROJ) + (size_t)b * SEQ * NIN;
    LAS unsigned char* vbuf = lds + wave * 10752;
    typedef unsigned u2v __attribute__((ext_vector_type(2)));
    const int l31 = lane & 31, hh = lane >> 5;
#define AT_CHUNK(p_, dt_, r4_) (lds + AT_O0 + (p_) * 128 + ((8 * (dt_) + 2 * (r4_) + hh + ((p_) >> 4) + (p_)) & 15) * 8)
#pragma unroll 1
    for (int i = 0; i < 2; ++i) {
        f32x16 oT[2]; oT[0] = f32x16{}; oT[1] = f32x16{}; float lsum = 0.f;
        const int pl = 64 * wave + 32 * i;
        attn_group<0>(base, vbuf, h, 0, 512 * pt + pl, lane, Mfix, oT, lsum);
        lsum += __shfl_xor(lsum, 32);
        const int p = pl + l31;
        if (hh == 0) ((LAS float*)(lds + AT_L0))[p] = lsum;
#pragma unroll
        for (int dt = 0; dt < 2; ++dt)
#pragma unroll
            for (int r4 = 0; r4 < 4; ++r4) { u2v w; w.x = cvtpk(oT[dt][4 * r4], oT[dt][4 * r4 + 1]); w.y = cvtpk(oT[dt][4 * r4 + 2], oT[dt][4 * r4 + 3]); *(LAS u2v*)AT_CHUNK(p, dt, r4) = w; }
    }
    __syncthreads();
#pragma unroll 1
    for (int i = 0; i < 2; ++i) {
        f32x16 oT[2]; oT[0] = f32x16{}; oT[1] = f32x16{}; float lsum = 0.f;
        const int pair = 2 * wave + i, c4 = pair & 3, tq = pair >> 2;
        attn_group<1>(base, vbuf, h, c4, 128 * pt + 32 * tq, lane, Mfix, oT, lsum);
        lsum += __shfl_xor(lsum, 32);
        const int p = 4 * (32 * tq + l31) + c4;
        if (hh == 0) ((LAS float*)(lds + AT_L0))[p] += lsum;
#pragma unroll
        for (int dt = 0; dt < 2; ++dt)
#pragma unroll
            for (int r4 = 0; r4 < 4; ++r4) { LAS u2v* cp = (LAS u2v*)AT_CHUNK(p, dt, r4); const u2v o0 = *cp;
                u2v w; w.x = cvtpk(oT[dt][4 * r4] + pg8::bflo(o0.x), oT[dt][4 * r4 + 1] + pg8::bfhi(o0.x)); w.y = cvtpk(oT[dt][4 * r4 + 2] + pg8::bflo(o0.y), oT[dt][4 * r4 + 3] + pg8::bfhi(o0.y)); *cp = w; }
    }
    __syncthreads();
#pragma unroll 1
    for (int i = 0; i < 2; ++i) {
        const int r16 = 2 * wave + i;
        f32x16 oT[2]; oT[0] = f32x16{}; oT[1] = f32x16{}; float lsum = 0.f;
        attn_group<2>(base, vbuf, h, r16, 32 * pt, lane, Mfix, oT, lsum);
        lsum += __shfl_xor(lsum, 32);
        const int p = 16 * l31 + r16;
        lsum += ((const LAS float*)(lds + AT_L0))[p];
        const float rl = 1.0f / lsum;
        bf16* yb = (bf16*)((unsigned char*)P.out + OUT_YB) + (size_t)(b * SEQ + 512 * pt + p) * 256 + h * 64;
#pragma unroll
        for (int dt = 0; dt < 2; ++dt)
#pragma unroll
            for (int r4 = 0; r4 < 4; ++r4) { const u2v o0 = *(const LAS u2v*)AT_CHUNK(p, dt, r4);
                u2v w; w.x = cvtpk((oT[dt][4 * r4] + pg8::bflo(o0.x)) * rl, (oT[dt][4 * r4 + 1] + pg8::bfhi(o0.x)) * rl); w.y = cvtpk((oT[dt][4 * r4 + 2] + pg8::bflo(o0.y)) * rl, (oT[dt][4 * r4 + 3] + pg8::bfhi(o0.y)) * rl);
                *(u2v*)(yb + 32 * dt + 8 * r4 + 4 * hh) = w; }
    }
#undef AT_CHUNK
    __syncthreads();
}

__host__ __device__ __forceinline__ unsigned f2key(float f) { const unsigned u = __builtin_bit_cast(unsigned, f); return (u & 0x80000000u) ? ~u : (u | 0x80000000u); }
__host__ __device__ __forceinline__ float key2f(unsigned k) { const unsigned u = (k & 0x80000000u) ? (k & 0x7fffffffu) : ~k; return __builtin_bit_cast(float, u); }
__device__ __forceinline__ unsigned fkmax(unsigned a, unsigned b) { unsigned r; asm("v_max_f32 %0, %1, %2" : "=v"(r) : "v"(a), "v"(b)); return r; }
__device__ __forceinline__ unsigned fkmin(unsigned a, unsigned b) { unsigned r; asm("v_min_f32 %0, %1, %2" : "=v"(r) : "v"(a), "v"(b)); return r; }
#define CE(K, a, b) do { const unsigned x_ = K[a], y_ = K[b]; K[a] = fkmax(x_, y_); K[b] = fkmin(x_, y_); } while (0)
#define BSORT16(K) do { CE(K,0,1); CE(K,3,2); CE(K,4,5); CE(K,7,6); CE(K,8,9); CE(K,11,10); CE(K,12,13); CE(K,15,14); CE(K,0,2); CE(K,1,3); CE(K,6,4); CE(K,7,5); CE(K,8,10); CE(K,9,11); CE(K,14,12); CE(K,15,13); CE(K,0,1); CE(K,2,3); CE(K,5,4); CE(K,7,6); CE(K,8,9); CE(K,10,11); CE(K,13,12); CE(K,15,14); CE(K,0,4); CE(K,1,5); CE(K,2,6); CE(K,3,7); CE(K,12,8); CE(K,13,9); CE(K,14,10); CE(K,15,11); CE(K,0,2); CE(K,1,3); CE(K,4,6); CE(K,5,7); CE(K,10,8); CE(K,11,9); CE(K,14,12); CE(K,15,13); CE(K,0,1); CE(K,2,3); CE(K,4,5); CE(K,6,7); CE(K,9,8); CE(K,11,10); CE(K,13,12); CE(K,15,14); CE(K,0,8); CE(K,1,9); CE(K,2,10); CE(K,3,11); CE(K,4,12); CE(K,5,13); CE(K,6,14); CE(K,7,15); CE(K,0,4); CE(K,1,5); CE(K,2,6); CE(K,3,7); CE(K,8,12); CE(K,9,13); CE(K,10,14); CE(K,11,15); CE(K,0,2); CE(K,1,3); CE(K,4,6); CE(K,5,7); CE(K,8,10); CE(K,9,11); CE(K,12,14); CE(K,13,15); CE(K,0,1); CE(K,2,3); CE(K,4,5); CE(K,6,7); CE(K,8,9); CE(K,10,11); CE(K,12,13); CE(K,14,15); } while (0)
#define BMERGE16(K) do { CE(K,0,8); CE(K,1,9); CE(K,2,10); CE(K,3,11); CE(K,4,12); CE(K,5,13); CE(K,6,14); CE(K,7,15); CE(K,0,4); CE(K,1,5); CE(K,2,6); CE(K,3,7); CE(K,8,12); CE(K,9,13); CE(K,10,14); CE(K,11,15); CE(K,0,2); CE(K,1,3); CE(K,4,6); CE(K,5,7); CE(K,8,10); CE(K,9,11); CE(K,12,14); CE(K,13,15); CE(K,0,1); CE(K,2,3); CE(K,4,5); CE(K,6,7); CE(K,8,9); CE(K,10,11); CE(K,12,13); CE(K,14,15); } while (0)
#define TOPMERGE16(A, B) do { _Pragma("unroll") for (int i_ = 0; i_ < 16; ++i_) A[i_] = fkmax(A[i_], B[15 - i_]); BMERGE16(A); } while (0)
template <int A, int B> struct PairIns {
    static __device__ __forceinline__ void run(const float (&s1)[16], const float (&s2)[16], unsigned (&K)[16]) {
        if constexpr ((A + 1) * (B + 1) <= 16) {
            unsigned x = (__builtin_bit_cast(unsigned, s1[A] + s2[B]) & ~255u) | (unsigned)((A << 4) | B);
#pragma unroll
            for (int i = (A + 1) * (B + 1) - 1; i < 16; ++i) { const unsigned a_ = K[i]; K[i] = fkmax(a_, x); x = fkmin(a_, x); }
            PairIns<A, B + 1>::run(s1, s2, K);
        } else if constexpr (B != 0) { PairIns<A + 1, 0>::run(s1, s2, K); }
    }
};
template <> struct PairIns<16, 0> { static __device__ __forceinline__ void run(const float (&)[16], const float (&)[16], unsigned (&)[16]) {} };

__device__ __forceinline__ float gelu_erf(float v) { return 0.5f * v * (1.0f + erff(v * 0.70710678118654752f)); }


typedef __bf16 bf16x2_t __attribute__((ext_vector_type(2)));
typedef float f32x2 __attribute__((ext_vector_type(2)));
constexpr int RSHIFT = 10, NR = NEXP >> RSHIFT;
constexpr int PL_BUF = 16384, PL_GATE = 8192, PL_WS = 32768, PL_WSB = 12288;

__device__ __forceinline__ float dot2u(unsigned x, unsigned w, float acc) {
    return __builtin_amdgcn_fdot2_f32_bf16(__builtin_bit_cast(bf16x2_t, x), __builtin_bit_cast(bf16x2_t, w), acc, false);
}
__device__ __forceinline__ float dot16_bf16(const unsigned (&x)[8], const v4u a, const v4u b) {
    float p = 0.f;
    p = dot2u(x[0], a.x, p); p = dot2u(x[1], a.y, p); p = dot2u(x[2], a.z, p); p = dot2u(x[3], a.w, p);
    p = dot2u(x[4], b.x, p); p = dot2u(x[5], b.y, p); p = dot2u(x[6], b.z, p); p = dot2u(x[7], b.w, p);
    return p;
}
__device__ __forceinline__ void rows_axpy2(float (&acc)[16], float& corr, float a0, float a1, const v4u w0, const v4u w1) {
    typedef _Float16 h2_ __attribute__((ext_vector_type(2)));
    const h2_ c = {(_Float16)__builtin_amdgcn_fmed3f(a0 * 4096.0f, -60000.0f, 60000.0f), (_Float16)__builtin_amdgcn_fmed3f(a1 * 4096.0f, -60000.0f, 60000.0f)};
    const h2_ one = {(_Float16)1.0f, (_Float16)1.0f};
    corr = __builtin_amdgcn_fdot2(c, one, corr, false);
    const unsigned x0[4] = {w0.x, w0.y, w0.z, w0.w}, x1[4] = {w1.x, w1.y, w1.z, w1.w};
#pragma unroll
    for (int j = 0; j < 4; ++j) {
        acc[4 * j + 0] = __builtin_amdgcn_fdot2(__builtin_bit_cast(h2_, __builtin_amdgcn_perm(x1[j], x0[j], 0x0c040c00u) | 0x64006400u), c, acc[4 * j + 0], false);
        acc[4 * j + 1] = __builtin_amdgcn_fdot2(__builtin_bit_cast(h2_, __builtin_amdgcn_perm(x1[j], x0[j], 0x0c050c01u) | 0x64006400u), c, acc[4 * j + 1], false);
        acc[4 * j + 2] = __builtin_amdgcn_fdot2(__builtin_bit_cast(h2_, __builtin_amdgcn_perm(x1[j], x0[j], 0x0c060c02u) | 0x64006400u), c, acc[4 * j + 2], false);
        acc[4 * j + 3] = __builtin_amdgcn_fdot2(__builtin_bit_cast(h2_, __builtin_amdgcn_perm(x1[j], x0[j], 0x0c070c03u) | 0x64006400u), c, acc[4 * j + 3], false); }
}
__device__ __forceinline__ void row_axpy1(f32x2 (&acc)[8], float a, const v4u w) {
    const unsigned ww[4] = {w.x, w.y, w.z, w.w};
#pragma unroll
    for (int j = 0; j < 4; ++j) { const f32x2 lo = {(float)(ww[j] & 0xffu), (float)((ww[j] >> 8) & 0xffu)}, hi = {(float)((ww[j] >> 16) & 0xffu), (float)(ww[j] >> 24)};
        acc[2 * j] = lo * a + acc[2 * j]; acc[2 * j + 1] = hi * a + acc[2 * j + 1]; }
}
typedef int i32x4 __attribute__((ext_vector_type(4)));

constexpr int GL_SHS = 0, GL_XQ = 2048, GL_CNT = 6144, GL_RM = 8192, GL_SA = 10240;
__device__ __forceinline__ void peer_gather_u(const Params& P, LAS unsigned char* lds, int tok0, int wave, int lane, int parity) {
    const LAS unsigned short* idxs = (const LAS unsigned short*)(lds + parity * PL_BUF); const LAS _Float16* gates = (const LAS _Float16*)(lds + parity * PL_BUF + PL_GATE);
    LAS unsigned char* wsb = lds + PL_WS + wave * PL_WSB;
    LAS int* srm = (LAS int*)(wsb + GL_RM); LAS float* shs = (LAS float*)(wsb + GL_SHS); LAS float* sa = (LAS float*)(wsb + GL_SA);
    LAS int* cnt = (LAS int*)(wsb + GL_CNT); LAS int* start = cnt + 64;
    const unsigned char* UQ = P.ws + WS_U; const f32x2* SUV = (const f32x2*)(P.ws + WS_SU);
    const bf16* X1B = (const bf16*)(P.ws + WS_X1B); const float* sumsq = (const float*)(P.ws + WS_SUMSQ);
    float sx[4];
#pragma unroll
    for (int tk = 0; tk < 4; ++tk) { const size_t t = (size_t)(tok0 + wave * 4 + tk); const float r2 = rsqrtf(sumsq[t] * (1.0f / DM) + EPS);
        const v4u xa = *(const v4u*)(X1B + t * DM + lane * 16), xb = *(const v4u*)(X1B + t * DM + lane * 16 + 8); f32x4 x[4]; float m = 0.f;
        x[0] = (f32x4){pg8::bflo(xa.x), pg8::bfhi(xa.x), pg8::bflo(xa.y), pg8::bfhi(xa.y)} * r2; x[1] = (f32x4){pg8::bflo(xa.z), pg8::bfhi(xa.z), pg8::bflo(xa.w), pg8::bfhi(xa.w)} * r2;
        x[2] = (f32x4){pg8::bflo(xb.x), pg8::bfhi(xb.x), pg8::bflo(xb.y), pg8::bfhi(xb.y)} * r2; x[3] = (f32x4){pg8::bflo(xb.z), pg8::bfhi(xb.z), pg8::bflo(xb.w), pg8::bfhi(xb.w)} * r2;
#pragma unroll
        for (int j = 0; j < 4; ++j) m = fmaxf(m, fmaxf(fmaxf(fabsf(x[j].x), fabsf(x[j].y)), fmaxf(fabsf(x[j].z), fabsf(x[j].w))));
#pragma unroll
        for (int o = 1; o < 64; o <<= 1) m = fmaxf(m, __shfl_xor(m, o));
        const float inv = m > 0.f ? 127.0f / m : 0.f; sx[tk] = m * (1.0f / 127.0f); unsigned w[4];
#pragma unroll
        for (int j = 0; j < 4; ++j) { const int q0 = __float2int_rn(x[j].x * inv), q1 = __float2int_rn(x[j].y * inv), q2 = __float2int_rn(x[j].z * inv), q3 = __float2int_rn(x[j].w * inv);
            w[j] = (unsigned)(q0 & 255) | ((unsigned)(q1 & 255) << 8) | ((unsigned)(q2 & 255) << 16) | ((unsigned)(q3 & 255) << 24); }
        v4u xw_; xw_.x = w[0]; xw_.y = w[1]; xw_.z = w[2]; xw_.w = w[3]; *(LAS v4u*)(wsb + GL_XQ + tk * 1024 + lane * 16) = xw_; }
    { int ee[8], sl[8]; float gg[8];
#pragma unroll
      for (int tk = 0; tk < 4; ++tk) { const int tl = wave * 4 + tk;
          ee[2 * tk] = idxs[tl * 128 + lane]; ee[2 * tk + 1] = idxs[tl * 128 + 64 + lane]; gg[2 * tk] = (float)gates[tl * 128 + lane]; gg[2 * tk + 1] = (float)gates[tl * 128 + 64 + lane]; }
      cnt[lane] = 0;
      LDS_WAIT(); asm volatile("" ::: "memory");
#pragma unroll
      for (int i = 0; i < 8; ++i) sl[i] = __hip_atomic_fetch_add(cnt + ((ee[i] >> RSHIFT) * 4 + (i >> 1)), 1, __ATOMIC_RELAXED, __HIP_MEMORY_SCOPE_WORKGROUP);
      LDS_WAIT(); asm volatile("" ::: "memory");
      { const int c = cnt[lane]; int inc = c;
#pragma unroll
        for (int o = 1; o < 64; o <<= 1) { const int t = __shfl_up(inc, o); if (lane >= o) inc += t; }
        start[lane] = inc - c; }
      LDS_WAIT(); asm volatile("" ::: "memory");
#pragma unroll
      for (int i = 0; i < 8; ++i) { const int pos = start[(ee[i] >> RSHIFT) * 4 + (i >> 1)] + sl[i]; const f32x2 sc2 = SUV[ee[i]]; srm[pos] = ee[i] | ((i >> 1) << 14); sa[pos] = gg[i] * sc2.y; shs[pos] = sc2.x * sx[i >> 1]; }
      LDS_WAIT(); asm volatile("" ::: "memory"); }
    {
        const int lu = fresh_lane(); const unsigned ulo = (unsigned)lu * 16u;
        const LAS unsigned char* xql = wsb + GL_XQ + lu * 16;
        const bool hh = (lu & 32) != 0, b4 = (lu & 16) != 0, b3 = (lu & 8) != 0;
        v4u rA[8], rB[8];
#define U_LOAD(R, pos_) do { const i32x4 e0_ = *(const LAS i32x4*)(srm + (pos_)) & 0x3fff, e1_ = *(const LAS i32x4*)(srm + (pos_) + 4) & 0x3fff; \
        R[0] = *(const v4u*)(UQ + (((unsigned)e0_[0] << 10) + ulo)); R[1] = *(const v4u*)(UQ + (((unsigned)e0_[1] << 10) + ulo)); R[2] = *(const v4u*)(UQ + (((unsigned)e0_[2] << 10) + ulo)); R[3] = *(const v4u*)(UQ + (((unsigned)e0_[3] << 10) + ulo)); \
        R[4] = *(const v4u*)(UQ + (((unsigned)e1_[0] << 10) + ulo)); R[5] = *(const v4u*)(UQ + (((unsigned)e1_[1] << 10) + ulo)); R[6] = *(const v4u*)(UQ + (((unsigned)e1_[2] << 10) + ulo)); R[7] = *(const v4u*)(UQ + (((unsigned)e1_[3] << 10) + ulo)); } while (0)
#define U_DOT1(R, k_, ev_) do { const v4u xs_ = *(const LAS v4u*)(xql + (((ev_) >> 4) & 0xc00)); \
        const int p0_ = __builtin_amdgcn_sdot4((int)R[k_].x, (int)xs_.x, 0, false), p1_ = __builtin_amdgcn_sdot4((int)R[k_].y, (int)xs_.y, 0, false); \
        pd_[k_] = __builtin_amdgcn_sdot4((int)R[k_].z, (int)xs_.z, p0_, false) + __builtin_amdgcn_sdot4((int)R[k_].w, (int)xs_.w, p1_, false); } while (0)
#define U_COMP(R, pos_) do { int pd_[8]; \
        { const i32x4 t0v_ = *(const LAS i32x4*)(srm + (pos_)), t1v_ = *(const LAS i32x4*)(srm + (pos_) + 4); \
          U_DOT1(R, 0, t0v_[0]); U_DOT1(R, 1, t0v_[1]); U_DOT1(R, 2, t0v_[2]); U_DOT1(R, 3, t0v_[3]); U_DOT1(R, 4, t1v_[0]); U_DOT1(R, 5, t1v_[1]); U_DOT1(R, 6, t1v_[2]); U_DOT1(R, 7, t1v_[3]); } \
        typedef unsigned u2s_ __attribute__((ext_vector_type(2))); \
        const u2s_ w0_ = __builtin_amdgcn_permlane32_swap((unsigned)pd_[0], (unsigned)pd_[4], false, false), w1_ = __builtin_amdgcn_permlane32_swap((unsigned)pd_[1], (unsigned)pd_[5], false, false); \
        const u2s_ w2_ = __builtin_amdgcn_permlane32_swap((unsigned)pd_[2], (unsigned)pd_[6], false, false), w3_ = __builtin_amdgcn_permlane32_swap((unsigned)pd_[3], (unsigned)pd_[7], false, false); \
        const int k0_ = (int)(w0_.x + w0_.y), k1_ = (int)(w1_.x + w1_.y), k2_ = (int)(w2_.x + w2_.y), k3_ = (int)(w3_.x + w3_.y);     \
        const u2s_ y0_ = __builtin_amdgcn_permlane16_swap((unsigned)k0_, (unsigned)k2_, false, false), y1_ = __builtin_amdgcn_permlane16_swap((unsigned)k1_, (unsigned)k3_, false, false); \
        const int m0_ = (int)(y0_.x + y0_.y), m1_ = (int)(y1_.x + y1_.y);                  \
        int kk_ = b3 ? m1_ : m0_; const int tt_ = b3 ? m0_ : m1_; \
        kk_ += __builtin_amdgcn_update_dpp(0, tt_, 0x128, 0xf, 0xf, false);            \
        kk_ += __builtin_amdgcn_update_dpp(0, kk_, 0x141, 0xf, 0xf, false);            \
        kk_ += __builtin_amdgcn_update_dpp(0, kk_, 0xB1, 0xf, 0xf, false);             \
        kk_ += __builtin_amdgcn_update_dpp(0, kk_, 0x4E, 0xf, 0xf, false);             \
        if ((lu & 7) == 0) { const int p_ = (pos_) + (lu >> 3); const float hid_ = (float)kk_ * shs[p_]; sa[p_] = gelu_erf(hid_) * sa[p_]; } } while (0)
        U_LOAD(rA, 0);
#pragma unroll 1
        for (int m = 0; m < 64; m += 2) {
            U_LOAD(rB, 8 * m + 8);  U_COMP(rA, 8 * m);
            U_LOAD(rA, (m + 2 < 64 ? 8 * m + 16 : 0));  U_COMP(rB, 8 * m + 8);
        }
#undef U_LOAD
#undef U_DOT1
#undef U_COMP
    }
    LDS_WAIT(); asm volatile("" ::: "memory");
}
__device__ __forceinline__ void peer_gather_v(const Params& P, LAS unsigned char* lds, int tok0, int wave) {
    typedef int i32x4_ __attribute__((ext_vector_type(4)));
    LAS unsigned char* wsb = lds + PL_WS + wave * PL_WSB;
    LAS int* srm = (LAS int*)(wsb + GL_RM); LAS float* sa = (LAS float*)(wsb + GL_SA);
    const unsigned char* VQ = P.ws + WS_V; const bf16* X1B = (const bf16*)(P.ws + WS_X1B);
    const int lv = fresh_lane(); const unsigned vlo = (unsigned)lv * 16u;
    float amax[4] = {0.f, 0.f, 0.f, 0.f};
#pragma unroll
    for (int i = 0; i < 8; ++i) { const int p = lv + 64 * i; const float av = fabsf(sa[p]); const int tk = (srm[p] >> 14) & 3;
        amax[0] = fmaxf(amax[0], tk == 0 ? av : 0.f); amax[1] = fmaxf(amax[1], tk == 1 ? av : 0.f); amax[2] = fmaxf(amax[2], tk == 2 ? av : 0.f); amax[3] = fmaxf(amax[3], tk == 3 ? av : 0.f); }
#pragma unroll
    for (int o = 1; o < 64; o <<= 1) { amax[0] = fmaxf(amax[0], __shfl_xor(amax[0], o)); amax[1] = fmaxf(amax[1], __shfl_xor(amax[1], o)); amax[2] = fmaxf(amax[2], __shfl_xor(amax[2], o)); amax[3] = fmaxf(amax[3], __shfl_xor(amax[3], o)); }
    { float inv[4];
#pragma unroll
      for (int t = 0; t < 4; ++t) inv[t] = amax[t] > 0.f ? 127.0f / amax[t] : 0.f;
#pragma unroll
      for (int i = 0; i < 8; ++i) { const int p = lv + 64 * i; const int tk = (srm[p] >> 14) & 3; const float iv = tk == 0 ? inv[0] : tk == 1 ? inv[1] : tk == 2 ? inv[2] : inv[3];
          const int q = __float2int_rn(sa[p] * iv); ((LAS int*)sa)[p] = (q & 255) | (tk << 8); } }
    LDS_WAIT(); asm volatile("" ::: "memory");
    i32x4_ acc[16];
#pragma unroll
    for (int j = 0; j < 16; ++j) acc[j] = (i32x4_){0, 0, 0, 0};
    {
        const int li = lv & 3;
        v4u rA[8], rB[8], rC[8], rD[8];
#define V_LOAD(R, pos_) do { const i32x4 e0_ = *(const LAS i32x4*)(srm + (pos_)) & 0x3fff, e1_ = *(const LAS i32x4*)(srm + (pos_) + 4) & 0x3fff; \
        R[0] = *(const v4u*)(VQ + (((unsigned)e0_[0] << 10) + vlo)); R[1] = *(const v4u*)(VQ + (((unsigned)e0_[1] << 10) + vlo)); R[2] = *(const v4u*)(VQ + (((unsigned)e0_[2] << 10) + vlo)); R[3] = *(const v4u*)(VQ + (((unsigned)e0_[3] << 10) + vlo)); \
        R[4] = *(const v4u*)(VQ + (((unsigned)e1_[0] << 10) + vlo)); R[5] = *(const v4u*)(VQ + (((unsigned)e1_[1] << 10) + vlo)); R[6] = *(const v4u*)(VQ + (((unsigned)e1_[2] << 10) + vlo)); R[7] = *(const v4u*)(VQ + (((unsigned)e1_[3] << 10) + vlo)); } while (0)
#define V_QUAD(r0_, r1_, r2_, r3_, aop_, j_) do { \
        const unsigned l01_ = __builtin_amdgcn_perm(r1_, r0_, 0x05010400u), h01_ = __builtin_amdgcn_perm(r1_, r0_, 0x07030602u); \
        const unsigned l23_ = __builtin_amdgcn_perm(r3_, r2_, 0x05010400u), h23_ = __builtin_amdgcn_perm(r3_, r2_, 0x07030602u); \
        acc[4 * (j_) + 0] = __builtin_amdgcn_mfma_i32_4x4x4i8((int)(aop_), (int)__builtin_amdgcn_perm(l23_, l01_, 0x05040100u), acc[4 * (j_) + 0], 0, 0, 0); \
        acc[4 * (j_) + 1] = __builtin_amdgcn_mfma_i32_4x4x4i8((int)(aop_), (int)__builtin_amdgcn_perm(l23_, l01_, 0x07060302u), acc[4 * (j_) + 1], 0, 0, 0); \
        acc[4 * (j_) + 2] = __builtin_amdgcn_mfma_i32_4x4x4i8((int)(aop_), (int)__builtin_amdgcn_perm(h23_, h01_, 0x05040100u), acc[4 * (j_) + 2], 0, 0, 0); \
        acc[4 * (j_) + 3] = __builtin_amdgcn_mfma_i32_4x4x4i8((int)(aop_), (int)__builtin_amdgcn_perm(h23_, h01_, 0x07060302u), acc[4 * (j_) + 3], 0, 0, 0); } while (0)
#define V_AOP(c0_, c1_, c2_, c3_) (((((c0_) >> 8) == li) ? ((unsigned)(c0_) & 255u) : 0u) | ((((c1_) >> 8) == li) ? (((unsigned)(c1_) & 255u) << 8) : 0u) | ((((c2_) >> 8) == li) ? (((unsigned)(c2_) & 255u) << 16) : 0u) | ((((c3_) >> 8) == li) ? (((unsigned)(c3_) & 255u) << 24) : 0u))
#define V_COMP(R, pos_) do { const i32x4 c0_ = *(const LAS i32x4*)((const LAS int*)sa + (pos_)), c1_ = *(const LAS i32x4*)((const LAS int*)sa + (pos_) + 4); \
        const unsigned a0_ = V_AOP(c0_[0], c0_[1], c0_[2], c0_[3]), a1_ = V_AOP(c1_[0], c1_[1], c1_[2], c1_[3]); \
        V_QUAD(R[0].x, R[1].x, R[2].x, R[3].x, a0_, 0); V_QUAD(R[0].y, R[1].y, R[2].y, R[3].y, a0_, 1); V_QUAD(R[0].z, R[1].z, R[2].z, R[3].z, a0_, 2); V_QUAD(R[0].w, R[1].w, R[2].w, R[3].w, a0_, 3); \
        V_QUAD(R[4].x, R[5].x, R[6].x, R[7].x, a1_, 0); V_QUAD(R[4].y, R[5].y, R[6].y, R[7].y, a1_, 1); V_QUAD(R[4].z, R[5].z, R[6].z, R[7].z, a1_, 2); V_QUAD(R[4].w, R[5].w, R[6].w, R[7].w, a1_, 3); } while (0)
        V_LOAD(rA, 0); V_LOAD(rB, 8); V_LOAD(rC, 16);
#pragma unroll 1
        for (int m = 0; m < 64; m += 4) {
            V_LOAD(rD, 8 * m + 24);  V_COMP(rA, 8 * m);
            V_LOAD(rA, (m + 4 < 64 ? 8 * m + 32 : 0));  V_COMP(rB, 8 * m + 8);
            V_LOAD(rB, (m + 5 < 64 ? 8 * m + 40 : 0));  V_COMP(rC, 8 * m + 16);
            V_LOAD(rC, (m + 6 < 64 ? 8 * m + 48 : 0));  V_COMP(rD, 8 * m + 24);
        }
#undef V_LOAD
#undef V_QUAD
#undef V_AOP
#undef V_COMP
    }
    const int le = fresh_lane();
#pragma unroll
    for (int tk = 0; tk < 4; ++tk) { const size_t t = (size_t)(tok0 + wave * 4 + tk); const float sc = amax[tk] * (1.0f / 127.0f);
        const v4u xa = *(const v4u*)(X1B + t * DM + le * 16), xb = *(const v4u*)(X1B + t * DM + le * 16 + 8); float* orow = P.out + t * DM + le * 16;
        const unsigned xw[8] = {xa.x, xa.y, xa.z, xa.w, xb.x, xb.y, xb.z, xb.w};
#pragma unroll
        for (int j = 0; j < 4; ++j) *(f32x4*)(orow + 4 * j) = (f32x4){pg8::bflo(xw[2 * j]) + sc * (float)acc[4 * j][tk], pg8::bfhi(xw[2 * j]) + sc * (float)acc[4 * j + 1][tk], pg8::bflo(xw[2 * j + 1]) + sc * (float)acc[4 * j + 2][tk], pg8::bfhi(xw[2 * j + 1]) + sc * (float)acc[4 * j + 3][tk]}; }
}

__device__ __forceinline__ void topk_part(const Params& P, LAS unsigned char* lds, int item, int wave, int parity) {
    const int lane = fresh_lane();
    const int tok0 = item * 32, hh = lane >> 5, l31 = lane & 31;
    LAS unsigned short* idxs = (LAS unsigned short*)(lds + parity * PL_BUF);
    LAS _Float16* gates = (LAS _Float16*)(lds + parity * PL_BUF + PL_GATE);
    const bf16* Q = (const bf16*)(P.ws + WS_Q); const bf16* SK = (const bf16*)(P.ws + WS_SK);
    unsigned L0[16], L1[16];
#pragma unroll
    for (int p = 0; p < 2; ++p) {
        f32x16 acc[4];
        { LAS unsigned char* tb = lds + PL_WS + wave * PL_WSB;
          const int r8 = lane >> 3, ch = lane & 7;
          v4u tq[4], t0[4], t1[4];
#pragma unroll
          for (int c = 0; c < 4; ++c) tq[c] = *(const v4u*)(Q + (size_t)(tok0 + r8 + 8 * c) * DM + wave * 128 + p * 64 + 8 * ch);
          const bf16* skp = SK + (size_t)((wave * 2 + p) * 128 + r8) * 64 + 8 * ch;
#pragma unroll
          for (int c = 0; c < 4; ++c) t0[c] = *(const v4u*)(skp + (size_t)(8 * c) * 64);
#pragma unroll
          for (int c = 0; c < 4; ++c) *(LAS v4u*)(tb + (r8 + 8 * c) * 144 + 16 * ch) = tq[c];
          bf16x8 bq[4];
#pragma unroll
          for (int ks = 0; ks < 4; ++ks) bq[ks] = *(const LAS bf16x8*)(tb + l31 * 144 + 32 * ks + 16 * hh);
#define TK_TILE(TC, TN, nt_) do { \
          _Pragma("unroll") for (int c = 0; c < 4; ++c) *(LAS v4u*)(tb + (r8 + 8 * c) * 144 + 16 * ch) = TC[c]; \
          if ((nt_) + 1 < 4) { _Pragma("unroll") for (int c = 0; c < 4; ++c) TN[c] = *(const v4u*)(skp + (size_t)(32 * ((nt_) + 1) + 8 * c) * 64); } \
          acc[nt_] = f32x16{}; \
          _Pragma("unroll") for (int ks = 0; ks < 4; ++ks) acc[nt_] = __builtin_amdgcn_mfma_f32_32x32x16_bf16(*(const LAS bf16x8*)(tb + l31 * 144 + 32 * ks + 16 * hh), bq[ks], acc[nt_], 0, 0, 0); } while (0)
          TK_TILE(t0, t1, 0); TK_TILE(t1, t0, 1); TK_TILE(t0, t1, 2); TK_TILE(t1, t0, 3);
#undef TK_TILE
        }
        unsigned G0[16], G1[16], G2[16], G3[16];
#pragma unroll
        for (int r = 0; r < 16; ++r) { const unsigned n = (unsigned)((r & 3) + 8 * (r >> 2)) + 4u * (unsigned)hh;
            const float a0_ = acc[0][r], a1_ = acc[1][r], a2_ = acc[2][r], a3_ = acc[3][r];
            G0[r] = (__builtin_bit_cast(unsigned, a0_) & ~127u) | n; G1[r] = (__builtin_bit_cast(unsigned, a1_) & ~127u) | (n + 32u); G2[r] = (__builtin_bit_cast(unsigned, a2_) & ~127u) | (n + 64u); G3[r] = (__builtin_bit_cast(unsigned, a3_) & ~127u) | (n + 96u); }
        BSORT16(G0); BSORT16(G1); BSORT16(G2); BSORT16(G3);
        TOPMERGE16(G0, G1); TOPMERGE16(G2, G3); TOPMERGE16(G0, G2);
#pragma unroll
        for (int i = 0; i < 16; ++i) { if (p == 0) L0[i] = G0[i]; else L1[i] = G0[i]; }
        __builtin_amdgcn_sched_barrier(0);
    }
    {
        unsigned O0[16], O1[16];
#pragma unroll
        for (int i = 0; i < 16; ++i) { O0[i] = (unsigned)__shfl_xor((int)L0[i], 32); O1[i] = (unsigned)__shfl_xor((int)L1[i], 32); }
        TOPMERGE16(L0, O0); TOPMERGE16(L1, O1);
    }
    {
        float s1[16], s2[16]; unsigned K[16];
        LAS int* tab = (LAS int*)(lds + PL_WS + wave * PL_WSB);
#pragma unroll
        for (int i = 0; i < 16; ++i) { s1[i] = __builtin_bit_cast(float, L0[i] & ~127u); s2[i] = __builtin_bit_cast(float, L1[i] & ~127u); tab[i * 64 + lane] = (int)(L0[i] & 127u); tab[1024 + i * 64 + lane] = (int)(L1[i] & 127u); K[i] = 0xff800000u; }
        PairIns<0, 0>::run(s1, s2, K);
        float e[16], sum = 0.f; const float v0 = __builtin_bit_cast(float, K[0] & ~255u);
#pragma unroll
        for (int i = 0; i < 16; ++i) { e[i] = __expf(__builtin_bit_cast(float, K[i] & ~255u) - v0); sum += e[i]; }
        const float rs = 1.0f / sum;
        LDS_WAIT();
        if (hh == 0) {
#pragma unroll
            for (int i = 0; i < 16; ++i) { const int a_ = (int)((K[i] >> 4) & 15u), b_ = (int)(K[i] & 15u);
                idxs[l31 * 128 + wave * 16 + i] = (unsigned short)(tab[a_ * 64 + lane] * 128 + tab[1024 + b_ * 64 + lane]); gates[l31 * 128 + wave * 16 + i] = (_Float16)(e[i] * rs); }
        }
    }
}

constexpr int NPHASE = 8;
__global__ void __launch_bounds__(NWAVES * 64, 2) mk_fwd(Params P) {
    extern __shared__ __attribute__((aligned(16))) unsigned char lds_raw[];
    LAS unsigned char* lds = (LAS unsigned char*)lds_raw;
    const int wave = __builtin_amdgcn_readfirstlane((int)threadIdx.x >> 6);
    const int G = gridDim.x;
    unsigned char* ws = P.ws;
#if MK_FUSED
    { const int l0 = fresh_lane(); for (int u = wave * 64 + l0; u < (LDS_BYTES - LDS_CTL) / 4; u += NWAVES * 64) ((LAS unsigned*)(lds + LDS_CTL))[u] = 0u; }
    __syncthreads();
    const XcdBarrier xbar = xcd_barrier_post((unsigned*)(ws + WS_CTL) + 4096, (volatile LAS unsigned*)(lds + LDS_CTL + 320) + 8, wave * 64 + fresh_lane());
#define SEAM0() cg::this_grid().sync()
#define SEAM() xcd_barrier(xbar, wave * 64 + fresh_lane())
#else
#define SEAM0() do {} while (0)
#define SEAM() do {} while (0)
#endif
#ifndef PHASE_MASK
#define PHASE_MASK 0xff
#endif
#define IN(k) (((PHASE_MASK >> (k)) & 1) && P.ph_lo <= (k) && (k) < P.ph_hi)
    bf16* XN = (bf16*)((unsigned char*)P.out + OUT_XN); bf16* MERGED = (bf16*)((unsigned char*)P.out + OUT_MERGED);
    bf16* YA = (bf16*)((unsigned char*)P.out + OUT_YA); bf16* YB = (bf16*)((unsigned char*)P.out + OUT_YB);
    bf16* PROJ = (bf16*)(ws + WS_PROJ);
    float* sumsq = (float*)(ws + WS_SUMSQ);

    if (IN(0)) {
        unsigned* sb = (unsigned*)(ws + WS_CTL) + 12000;
        p0_prologue_a(P, lds, wave, fresh_lane(), 0);
#if MK_FUSED
        asm volatile("s_waitcnt vmcnt(0)" ::: "memory"); __syncthreads();
        if (wave == 0 && fresh_lane() == 0) { __builtin_amdgcn_fence(__ATOMIC_RELEASE, "agent"); asm volatile("s_waitcnt vmcnt(0)" ::: "memory"); (void)__hip_atomic_fetch_add(sb, 1u, __ATOMIC_RELAXED, __HIP_MEMORY_SCOPE_AGENT); }
#endif
        p0_prologue_a(P, lds, wave, fresh_lane(), 1);
#if MK_FUSED
        if (wave == 0 && fresh_lane() == 0) { unsigned sp = 0; while (__hip_atomic_load(sb, __ATOMIC_RELAXED, __HIP_MEMORY_SCOPE_AGENT) < (unsigned)G) { __builtin_amdgcn_s_sleep(2); if (++sp > (1u << 22)) break; }
            __builtin_amdgcn_fence(__ATOMIC_ACQUIRE, "agent"); asm volatile("s_waitcnt vmcnt(0)" ::: "memory"); }
        __syncthreads();
#endif
        p0_prologue_b(P, lds, wave, fresh_lane()); SEAM0(); }
    if (IN(1)) {
        pg8::Gemm g{XN, (const bf16*)(ws + WS_WIN), MTOK, NIN, DM / 2};
        pg8::StaticOrder S; S.init(MTOK, NIN, G, (int)blockIdx.x);
        pg8::EpiProj E{PROJ, P.hg_lb, P.q_norm_g, P.k_norm_g, (const float*)(ws + WS_SXN), (const float*)(ws + WS_SW), (bf16*)((unsigned char*)P.out + OUT_KI)};
        pg8::gemm_phase<pg8::EpiProj, pg8::StaticOrder, true, true, true>(lds, g, S, E, wave);
        { const int nunits = (MTOK / 256) * (NIN / 256), rem = nunits % G;
          const int lq = fresh_lane();
          if (rem == 0) quant_tables(P, (int)blockIdx.x, G, wave, lq); else if ((int)blockIdx.x >= rem) quant_tables(P, (int)blockIdx.x - rem, G - rem, wave, lq); }
        SEAM();
    }
    if (IN(2)) {
        const int lane2 = fresh_lane();
        const int nh = (G >= 128) ? 64 : 0;
        if (nh) { if ((int)blockIdx.x < nh) hgrn_chunked_item(P, lds, (int)blockIdx.x, wave, lane2); }
        else { for (int it = (int)blockIdx.x; it < BATCH * 4; it += G) hgrn_chunked_item(P, lds, it, wave, lane2); }
        {
            float mq = fabsf(P.q_norm_g[lane2]), mk = fabsf(P.k_norm_g[lane2]);
#pragma unroll
            for (int o = 1; o < 64; o <<= 1) { mq = fmaxf(mq, __shfl_xor(mq, o)); mk = fmaxf(mk, __shfl_xor(mk, o)); }
            const float Mfix = 8.0f * 1.4426950408889634f * 1.02f * mq * mk;
            unsigned* ctr = (unsigned*)(ws + WS_CTL) + 8192;
            for (;;) { if (wave == 0 && lane2 == 0) *(volatile LAS unsigned*)(lds + AT_TSK) = __hip_atomic_fetch_add(ctr, 1u, __ATOMIC_RELAXED, __HIP_MEMORY_SCOPE_AGENT);
                __syncthreads();
                const int task = __builtin_amdgcn_readfirstlane((int)*(volatile LAS unsigned*)(lds + AT_TSK)); if (task >= BATCH * 4 * 4) break;
                attn_wg_task(P, lds, task, wave, lane2, Mfix); }
        }
        SEAM();
    }
    if (IN(3)) {
        { pg8::Gemm g{YA, (const bf16*)(ws + WS_WA), MTOK, DM, 512}; pg8::StaticOrder S; S.init(MTOK, DM, G, (int)blockIdx.x);
          pg8::EpiGate<0> E{MERGED, PROJ + 4352};
          pg8::gemm_phase<pg8::EpiGate<0>, pg8::StaticOrder, true, true>(lds, g, S, E, wave); }
        VM_WAIT(); __syncthreads();
        { pg8::Gemm g{YB, (const bf16*)(ws + WS_WB), MTOK, DM, 256}; pg8::StaticOrder S; S.init(MTOK, DM, G, (int)blockIdx.x);
          pg8::EpiGate<1> E{MERGED, PROJ + 5376};
          pg8::gemm_phase<pg8::EpiGate<1>, pg8::StaticOrder, true, true>(lds, g, S, E, wave); }
        SEAM();
    }
    if (IN(4)) {
        pg8::Gemm g{MERGED, (const bf16*)(ws + WS_WOUT), MTOK, DM, DM}; pg8::StaticOrder S; S.init(MTOK, DM, G, (int)blockIdx.x);
        pg8::EpiResid E{P.x, (bf16*)(ws + WS_X1B), sumsq};
        pg8::gemm_phase<pg8::EpiResid, pg8::StaticOrder, true, true>(lds, g, S, E, wave);
        SEAM();
    }
    if (IN(5)) {
        pg8::Gemm g{(const bf16*)(ws + WS_X1B), (const bf16*)(ws + WS_WQ), MTOK, DM, DM}; pg8::StaticOrder S; S.init(MTOK, DM, G, (int)blockIdx.x);
        pg8::EpiRowScale E{(bf16*)(ws + WS_Q), sumsq};
        pg8::gemm_phase<pg8::EpiRowScale, pg8::StaticOrder, true, true>(lds, g, S, E, wave);
        SEAM();
    }
    if (IN(6)) {
        const int nit = (MTOK / 32 - (int)blockIdx.x + G - 1) / G;
        if (nit > 0) topk_part(P, lds, (int)blockIdx.x, wave, 0);
        __syncthreads();
#pragma unroll 1
        for (int k = 0; k < nit; ++k) {
            const int item = (int)blockIdx.x + k * G;
            peer_gather_u(P, lds, item * 32, wave, fresh_lane(), k & 1);
            if (wave < 4) { __builtin_amdgcn_s_setprio(2); peer_gather_v(P, lds, item * 32, wave); __builtin_amdgcn_s_setprio(0); if (k + 1 < nit) topk_part(P, lds, item + G, wave, (k + 1) & 1); }
            else { if (k + 1 < nit) topk_part(P, lds, item + G, wave, (k + 1) & 1); __builtin_amdgcn_s_setprio(2); peer_gather_v(P, lds, item * 32, wave); __builtin_amdgcn_s_setprio(0); }
            __syncthreads();
        }
    }
#undef IN
#undef SEAM
#undef SEAM0
}

extern "C" void kernel_launch(void* const* d_in, const int* in_sizes, int n_in, void* d_out, int out_size, void* d_ws, size_t ws_size, hipStream_t stream) {
    static int grid = 0;
    if (grid == 0) {
        if (n_in != 15 || in_sizes[0] != MTOK * DM || out_size != MTOK * DM || ws_size < WS_END) {
            fprintf(stderr, "kernel_launch: unexpected shapes (n_in %d, in0 %d, out %d, ws %zu); nothing launched\n", n_in, n_in > 0 ? in_sizes[0] : -1, out_size, ws_size); grid = -1; return; }
        int dev = 0, cus = 0, per_cu = 0;
        if (hipGetDevice(&dev) != hipSuccess || hipDeviceGetAttribute(&cus, hipDeviceAttributeMultiprocessorCount, dev) != hipSuccess) { fprintf(stderr, "kernel_launch: device query failed\n"); grid = -1; return; }
        if (hipFuncSetAttribute((const void*)mk_fwd, hipFuncAttributeMaxDynamicSharedMemorySize, LDS_BYTES) != hipSuccess) { fprintf(stderr, "kernel_launch: hipFuncSetAttribute failed\n"); grid = -1; return; }
        if (hipOccupancyMaxActiveBlocksPerMultiprocessor(&per_cu, (const void*)mk_fwd, NWAVES * 64, LDS_BYTES) != hipSuccess || per_cu < 1) { fprintf(stderr, "kernel_launch: occupancy query says %d blocks per CU\n", per_cu); per_cu = 1; }
        (void)hipGetLastError();
        grid = cus;
        fprintf(stderr, "kernel_launch: %d CUs, occupancy query %d per CU, grid %d\n", cus, per_cu, grid);
    }
    if (grid < 0) return;
    (void)hipMemsetAsync((char*)d_ws + WS_CTL, 0, CTL_ZERO_BYTES, stream);
    Params p{};
    p.x = (const float*)d_in[0]; p.norm1_g = (const float*)d_in[1]; p.w_in = (const float*)d_in[2]; p.hg_norm_g = (const float*)d_in[3]; p.hg_lb = (const float*)d_in[4];
    p.q_norm_g = (const float*)d_in[5]; p.k_norm_g = (const float*)d_in[6]; p.w_a = (const float*)d_in[7]; p.w_b = (const float*)d_in[8]; p.w_out = (const float*)d_in[9];
    p.norm2_g = (const float*)d_in[10]; p.peer_wq = (const float*)d_in[11]; p.peer_sk = (const float*)d_in[12]; p.peer_u = (const float*)d_in[13]; p.peer_v = (const float*)d_in[14];
    p.out = (float*)d_out; p.ws = (unsigned char*)d_ws;
#if MK_FUSED
    p.ph_lo = 0; p.ph_hi = NPHASE;
    void* args[] = {&p};
    hipError_t e = hipLaunchCooperativeKernel((const void*)mk_fwd, dim3(grid), dim3(NWAVES * 64), args, LDS_BYTES, stream);
    if (e != hipSuccess) fprintf(stderr, "kernel_launch: cooperative launch failed: %s (grid %d)\n", hipGetErrorString(e), grid);
#else
    for (int ph = 0; ph < 7; ++ph) { p.ph_lo = ph; p.ph_hi = ph + 1; hipLaunchKernelGGL(mk_fwd, dim3(grid), dim3(NWAVES * 64), LDS_BYTES, stream, p); }
#endif
}
```

```cpp
#include <hip/hip_runtime.h>
#include <hip/hip_cooperative_groups.h>
#include <cstdio>
#include <cstdint>
#include <cmath>
namespace cg = cooperative_groups;
#ifndef MK_FUSED
#define MK_FUSED 1
#endif
namespace pg8 {
#define PG8_LAS __attribute__((address_space(3)))
typedef unsigned short bf16_t;
typedef short bf16x8 __attribute__((ext_vector_type(8)));
typedef float f32x4 __attribute__((ext_vector_type(4)));
typedef unsigned u32x4 __attribute__((ext_vector_type(4)));
constexpr int BM = 256, BK = 64, HALF = 128, HTB = HALF * BK * 2  , STAGE_BYTES = 8 * HTB, NXCD = 8, WGM = 8;

__host__ __device__ __forceinline__ int lds_byte(int r, int c) { const int st = (r >> 4) * 2 + (c >> 5), rr = r & 15, cc = c & 31, ob = rr * 64 + cc * 2; return st * 1024 + (ob ^ (((ob >> 9) & 1) << 5)); }
__host__ __device__ __forceinline__ void stage_rc(int b, int& R, int& C) { const int st = b / 1024, sb = b % 1024, swz = sb ^ (((sb >> 9) & 1) << 5); R = (st >> 1) * 16 + swz / 64; C = (st & 1) * 32 + (swz % 64) / 2; }
__host__ __device__ __forceinline__ int perm32(int rho) { const int n = rho >> 4, i = rho & 15; return 8 * (i >> 2) + 4 * n + (i & 3); }

struct Unit { int pm, pn; };
struct Gemm { const bf16_t* A; const bf16_t* Bt; int M, N, K; };

struct StaticOrder {
    bool swap02 = false;
    int nM, nN, nwg, G, c, ibase = 0, ilim = 1 << 30;
    __host__ __device__ void init(int M, int N, int G_, int c_) { nM = M / BM; nN = N / BM; nwg = nM * nN; G = G_; c = c_; }
    __host__ __device__ bool next(int i, Unit& u) const {
        i += ibase; if (i >= ilim) return false;
        const long L = (long)i * G + c; if (L >= nwg) return false;
        int wgid = (int)L; { const int q = nwg / NXCD, r = nwg % NXCD, xcd = wgid % NXCD, off = wgid / NXCD; wgid = (xcd < r ? xcd * (q + 1) : r * (q + 1) + (xcd - r) * q) + off; }
        const int nig = WGM * nN, gid = wgid / nig, fm = gid * WGM, gsz = (nM - fm) < WGM ? (nM - fm) : WGM;
        u.pm = fm + ((wgid % nig) % gsz); u.pn = (wgid % nig) / gsz;
        if (swap02 && (gid & 1)) { if (u.pn == 0) u.pn = 2; else if (u.pn == 2) u.pn = 0; }
        return true;
    }
    __device__ __forceinline__ void a_ready(const Unit&) const {}
    __device__ __forceinline__ void done(const Unit&) const {}
};

__device__ __forceinline__ unsigned cvt_pk_bf16(float lo, float hi) { unsigned r; asm volatile("v_cvt_pk_bf16_f32 %0, %1, %2" : "=v"(r) : "v"(lo), "v"(hi)); return r; }
typedef float f32x2 __attribute__((ext_vector_type(2)));
__device__ __forceinline__ f32x2 gelu_pk(f32x2 v) {
    const f32x2 av = __builtin_elementwise_abs(v), d = av * 0.2316418882f + 1.0f;
    f32x2 t; t.x = __builtin_amdgcn_rcpf(d.x); t.y = __builtin_amdgcn_rcpf(d.y);
    f32x2 q = t * 0.5307027145f + (-0.7265760135f); q = q * t + 0.7107068705f; q = q * t + (-0.142248368f); q = q * t + 0.127414796f; q = q * t;
    const f32x2 s = (v * v) * (-0.72134752044f);
    f32x2 e; e.x = __builtin_amdgcn_exp2f(s.x); e.y = __builtin_amdgcn_exp2f(s.y);
    const f32x2 m = v * (q * e), r = v - m;
    f32x2 o; o.x = v.x < 0.f ? m.x : r.x; o.y = v.y < 0.f ? m.y : r.y; return o;
}

template <int ACT  > struct EpiBf16 {
    static constexpr bool PERM = true, AFTER_DRAIN = false; static_assert(ACT == 0 || ACT == 1, "EpiBf16: ACT is 0 (none) or 1 (gelu_pk)");
    bf16_t* O; int ldc; const float* bias; int split_cols; size_t split_stride; float scale0;
    __device__ __forceinline__ void operator()(const f32x4 (&acc)[2][2][4][2], const Unit& u, int wr, int wc, int fr, int fq) const {
        const int row0 = u.pm * BM + wr * 64 + fr; int colt = u.pn * BM; bf16_t* base = O;
        float sc = 1.f; if (split_cols) { const int t = colt / split_cols; base += (size_t)t * split_stride; colt -= t * split_cols; if (t == 0) sc = scale0; }
        const int col0 = colt + wc * 32 + 8 * fq, bcol0 = u.pn * BM + wc * 32 + 8 * fq;
        f32x4 bv[2][2];
#pragma unroll
        for (int bj = 0; bj < 2; ++bj)
#pragma unroll
            for (int n = 0; n < 2; ++n) bv[bj][n] = bias ? *(const f32x4*)(bias + bcol0 + bj * HALF + 4 * n) : (f32x4){0.f, 0.f, 0.f, 0.f};
#pragma unroll
        for (int ai = 0; ai < 2; ++ai)
#pragma unroll
            for (int m = 0; m < 4; ++m) { bf16_t* rowp = base + (size_t)(row0 + ai * HALF + m * 16) * ldc + col0;
#pragma unroll
                for (int bj = 0; bj < 2; ++bj) { f32x4 v0 = acc[ai][bj][m][0] + bv[bj][0], v1 = acc[ai][bj][m][1] + bv[bj][1];
                    if (ACT == 1) { f32x2 a = gelu_pk((f32x2){v0[0], v0[1]}), b = gelu_pk((f32x2){v0[2], v0[3]}), c = gelu_pk((f32x2){v1[0], v1[1]}), d = gelu_pk((f32x2){v1[2], v1[3]});
                        v0 = (f32x4){a.x, a.y, b.x, b.y}; v1 = (f32x4){c.x, c.y, d.x, d.y}; }
                    v0 = v0 * sc; v1 = v1 * sc; u32x4 w; w.x = cvt_pk_bf16(v0[0], v0[1]); w.y = cvt_pk_bf16(v0[2], v0[3]); w.z = cvt_pk_bf16(v1[0], v1[1]); w.w = cvt_pk_bf16(v1[2], v1[3]);
                    *(u32x4*)(rowp + bj * HALF) = w; } }
    }
};

__device__ __forceinline__ float bf2f(unsigned short b) { return __builtin_bit_cast(float, (unsigned)b << 16); }
__device__ __forceinline__ float bflo(unsigned w) { return __builtin_bit_cast(float, w << 16); }
__device__ __forceinline__ float bfhi(unsigned w) { return __builtin_bit_cast(float, w & 0xffff0000u); }
__device__ __forceinline__ float sigmoidf_(float v) { return __builtin_amdgcn_rcpf(1.0f + __expf(-v)); }
constexpr int PROJ_LD = 6400;
constexpr float NORM_EPS_ = 1e-6f;
constexpr float QSCALE = 0.125f * 1.4426950408889634f;

struct EpiProj {
    static constexpr bool PERM = true, AFTER_DRAIN = false;
    bf16_t* O; const float* lbl; const float* gq; const float* gk; const float* sxn; const float* sw; bf16_t* KIO;
    __device__ __forceinline__ void operator()(const f32x4 (&acc)[2][2][4][2], const Unit& u, int wr, int wc, int fr, int fq) const {
        const int pn = u.pn;
        int type;
        if (pn < 2) type = 1; else if (pn < 4) type = 2; else if (pn < 6) type = 0; else if (pn < 8) type = 3; else if (pn < 11) type = 4; else if (pn < 14) type = 5; else if (pn < 17) type = 0; else type = 1;
        const int row0 = u.pm * BM + wr * 64 + fr;
        const int colL0 = pn * BM + wc * 64 + 8 * fq;
        float aux[2][8];
#pragma unroll
        for (int bj = 0; bj < 2; ++bj)
#pragma unroll
            for (int e = 0; e < 8; ++e) aux[bj][e] = 1.0f;
        if (type == 2) {
#pragma unroll
            for (int bj = 0; bj < 2; ++bj)
#pragma unroll
                for (int e = 0; e < 8; ++e) { const int c = colL0 + 32 * bj + e - 512; aux[bj][e] = sigmoidf_(lbl[c] - lbl[512 + c]); }
        } else if (type == 4 || type == 5) {
            const float* g = (type == 4) ? gq : gk; const float sc = (type == 4) ? QSCALE : 1.0f;
#pragma unroll
            for (int bj = 0; bj < 2; ++bj)
#pragma unroll
                for (int e = 0; e < 8; ++e) aux[bj][e] = g[32 * bj + 8 * fq + e] * sc;
        }
        float swv[2][8];
#pragma unroll
        for (int bj = 0; bj < 2; ++bj)
#pragma unroll
            for (int e = 0; e < 8; ++e) swv[bj][e] = sw[pn * BM + bj * HALF + wc * 32 + 8 * fq + e];
        float carry[2][8];
#pragma unroll
        for (int bj = 0; bj < 2; ++bj)
#pragma unroll
            for (int e = 0; e < 8; ++e) carry[bj][e] = 0.f;
        float rscv[8];
#pragma unroll
        for (int q = 0; q < 8; ++q) rscv[q] = sxn[row0 + (q >> 2) * HALF + (q & 3) * 16];
        asm volatile("" ::: "memory");
#pragma unroll
        for (int ai = 0; ai < 2; ++ai)
#pragma unroll
            for (int m = 0; m < 4; ++m) {
                const float rsc = rscv[4 * ai + m];
                float v[2][8];
#pragma unroll
                for (int bj = 0; bj < 2; ++bj)
#pragma unroll
                    for (int n = 0; n < 2; ++n) { typedef int i32x4_ __attribute__((ext_vector_type(4))); const i32x4_ iv = __builtin_bit_cast(i32x4_, acc[ai][bj][m][n]);
#pragma unroll
                        for (int i = 0; i < 4; ++i) v[bj][4 * n + i] = (float)iv[i] * (rsc * swv[bj][4 * n + i]); }
                if (type == 1) {
#pragma unroll
                    for (int bj = 0; bj < 2; ++bj)
#pragma unroll
                        for (int e = 0; e < 8; ++e) v[bj][e] = sigmoidf_(v[bj][e]);
                } else if (type == 2) {
                    float ki[2][8];
#pragma unroll
                    for (int bj = 0; bj < 2; ++bj)
#pragma unroll
                        for (int e = 0; e < 8; ++e) { const float lb = aux[bj][e]; const float ex = fminf(__expf(-v[bj][e]), 1e30f), sg = __builtin_amdgcn_rcpf(1.0f + ex);
                            const float f = lb + (1.0f - lb) * sg, kk = (1.0f - lb) * (ex * sg);
                            float g = __builtin_amdgcn_logf(f);
                            g += __builtin_bit_cast(float, __builtin_amdgcn_update_dpp(0, __builtin_bit_cast(int, g), 0x111, 0xf, 0xf, true));
                            g += __builtin_bit_cast(float, __builtin_amdgcn_update_dpp(0, __builtin_bit_cast(int, g), 0x112, 0xf, 0xf, true));
                            g += __builtin_bit_cast(float, __builtin_amdgcn_update_dpp(0, __builtin_bit_cast(int, g), 0x114, 0xf, 0xf, true));
                            g += __builtin_bit_cast(float, __builtin_amdgcn_update_dpp(0, __builtin_bit_cast(int, g), 0x118, 0xf, 0xf, true));
                            if (m > 0) g += carry[bj][e];
                            if (m < 3) carry[bj][e] = __shfl(g, 16 * fq + 15);
                            v[bj][e] = __builtin_amdgcn_exp2f(g); ki[bj][e] = kk * __builtin_amdgcn_exp2f(-g); }
                    bf16_t* kp = KIO + (size_t)(row0 + ai * HALF + m * 16) * 512 + (colL0 - 512);
#pragma unroll
                    for (int bj = 0; bj < 2; ++bj) { u32x4 w; w.x = cvt_pk_bf16(ki[bj][0], ki[bj][1]); w.y = cvt_pk_bf16(ki[bj][2], ki[bj][3]); w.z = cvt_pk_bf16(ki[bj][4], ki[bj][5]); w.w = cvt_pk_bf16(ki[bj][6], ki[bj][7]);
                        *(u32x4*)(kp + 32 * bj) = w; }
                } else if (type == 3) {
#pragma unroll
                    for (int bj = 0; bj < 2; ++bj)
#pragma unroll
                        for (int e = 0; e < 8; ++e) v[bj][e] = v[bj][e] * sigmoidf_(v[bj][e]);
                } else if (type >= 4) {
                    float ss = 0.f;
#pragma unroll
                    for (int bj = 0; bj < 2; ++bj)
#pragma unroll
                        for (int e = 0; e < 8; ++e) ss += v[bj][e] * v[bj][e];
                    ss += __shfl_xor(ss, 16); ss += __shfl_xor(ss, 32);
                    const float rs = rsqrtf(ss * (1.0f / 64.0f) + NORM_EPS_);
#pragma unroll
                    for (int bj = 0; bj < 2; ++bj)
#pragma unroll
                        for (int e = 0; e < 8; ++e) v[bj][e] = v[bj][e] * rs * aux[bj][e];
                }
                bf16_t* rowp = O + (size_t)(row0 + ai * HALF + m * 16) * PROJ_LD + colL0;
#pragma unroll
                for (int bj = 0; bj < 2; ++bj) { u32x4 w; w.x = cvt_pk_bf16(v[bj][0], v[bj][1]); w.y = cvt_pk_bf16(v[bj][2], v[bj][3]); w.z = cvt_pk_bf16(v[bj][4], v[bj][5]); w.w = cvt_pk_bf16(v[bj][6], v[bj][7]);
                    __builtin_nontemporal_store(w, (u32x4*)(rowp + 32 * bj)); }
            }
    }
};

template <int SECOND> struct EpiGate {
    static constexpr bool PERM = true, AFTER_DRAIN = false;
    bf16_t* O; const bf16_t* gate;
    __device__ __forceinline__ void operator()(const f32x4 (&acc)[2][2][4][2], const Unit& u, int wr, int wc, int fr, int fq) const {
        const int row0 = u.pm * BM + wr * 64 + fr; const int col0 = u.pn * BM + wc * 32 + 8 * fq;
#pragma unroll
        for (int ai = 0; ai < 2; ++ai)
#pragma unroll
            for (int m = 0; m < 4; ++m) { const size_t r = (size_t)(row0 + ai * HALF + m * 16);
#pragma unroll
                for (int bj = 0; bj < 2; ++bj) { const int c = col0 + bj * HALF;
                    const u32x4 gw = *(const u32x4*)(gate + r * PROJ_LD + c);
                    float v[8];
#pragma unroll
                    for (int n = 0; n < 2; ++n)
#pragma unroll
                        for (int i = 0; i < 4; ++i) v[4 * n + i] = acc[ai][bj][m][n][i];
                    v[0] *= bflo(gw.x); v[1] *= bfhi(gw.x); v[2] *= bflo(gw.y); v[3] *= bfhi(gw.y); v[4] *= bflo(gw.z); v[5] *= bfhi(gw.z); v[6] *= bflo(gw.w); v[7] *= bfhi(gw.w);
                    if (SECOND) { const u32x4 tw = *(const u32x4*)(O + r * 1024 + c);
                        v[0] += bflo(tw.x); v[1] += bfhi(tw.x); v[2] += bflo(tw.y); v[3] += bfhi(tw.y); v[4] += bflo(tw.z); v[5] += bfhi(tw.z); v[6] += bflo(tw.w); v[7] += bfhi(tw.w); }
                    u32x4 w; w.x = cvt_pk_bf16(v[0], v[1]); w.y = cvt_pk_bf16(v[2], v[3]); w.z = cvt_pk_bf16(v[4], v[5]); w.w = cvt_pk_bf16(v[6], v[7]);
                    *(u32x4*)(O + r * 1024 + c) = w; asm volatile("" ::: "memory"); } }
    }
};

struct EpiResid {
    static constexpr bool PERM = true, AFTER_DRAIN = false;
    const float* X; bf16_t* X1B; float* sumsq;
    __device__ __forceinline__ void operator()(const f32x4 (&acc)[2][2][4][2], const Unit& u, int wr, int wc, int fr, int fq) const {
        const int row0 = u.pm * BM + wr * 64 + fr; const int col0 = u.pn * BM + wc * 32 + 8 * fq;
        f32x4 xv[2][8];
#define ER_LOAD(g_, buf_) do { _Pragma("unroll") for (int j = 0; j < 4; ++j) { const int ai = (g_) >> 1, m = 2 * ((g_) & 1) + (j >> 1), bj = j & 1; const size_t off = (size_t)(row0 + ai * HALF + m * 16) * 1024 + col0 + bj * HALF; \
            xv[buf_][2 * j] = __builtin_nontemporal_load((const f32x4*)(X + off)); xv[buf_][2 * j + 1] = __builtin_nontemporal_load((const f32x4*)(X + off + 4)); } } while (0)
        ER_LOAD(0, 0);
#pragma unroll
        for (int g = 0; g < 4; ++g) {
            if (g + 1 < 4) ER_LOAD(g + 1, (g + 1) & 1);
#pragma unroll
            for (int mm = 0; mm < 2; ++mm) { const int ai = g >> 1, m = 2 * (g & 1) + mm; const size_t r = (size_t)(row0 + ai * HALF + m * 16); float ss = 0.f;
#pragma unroll
                for (int bj = 0; bj < 2; ++bj) { const size_t off = r * 1024 + col0 + bj * HALF; const int j = 2 * mm + bj;
                    const f32x4 v0 = acc[ai][bj][m][0] + xv[g & 1][2 * j], v1 = acc[ai][bj][m][1] + xv[g & 1][2 * j + 1];
                    ss += (v0[0] * v0[0] + v0[1] * v0[1]) + (v0[2] * v0[2] + v0[3] * v0[3]) + (v1[0] * v1[0] + v1[1] * v1[1]) + (v1[2] * v1[2] + v1[3] * v1[3]);
                    u32x4 w; w.x = cvt_pk_bf16(v0[0], v0[1]); w.y = cvt_pk_bf16(v0[2], v0[3]); w.z = cvt_pk_bf16(v1[0], v1[1]); w.w = cvt_pk_bf16(v1[2], v1[3]);
                    *(u32x4*)(X1B + off) = w; }
                ss += __shfl_xor(ss, 16); ss += __shfl_xor(ss, 32);
                if (fq == 0) atomicAdd(sumsq + r, ss); }
            asm volatile("" ::: "memory");
        }
#undef ER_LOAD
    }
};

struct EpiRowScale {
    static constexpr bool PERM = true, AFTER_DRAIN = false;
    bf16_t* O; const float* sumsq;
    __device__ __forceinline__ void operator()(const f32x4 (&acc)[2][2][4][2], const Unit& u, int wr, int wc, int fr, int fq) const {
        const int row0 = u.pm * BM + wr * 64 + fr; const int col0 = u.pn * BM + wc * 32 + 8 * fq;
        float sq[8];
#pragma unroll
        for (int q = 0; q < 8; ++q) sq[q] = __hip_atomic_load(sumsq + (size_t)(row0 + (q >> 2) * HALF + (q & 3) * 16), __ATOMIC_RELAXED, __HIP_MEMORY_SCOPE_AGENT);
        asm volatile("" ::: "memory");
#pragma unroll
        for (int ai = 0; ai < 2; ++ai)
#pragma unroll
            for (int m = 0; m < 4; ++m) { const size_t r = (size_t)(row0 + ai * HALF + m * 16);
                const float rs = rsqrtf(sq[4 * ai + m] * (1.0f / 1024.0f) + NORM_EPS_);
#pragma unroll
                for (int bj = 0; bj < 2; ++bj) { const f32x4 v0 = acc[ai][bj][m][0] * rs, v1 = acc[ai][bj][m][1] * rs;
                    u32x4 w; w.x = cvt_pk_bf16(v0[0], v0[1]); w.y = cvt_pk_bf16(v0[2], v0[3]); w.z = cvt_pk_bf16(v1[0], v1[1]); w.w = cvt_pk_bf16(v1[2], v1[3]);
                    *(u32x4*)(O + r * 1024 + col0 + bj * HALF) = w; } }
    }
};
template <class Epi, class Sched, bool ALIGN_EPI = false, bool SP2 = false, bool I8 = false>
__device__ __forceinline__ void gemm_phase(PG8_LAS unsigned char* lds, const Gemm g, const Sched& S, const Epi& E, const int wid  ) {
    int lane; asm volatile("v_mbcnt_lo_u32_b32 %0, -1, 0\n\tv_mbcnt_hi_u32_b32 %0, -1, %0" : "=v"(lane));
    const int tid = wid * 64 + lane, wr = wid >> 2, wc = wid & 3, fr = lane & 15, fq = lane >> 4;
    const int K = g.K, nt = K / BK;
    unsigned voffA[2], voffB[2];
#pragma unroll
    for (int i = 0; i < 2; ++i) { int R, C; stage_rc(tid * 16 + i * 8192, R, C); const int Rb = Epi::PERM ? ((R & ~31) + perm32(R & 31)) : R;
        voffA[i] = (unsigned)(R * K + C) * 2u; voffB[i] = (unsigned)(Rb * K + C) * 2u; }
    const size_t kstep = (size_t)(BK * 2);
    const size_t hstep = (size_t)HALF * K * 2;
    const size_t tstep = 2 * hstep;
    const unsigned ldsw = (unsigned)wid * 1024u;
    const int aoff = lds_byte(wr * 64 + fr, fq * 8), boff = lds_byte(wc * 32 + fr, fq * 8);
#define PG8_SA(b, h) (((b) * 2 + (h)) * HTB)
#define PG8_SB(b, h) ((4 + (b) * 2 + (h)) * HTB)
#define PG8_STAGE(bufoff, gbase, voff) do { _Pragma("unroll") for (int _i = 0; _i < 2; ++_i) \
        __builtin_amdgcn_global_load_lds((const unsigned*)((const char*)(gbase) + (voff)[_i]), (PG8_LAS unsigned*)(lds + (bufoff) + ldsw + _i * 8192), 16, 0, 0); } while (0)
#define PG8_LDA(dst, b, h) do { _Pragma("unroll") for (int m = 0; m < 4; ++m) _Pragma("unroll") for (int k = 0; k < 2; ++k) dst[m][k] = *(const PG8_LAS bf16x8*)(lds + PG8_SA(b, h) + aoff + m * 2048 + k * 1024); } while (0)
#define PG8_LDB(dst, b, h) do { _Pragma("unroll") for (int n = 0; n < 2; ++n) _Pragma("unroll") for (int k = 0; k < 2; ++k) dst[n][k] = *(const PG8_LAS bf16x8*)(lds + PG8_SB(b, h) + boff + n * 2048 + k * 1024); } while (0)
#define PG8_MMA(ai, bj, At, Bt) do { __builtin_amdgcn_s_setprio(1); _Pragma("unroll") for (int m = 0; m < 4; ++m) _Pragma("unroll") for (int n = 0; n < 2; ++n) _Pragma("unroll") for (int k = 0; k < 2; ++k) \
        { if constexpr (I8) { typedef int i32x4_ __attribute__((ext_vector_type(4))); acc[ai][bj][m][n] = __builtin_bit_cast(f32x4, __builtin_amdgcn_mfma_i32_16x16x64_i8(__builtin_bit_cast(i32x4_, Bt[n][k]), __builtin_bit_cast(i32x4_, At[m][k]), __builtin_bit_cast(i32x4_, acc[ai][bj][m][n]), 0, 0, 0)); } \
          else acc[ai][bj][m][n] = __builtin_amdgcn_mfma_f32_16x16x32_bf16(Bt[n][k], At[m][k], acc[ai][bj][m][n], 0, 0, 0); } __builtin_amdgcn_s_setprio(0); } while (0)
#define PG8_WAIT_V(n) asm volatile("s_waitcnt vmcnt(" #n ")" ::: "memory")
#define PG8_WAIT_L(n) asm volatile("s_waitcnt lgkmcnt(" #n ")" ::: "memory")
#define PG8_BAR __builtin_amdgcn_s_barrier()
#define PG8_SCHED __builtin_amdgcn_sched_barrier(0)
    Unit cur, nxt; int ui = 0;
    if (!S.next(0, cur)) return;
    f32x4 acc[2][2][4][2];
#pragma unroll
    for (int a = 0; a < 2; ++a)
#pragma unroll
        for (int b = 0; b < 2; ++b)
#pragma unroll
            for (int m = 0; m < 4; ++m)
#pragma unroll
                for (int n = 0; n < 2; ++n) acc[a][b][m][n] = (f32x4){0.f, 0.f, 0.f, 0.f};
    bf16x8 At[4][2], B0[2][2], B1[2][2];
    const char* cA = (const char*)g.A + (size_t)cur.pm * tstep; const char* cB = (const char*)g.Bt + (size_t)cur.pn * tstep;
    S.a_ready(cur);
    if constexpr (SP2) {
        PG8_STAGE(PG8_SB(0, 0), cB, voffB); PG8_STAGE(PG8_SB(0, 1), cB + hstep, voffB); PG8_STAGE(PG8_SA(0, 0), cA, voffA); PG8_STAGE(PG8_SA(0, 1), cA + hstep, voffA);
        if (wr == 1) PG8_BAR;
        PG8_WAIT_V(2); PG8_BAR;
        PG8_STAGE(PG8_SB(1, 0), cB + kstep, voffB); PG8_STAGE(PG8_SA(1, 0), cA + kstep, voffA); PG8_STAGE(PG8_SB(1, 1), cB + hstep + kstep, voffB);
        PG8_WAIT_V(6); PG8_BAR;
    } else {
        PG8_STAGE(PG8_SB(0, 0), cB, voffB); PG8_STAGE(PG8_SA(0, 0), cA, voffA); PG8_STAGE(PG8_SB(0, 1), cB + hstep, voffB); PG8_STAGE(PG8_SA(0, 1), cA + hstep, voffA);
        if (wr == 1) PG8_BAR;
        PG8_WAIT_V(4); PG8_BAR;
        PG8_STAGE(PG8_SB(1, 0), cB + kstep, voffB); PG8_STAGE(PG8_SA(1, 0), cA + kstep, voffA); PG8_STAGE(PG8_SB(1, 1), cB + hstep + kstep, voffB);
        PG8_WAIT_V(6); PG8_BAR;
    }
    for (;;) {
        const bool has_next = S.next(ui + 1, nxt);
        const char* nA = has_next ? (const char*)g.A + (size_t)nxt.pm * tstep : cA; const char* nB = has_next ? (const char*)g.Bt + (size_t)nxt.pn * tstep : cB;
        for (int t = 0; t < nt; t += 2) {
            const bool last = (t == nt - 2);
            const char* a1 = cA + (size_t)(t + 1) * kstep;
            const char* a2 = last ? nA : cA + (size_t)(t + 2) * kstep; const char* b2 = last ? nB : cB + (size_t)(t + 2) * kstep;
            const char* a3 = a2 + kstep; const char* b3 = b2 + kstep;
            if (last && has_next) S.a_ready(nxt);
            if constexpr (SP2) {
            PG8_LDB(B0, 0, 0); PG8_LDB(B1, 0, 1); PG8_SCHED; PG8_LDA(At, 0, 0); PG8_STAGE(PG8_SA(1, 1), a1 + hstep, voffA);
            PG8_WAIT_V(8); PG8_WAIT_L(0); PG8_BAR; PG8_MMA(0, 0, At, B0); PG8_MMA(0, 1, At, B1); PG8_BAR; PG8_SCHED;
            PG8_LDA(At, 0, 1); PG8_STAGE(PG8_SB(0, 0), b2, voffB); PG8_STAGE(PG8_SB(0, 1), b2 + hstep, voffB); PG8_STAGE(PG8_SA(0, 0), a2, voffA);
            PG8_WAIT_V(8); PG8_WAIT_L(0); PG8_BAR; PG8_MMA(1, 0, At, B0); PG8_MMA(1, 1, At, B1); PG8_BAR; PG8_SCHED;
            PG8_LDB(B0, 1, 0); PG8_LDB(B1, 1, 1); PG8_SCHED; PG8_LDA(At, 1, 0); PG8_STAGE(PG8_SA(0, 1), a2 + hstep, voffA);
            PG8_WAIT_V(8); PG8_WAIT_L(0); PG8_BAR; PG8_MMA(0, 0, At, B0); PG8_MMA(0, 1, At, B1); PG8_BAR; PG8_SCHED;
            PG8_LDA(At, 1, 1); PG8_STAGE(PG8_SB(1, 0), b3, voffB); PG8_STAGE(PG8_SB(1, 1), b3 + hstep, voffB); PG8_STAGE(PG8_SA(1, 0), a3, voffA);
            PG8_WAIT_V(8); PG8_WAIT_L(0); PG8_BAR; PG8_MMA(1, 0, At, B0); PG8_MMA(1, 1, At, B1); PG8_BAR; PG8_SCHED;
            } else {
            PG8_LDB(B0, 0, 0); PG8_SCHED; PG8_LDA(At, 0, 0); PG8_STAGE(PG8_SA(1, 1), a1 + hstep, voffA);
            PG8_WAIT_L(8); PG8_BAR; PG8_WAIT_L(0); PG8_MMA(0, 0, At, B0); PG8_BAR; PG8_SCHED;
            PG8_LDB(B1, 0, 1); PG8_STAGE(PG8_SB(0, 0), b2, voffB);
            PG8_BAR; PG8_WAIT_L(0); PG8_MMA(0, 1, At, B1); PG8_BAR;
            PG8_LDA(At, 0, 1); PG8_STAGE(PG8_SA(0, 0), a2, voffA);
            PG8_BAR; PG8_WAIT_L(0); PG8_MMA(1, 0, At, B0); PG8_BAR; PG8_SCHED;
            PG8_STAGE(PG8_SB(0, 1), b2 + hstep, voffB);
            PG8_WAIT_V(6); PG8_BAR; PG8_MMA(1, 1, At, B1); PG8_BAR;
            PG8_LDB(B0, 1, 0); PG8_SCHED; PG8_LDA(At, 1, 0); PG8_STAGE(PG8_SA(0, 1), a2 + hstep, voffA);
            PG8_WAIT_L(8); PG8_BAR; PG8_WAIT_L(0); PG8_MMA(0, 0, At, B0); PG8_BAR; PG8_SCHED;
            PG8_LDB(B1, 1, 1); PG8_STAGE(PG8_SB(1, 0), b3, voffB);
            PG8_BAR; PG8_WAIT_L(0); PG8_MMA(0, 1, At, B1); PG8_BAR;
            PG8_LDA(At, 1, 1); PG8_STAGE(PG8_SA(1, 0), a3, voffA);
            PG8_BAR; PG8_WAIT_L(0); PG8_MMA(1, 0, At, B0); PG8_BAR; PG8_SCHED;
            PG8_STAGE(PG8_SB(1, 1), b3 + hstep, voffB);
            PG8_WAIT_V(6); PG8_BAR; PG8_MMA(1, 1, At, B1); PG8_BAR;
            }
        }
        if constexpr (ALIGN_EPI) { if (wr == 0) PG8_BAR; }
        if constexpr (!Epi::AFTER_DRAIN) { E(acc, cur, wr, wc, fr, fq); S.done(cur); }
        if (!has_next) break;
#pragma unroll
        for (int a = 0; a < 2; ++a)
#pragma unroll
            for (int b = 0; b < 2; ++b)
#pragma unroll
                for (int m = 0; m < 4; ++m)
#pragma unroll
                    for (int n = 0; n < 2; ++n) acc[a][b][m][n] = (f32x4){0.f, 0.f, 0.f, 0.f};
        cur = nxt; cA = nA; cB = nB; ++ui;
        if constexpr (ALIGN_EPI) { if (wr == 1) PG8_BAR; }
    }
    PG8_WAIT_V(0);
    if constexpr (!ALIGN_EPI) { if (wr == 0) PG8_BAR; }
    PG8_BAR;
    if constexpr (Epi::AFTER_DRAIN) { E.fused(acc, cur, wr, wc, fr, fq, lds, wid, lane); S.done(cur); }
#undef PG8_SA
#undef PG8_SB
#undef PG8_STAGE
#undef PG8_LDA
#undef PG8_LDB
#undef PG8_MMA
#undef PG8_WAIT_V
#undef PG8_WAIT_L
#undef PG8_BAR
#undef PG8_SCHED
}
}

#define GAS __attribute__((address_space(1)))
#define LAS __attribute__((address_space(3)))
typedef unsigned short bf16;
typedef unsigned v4u __attribute__((ext_vector_type(4)));
typedef float f32x4 __attribute__((ext_vector_type(4)));
typedef float f32x16 __attribute__((ext_vector_type(16)));
typedef short bf16x8 __attribute__((ext_vector_type(8)));
#define LDS_WAIT() asm volatile("s_waitcnt lgkmcnt(0)" ::: "memory")
#define VM_WAIT() asm volatile("s_waitcnt vmcnt(0)" ::: "memory")

constexpr int NWAVES = 8;
constexpr int BATCH = 16, SEQ = 2048, DM = 1024, MTOK = BATCH * SEQ, NIN = 6400;
constexpr int NEXP = 16384;
constexpr float EPS = 1e-6f;
constexpr size_t MiB = 1u << 20;
constexpr size_t WS_CTL = 0, CTL_ZERO_BYTES = 1 * MiB;
constexpr size_t WS_SUMSQ = 512 * 1024;
constexpr size_t WS_WIN = 1 * MiB, WS_WA = 14 * MiB, WS_WB = 15 * MiB, WS_WOUT = 16 * MiB, WS_WQ = 18 * MiB, WS_SK = 20 * MiB;
constexpr size_t WS_U = 24 * MiB, WS_V = 56 * MiB;
constexpr size_t WS_SXN = 22 * MiB, WS_SW = 22 * MiB + 262144;
constexpr size_t WS_CMAX = 65536;
constexpr size_t WS_SU = 21 * MiB;
constexpr size_t WS_PROJ = 88 * MiB;
constexpr size_t WS_X1F = 88 * MiB, WS_X1B = 216 * MiB, WS_Q = 280 * MiB;
constexpr size_t WS_END = 488 * MiB;
constexpr size_t OUT_XN = 0, OUT_MERGED = 0, OUT_KI = 32 * MiB, OUT_YA = 64 * MiB, OUT_YB = 96 * MiB;
constexpr int LDS_CTL = 155648, LDS_BYTES = LDS_CTL + 1024;

__device__ __forceinline__ unsigned pk2(float lo, float hi) { typedef __bf16 b2_ __attribute__((ext_vector_type(2))); typedef float f2_ __attribute__((ext_vector_type(2))); f2_ v = {lo, hi}; return __builtin_bit_cast(unsigned, __builtin_convertvector(v, b2_)); }
__device__ __forceinline__ unsigned f2bf(float f) { return pk2(f, 0.f) & 0xffffu; }
__device__ __forceinline__ float bf2f_(unsigned short b) { return __builtin_bit_cast(float, (unsigned)b << 16); }
__device__ __forceinline__ float wave_sum(float v) {
#pragma unroll
    for (int o = 1; o < 64; o <<= 1) v += __shfl_xor(v, o);
    return v;
}

__device__ __forceinline__ int fresh_lane() { int l; asm volatile("v_mbcnt_lo_u32_b32 %0, -1, 0\n\tv_mbcnt_hi_u32_b32 %0, -1, %0" : "=v"(l)); return l; }

#define XB_TMO      128
#define XB_XCNT(j)  (256  + 64 * (j))
#define XB_XSUB(j)  (1280 + 64 * (j))
#define XB_XGEN(j)  (2304 + 64 * (j))
#define XB_TOP      3328
#define XB_TOPGEN   3392
#define XCD_BAR_WORDS 3456
#define XB_SPIN_CAP (1u << 23)
__device__ __forceinline__ unsigned xb_ld(unsigned* p)              { return __hip_atomic_load(p, __ATOMIC_RELAXED, __HIP_MEMORY_SCOPE_AGENT); }
__device__ __forceinline__ unsigned xb_add(unsigned* p, unsigned v) { return __hip_atomic_fetch_add(p, v, __ATOMIC_RELAXED, __HIP_MEMORY_SCOPE_AGENT); }
__device__ __forceinline__ unsigned xb_xcc_id() { return (unsigned)__builtin_amdgcn_s_getreg((3 << 11) | 20) & 0xFu; }
#define XB_SPIN(cond, bar) do { unsigned _sp = 0; while (cond) { __builtin_amdgcn_s_sleep(1); \
    if ((++_sp & 255u) == 0u) { if (xb_ld(&(bar)[XB_TMO])) break; if (_sp > XB_SPIN_CAP) { atomicAdd(&(bar)[XB_TMO], 1u); break; } } } } while (0)
struct XcdBarrier { unsigned* bar; unsigned x; volatile LAS unsigned* st; };
__device__ __forceinline__ XcdBarrier xcd_barrier_post(unsigned* bar, volatile LAS unsigned* st, int tid) {
    XcdBarrier b; b.bar = bar; b.x = xb_xcc_id(); b.st = st;
    if (tid == 0) (void)xb_add(&bar[XB_XCNT(b.x)], 1u);
    return b;
}
__device__ __forceinline__ void xcd_barrier_complete(unsigned* bar, unsigned x, unsigned& nloc, unsigned& nx) {
    const unsigned G = gridDim.x;
    unsigned sum, cnt, mine, sp = 0u;
    for (;;) {
        sum = 0u; cnt = 0u; mine = 0u;
#pragma unroll
        for (unsigned j = 0; j < 16; ++j) { const unsigned c = xb_ld(&bar[XB_XCNT(j)]); sum += c; cnt += (c > 0u) ? 1u : 0u; mine = (j == x) ? c : mine; }
        if (sum == G) break;
        __builtin_amdgcn_s_sleep(1);
        if ((++sp & 255u) == 0u) { if (xb_ld(&bar[XB_TMO])) break; if (sp > XB_SPIN_CAP) { atomicAdd(&bar[XB_TMO], 1u); break; } }
    }
    nloc = mine > 0u ? mine : 1u; nx = cnt > 0u ? cnt : 1u;
}
__device__ __forceinline__ void xcd_barrier(const XcdBarrier& b, int tid) {
    asm volatile("s_waitcnt vmcnt(0)" ::: "memory");
    __syncthreads();
    if (tid == 0) {
        unsigned* bar = b.bar;
        __builtin_amdgcn_s_waitcnt(0);
        unsigned nloc = b.st[0], nx = b.st[1];
        if (nloc == 0u) { xcd_barrier_complete(bar, b.x, nloc, nx); b.st[0] = nloc; b.st[1] = nx; }
        const unsigned old = xb_add(&bar[XB_XSUB(b.x)], 1u);
        const unsigned gen = old / nloc;
        if (old + 1u == (gen + 1u) * nloc) {
            __builtin_amdgcn_fence(__ATOMIC_RELEASE, "agent");
            asm volatile("s_waitcnt vmcnt(0)" ::: "memory");
            const unsigned og = xb_add(&bar[XB_TOP], 1u);
            const unsigned tg = og / nx;
            if (og + 1u == (tg + 1u) * nx) xb_add(&bar[XB_TOPGEN], 1u);
            else XB_SPIN(xb_ld(&bar[XB_TOPGEN]) == tg, bar);
            __builtin_amdgcn_fence(__ATOMIC_ACQUIRE, "agent");
            xb_add(&bar[XB_XGEN(b.x)], 1u);
            asm volatile("s_waitcnt vmcnt(0)" ::: "memory");
        } else {
            XB_SPIN(xb_ld(&bar[XB_XGEN(b.x)]) == gen, bar);
            __builtin_amdgcn_fence(__ATOMIC_ACQUIRE, "agent");
            asm volatile("s_waitcnt vmcnt(0)" ::: "memory");
        }
    }
    __syncthreads();
}

struct Params {
    const float* x; const float* norm1_g; const float* w_in; const float* hg_norm_g; const float* hg_lb; const float* q_norm_g; const float* k_norm_g;
    const float* w_a; const float* w_b; const float* w_out; const float* norm2_g; const float* peer_wq; const float* peer_sk; const float* peer_u; const float* peer_v;
    float* out; unsigned char* ws; int ph_lo, ph_hi;
};

__device__ __forceinline__ void p0_transpose_item(const float* W, int K, int N, const float* gk, bool permute, bf16* WT, LAS float* scr, int item, int lane) {
    const int nblk = N / 32, kb = item / nblk, nb = item % nblk, k0 = 64 * kb, n0 = 32 * nb;
    { const int r8 = lane >> 3, c4 = (lane & 7) * 4; f32x4 w[8];
#pragma unroll
      for (int i = 0; i < 8; ++i) w[i] = *(const GAS f32x4*)(W + (size_t)(k0 + 8 * i + r8) * N + n0 + c4);
#pragma unroll
      for (int i = 0; i < 8; ++i) { const int kk = 8 * i + r8; const float g = gk ? gk[k0 + kk] : 1.0f; LAS float* d = scr + kk * 33 + c4; d[0] = w[i].x * g; d[1] = w[i].y * g; d[2] = w[i].z * g; d[3] = w[i].w * g; } }
    LDS_WAIT(); asm volatile("" ::: "memory");
    int prow0 = n0;
    if (permute) { const int tile = n0 >> 8, lc = n0 & 255, wc = lc >> 6, bj = (lc >> 5) & 1; prow0 = tile * 256 + 128 * bj + 32 * wc; }
    const int c = lane & 7;
#pragma unroll
    for (int j = 0; j < 4; ++j) { const int n = (lane >> 3) + 8 * j; const LAS float* s = scr + (8 * c) * 33 + n;
        v4u o; o.x = pk2(s[0 * 33], s[1 * 33]); o.y = pk2(s[2 * 33], s[3 * 33]); o.z = pk2(s[4 * 33], s[5 * 33]); o.w = pk2(s[6 * 33], s[7 * 33]);
        *(GAS v4u*)(WT + (size_t)(prow0 + n) * K + k0 + 8 * c) = o; }
    LDS_WAIT(); asm volatile("" ::: "memory");
}
template <bool SIGNED> __device__ __forceinline__ void row_quant8(const float* xrow, const float* gcol, unsigned char* orow, float* scale_out, int lane) {
    const GAS f32x4* xr = (const GAS f32x4*)xrow + 4 * lane;
    f32x4 v[4]; float m = 0.f;
#pragma unroll
    for (int j = 0; j < 4; ++j) { v[j] = xr[j]; if (gcol) v[j] = v[j] * ((const GAS f32x4*)gcol)[4 * lane + j]; m = fmaxf(m, fmaxf(fmaxf(fabsf(v[j].x), fabsf(v[j].y)), fmaxf(fabsf(v[j].z), fabsf(v[j].w)))); }
#pragma unroll
    for (int o = 1; o < 64; o <<= 1) m = fmaxf(m, __shfl_xor(m, o));
    const float inv = m > 0.f ? 127.0f / m : 0.f; const int off = SIGNED ? 0 : 128;
    v4u o; unsigned w[4];
#pragma unroll
    for (int j = 0; j < 4; ++j) { const int q0 = __float2int_rn(v[j].x * inv) + off, q1 = __float2int_rn(v[j].y * inv) + off, q2 = __float2int_rn(v[j].z * inv) + off, q3 = __float2int_rn(v[j].w * inv) + off;
        w[j] = (unsigned)(q0 & 255) | ((unsigned)(q1 & 255) << 8) | ((unsigned)(q2 & 255) << 16) | ((unsigned)(q3 & 255) << 24); }
    o.x = w[0]; o.y = w[1]; o.z = w[2]; o.w = w[3];
    *(GAS v4u*)(orow + 16 * lane) = o;
    if (lane == 0) *scale_out = m * (1.0f / 127.0f);
}
template <bool SIGNED> __device__ __forceinline__ void row_quant8_regs(const f32x4 (&v)[4], unsigned char* orow, float* scale_out, int lane) {
    float m = 0.f;
#pragma unroll
    for (int j = 0; j < 4; ++j) m = fmaxf(m, fmaxf(fmaxf(fabsf(v[j].x), fabsf(v[j].y)), fmaxf(fabsf(v[j].z), fabsf(v[j].w))));
#pragma unroll
    for (int o = 1; o < 64; o <<= 1) m = fmaxf(m, __shfl_xor(m, o));
    const float inv = m > 0.f ? 127.0f / m : 0.f; const int off = SIGNED ? 0 : 128;
    v4u o; unsigned w[4];
#pragma unroll
    for (int j = 0; j < 4; ++j) { const int q0 = __float2int_rn(v[j].x * inv) + off, q1 = __float2int_rn(v[j].y * inv) + off, q2 = __float2int_rn(v[j].z * inv) + off, q3 = __float2int_rn(v[j].w * inv) + off;
        w[j] = (unsigned)(q0 & 255) | ((unsigned)(q1 & 255) << 8) | ((unsigned)(q2 & 255) << 16) | ((unsigned)(q3 & 255) << 24); }
    o.x = w[0]; o.y = w[1]; o.z = w[2]; o.w = w[3];
    *(GAS v4u*)(orow + 16 * lane) = o;
    if (lane == 0) *scale_out = m * (1.0f / 127.0f);
}
__device__ __forceinline__ void quant_tables(const Params& P, int wi, int nw, int wave, int lane) {
    unsigned char* UQ = P.ws + WS_U; unsigned char* VQ = P.ws + WS_V; float* SUV = (float*)(P.ws + WS_SU);
    f32x4 gg[4];
#pragma unroll
    for (int j = 0; j < 4; ++j) gg[j] = ((const GAS f32x4*)P.norm2_g)[4 * lane + j];
    const int stride = nw * NWAVES;
    for (int e = wi * NWAVES + wave; e < NEXP; e += 2 * stride) {
        const int e2 = e + stride < NEXP ? e + stride : e;
        f32x4 ua[4], va[4], ub[4], vb[4];
#pragma unroll
        for (int j = 0; j < 4; ++j) { ua[j] = ((const GAS f32x4*)(P.peer_u + (size_t)e * DM))[4 * lane + j]; va[j] = ((const GAS f32x4*)(P.peer_v + (size_t)e * DM))[4 * lane + j];
            ub[j] = ((const GAS f32x4*)(P.peer_u + (size_t)e2 * DM))[4 * lane + j]; vb[j] = ((const GAS f32x4*)(P.peer_v + (size_t)e2 * DM))[4 * lane + j]; }
#pragma unroll
        for (int j = 0; j < 4; ++j) { ua[j] = ua[j] * gg[j]; ub[j] = ub[j] * gg[j]; }
        row_quant8_regs<true>(ua, UQ + (size_t)e * DM, SUV + 2 * e, lane); row_quant8_regs<true>(va, VQ + (size_t)e * DM, SUV + 2 * e + 1, lane);
        row_quant8_regs<true>(ub, UQ + (size_t)e2 * DM, SUV + 2 * e2, lane); row_quant8_regs<true>(vb, VQ + (size_t)e2 * DM, SUV + 2 * e2 + 1, lane);
    }
}
__device__ __forceinline__ void p0_colmax_item(const float* W, int N, const float* gk, unsigned* cmax, int item, int lane) {
    const int nblk = N / 32, kb = item / nblk, nb = item % nblk, k0 = 64 * kb, n0 = 32 * nb;
    const int r8 = lane >> 3, c4 = (lane & 7) * 4; f32x4 w[8];
#pragma unroll
    for (int i = 0; i < 8; ++i) w[i] = *(const GAS f32x4*)(W + (size_t)(k0 + 8 * i + r8) * N + n0 + c4);
    float m0 = 0.f, m1 = 0.f, m2 = 0.f, m3 = 0.f;
#pragma unroll
    for (int i = 0; i < 8; ++i) { const float g = gk[k0 + 8 * i + r8]; m0 = fmaxf(m0, fabsf(w[i].x * g)); m1 = fmaxf(m1, fabsf(w[i].y * g)); m2 = fmaxf(m2, fabsf(w[i].z * g)); m3 = fmaxf(m3, fabsf(w[i].w * g)); }
#pragma unroll
    for (int o = 8; o < 64; o <<= 1) { m0 = fmaxf(m0, __shfl_xor(m0, o)); m1 = fmaxf(m1, __shfl_xor(m1, o)); m2 = fmaxf(m2, __shfl_xor(m2, o)); m3 = fmaxf(m3, __shfl_xor(m3, o)); }
    if (lane < 8) { atomicMax(cmax + n0 + c4, __builtin_bit_cast(unsigned, m0)); atomicMax(cmax + n0 + c4 + 1, __builtin_bit_cast(unsigned, m1)); atomicMax(cmax + n0 + c4 + 2, __builtin_bit_cast(unsigned, m2)); atomicMax(cmax + n0 + c4 + 3, __builtin_bit_cast(unsigned, m3)); }
}
__device__ __forceinline__ void p0_quant_item(const float* W, int K, int N, const float* gk, const unsigned* cmax, unsigned char* WT8, float* sw, LAS float* scr, int item, int lane) {
    const int nblk = N / 32, kb = item / nblk, nb = item % nblk, k0 = 64 * kb, n0 = 32 * nb;
    const float cm = __builtin_bit_cast(float, __hip_atomic_load(cmax + n0 + (lane & 31), __ATOMIC_RELAXED, __HIP_MEMORY_SCOPE_AGENT)); const float inv = cm > 0.f ? 127.0f / cm : 0.f;
    { const int r8 = lane >> 3, c4 = (lane & 7) * 4; f32x4 w[8]; float iv[4];
#pragma unroll
      for (int i = 0; i < 8; ++i) w[i] = *(const GAS f32x4*)(W + (size_t)(k0 + 8 * i + r8) * N + n0 + c4);
#pragma unroll
      for (int j = 0; j < 4; ++j) { const float c = __builtin_bit_cast(float, __hip_atomic_load(cmax + n0 + c4 + j, __ATOMIC_RELAXED, __HIP_MEMORY_SCOPE_AGENT)); iv[j] = c > 0.f ? 127.0f / c : 0.f; }
#pragma unroll
      for (int i = 0; i < 8; ++i) { const int kk = 8 * i + r8; const float g = gk[k0 + kk]; LAS float* d = scr + kk * 33 + c4; d[0] = w[i].x * g * iv[0]; d[1] = w[i].y * g * iv[1]; d[2] = w[i].z * g * iv[2]; d[3] = w[i].w * g * iv[3]; } }
    (void)inv;
    LDS_WAIT(); asm volatile("" ::: "memory");
    const int tile = n0 >> 8, lc = n0 & 255, wc = lc >> 6, bj = (lc >> 5) & 1; const int prow0 = tile * 256 + 128 * bj + 32 * wc;
    if (kb == 0 && lane < 32) sw[prow0 + lane] = cm * (1.0f / 127.0f);
    const int n = lane >> 1, hf = lane & 1; const LAS float* sp = scr + (32 * hf) * 33 + n; unsigned w[8];
#pragma unroll
    for (int j = 0; j < 8; ++j) { const int q0 = __float2int_rn(sp[(4 * j) * 33]), q1 = __float2int_rn(sp[(4 * j + 1) * 33]), q2 = __float2int_rn(sp[(4 * j + 2) * 33]), q3 = __float2int_rn(sp[(4 * j + 3) * 33]);
        w[j] = (unsigned)(q0 & 255) | ((unsigned)(q1 & 255) << 8) | ((unsigned)(q2 & 255) << 16) | ((unsigned)(q3 & 255) << 24); }
    v4u o0, o1; o0.x = w[0]; o0.y = w[1]; o0.z = w[2]; o0.w = w[3]; o1.x = w[4]; o1.y = w[5]; o1.z = w[6]; o1.w = w[7];
    GAS v4u* dst = (GAS v4u*)(WT8 + (size_t)(prow0 + n) * K + k0 + 32 * hf); dst[0] = o0; dst[1] = o1;
    LDS_WAIT(); asm volatile("" ::: "memory");
}
__device__ __forceinline__ void row_quant_rms_regs(const f32x4 (&v)[4], unsigned char* orow, float* scale_out, int lane) {
    float m = 0.f, ss = 0.f;
#pragma unroll
    for (int j = 0; j < 4; ++j) { m = fmaxf(m, fmaxf(fmaxf(fabsf(v[j].x), fabsf(v[j].y)), fmaxf(fabsf(v[j].z), fabsf(v[j].w)))); ss += (v[j].x * v[j].x + v[j].y * v[j].y) + (v[j].z * v[j].z + v[j].w * v[j].w); }
#pragma unroll
    for (int o = 1; o < 64; o <<= 1) { m = fmaxf(m, __shfl_xor(m, o)); ss += __shfl_xor(ss, o); }
    const float inv = m > 0.f ? 127.0f / m : 0.f; unsigned w[4];
#pragma unroll
    for (int j = 0; j < 4; ++j) { const int q0 = __float2int_rn(v[j].x * inv), q1 = __float2int_rn(v[j].y * inv), q2 = __float2int_rn(v[j].z * inv), q3 = __float2int_rn(v[j].w * inv);
        w[j] = (unsigned)(q0 & 255) | ((unsigned)(q1 & 255) << 8) | ((unsigned)(q2 & 255) << 16) | ((unsigned)(q3 & 255) << 24); }
    v4u o; o.x = w[0]; o.y = w[1]; o.z = w[2]; o.w = w[3];
    *(GAS v4u*)(orow + 16 * lane) = o;
    if (lane == 0) *scale_out = rsqrtf(ss * (1.0f / DM) + EPS) * m * (1.0f / 127.0f);
}
__device__ __forceinline__ void p0_prologue_a(const Params& P, LAS unsigned char* lds, int wave, int lane, int part) {
    const int tid = wave * 64 + lane;
    LAS float* scr = (LAS float*)(lds + wave * 16384);
    const int gw = blockIdx.x * NWAVES + wave, NGW = gridDim.x * NWAVES;
    bf16* WA = (bf16*)(P.ws + WS_WA); bf16* WB = (bf16*)(P.ws + WS_WB); bf16* WOUT = (bf16*)(P.ws + WS_WOUT); bf16* WQ = (bf16*)(P.ws + WS_WQ);
    constexpr int I_IN = (1024 / 64) * (NIN / 32), I_A = (512 / 64) * (1024 / 32), I_B = (256 / 64) * (1024 / 32), I_O = (1024 / 64) * (1024 / 32), I_Q = I_O;
    constexpr int NITEMS = I_IN + I_A + I_B + I_O + I_Q;
    if (part == 0) { for (int it = gw; it < I_IN; it += NGW) p0_colmax_item(P.w_in, NIN, P.norm1_g, (unsigned*)(P.ws + WS_CMAX), it, lane); return; }
    for (int it = I_IN + (gw + 1408) % NGW; it < NITEMS; it += NGW) {
        int r = it - I_IN;
        if (r < I_A) { p0_transpose_item(P.w_a, 512, 1024, nullptr, false, WA, scr, r, lane); continue; } r -= I_A;
        if (r < I_B) { p0_transpose_item(P.w_b, 256, 1024, nullptr, false, WB, scr, r, lane); continue; } r -= I_B;
        if (r < I_O) { p0_transpose_item(P.w_out, 1024, 1024, nullptr, false, WOUT, scr, r, lane); continue; } r -= I_O;
        p0_transpose_item(P.peer_wq, 1024, 1024, P.norm2_g, false, WQ, scr, r, lane);
    }
    { bf16* SK = (bf16*)(P.ws + WS_SK); const int gt = blockIdx.x * (NWAVES * 64) + tid, NT = gridDim.x * NWAVES * 64;
      for (int i = gt; i < 8 * 2 * 128 * 64 / 2; i += NT) ((unsigned*)SK)[i] = pk2(P.peer_sk[2 * i], P.peer_sk[2 * i + 1]); }
    { unsigned char* XN8 = (unsigned char*)P.out + OUT_XN; float* sxn = (float*)(P.ws + WS_SXN);
      for (int m = gw; m < MTOK; m += 2 * NGW) { const int m2 = m + NGW < MTOK ? m + NGW : m;
          f32x4 va[4], vb[4];
#pragma unroll
          for (int j = 0; j < 4; ++j) { va[j] = ((const GAS f32x4*)(P.x + (size_t)m * DM))[4 * lane + j]; vb[j] = ((const GAS f32x4*)(P.x + (size_t)m2 * DM))[4 * lane + j]; }
          row_quant_rms_regs(va, XN8 + (size_t)m * DM, sxn + m, lane); row_quant_rms_regs(vb, XN8 + (size_t)m2 * DM, sxn + m2, lane); } }
}
__device__ __forceinline__ void p0_prologue_b(const Params& P, LAS unsigned char* lds, int wave, int lane) {
    LAS float* scr = (LAS float*)(lds + wave * 16384);
    const int gw = blockIdx.x * NWAVES + wave, NGW = gridDim.x * NWAVES;
    constexpr int I_IN = (1024 / 64) * (NIN / 32);
    for (int it = (gw + 896) % NGW; it < I_IN; it += NGW) p0_quant_item(P.w_in, 1024, NIN, P.norm1_g, (const unsigned*)(P.ws + WS_CMAX), P.ws + WS_WIN, (float*)(P.ws + WS_SW), scr, it, lane);
}

__device__ __forceinline__ unsigned cvtpk(float lo, float hi) { typedef __bf16 b2 __attribute__((ext_vector_type(2))); typedef float f2 __attribute__((ext_vector_type(2))); f2 v = {lo, hi}; return __builtin_bit_cast(unsigned, __builtin_convertvector(v, b2)); }
typedef short s16x4 __attribute__((ext_vector_type(4)));
__device__ __forceinline__ s16x4 ds_tr16(const LAS unsigned char* p) { return __builtin_bit_cast(s16x4, __builtin_amdgcn_ds_read_tr16_b64_v4i16((LAS s16x4*)p)); }
__device__ __forceinline__ void hgrn_chunked_item(const Params& P, LAS unsigned char* lds, int item, int wave, int lane) {
    constexpr int QD_P = 272, TR_P = 320;
    constexpr int L_QD = 0, L_KI = 17408, L_KT = 34816, L_V = 55296, L_DEC = 75776, L_AP = 76288, L_OB = 82432;
    const int tid = wave * 64 + lane, b = item >> 2, h = item & 3;
    const int lrow = tid >> 3, lc = (tid & 7) * 16;
    const int l31 = lane & 31, hh = lane >> 5, jv = wave & 3, kh = wave >> 2;
    const bf16* base = (const bf16*)(P.ws + WS_PROJ) + (size_t)b * SEQ * NIN + h * 128;
    const bf16* kib = (const bf16*)((const unsigned char*)P.out + OUT_KI) + (size_t)b * SEQ * 512 + h * 128;
    bf16* YA = (bf16*)((unsigned char*)P.out + OUT_YA) + (size_t)b * SEQ * 512 + h * 128;
    float gn[16];
#pragma unroll
    for (int e = 0; e < 16; ++e) gn[e] = P.hg_norm_g[lc + e];
    f32x16 S[2];
    S[0] = f32x16{}; S[1] = f32x16{};
    v4u pq[2], pd[2], pk[2], pv[2], pg[2];
#define HG_LOAD(n_) do { const size_t ro_ = (size_t)((n_) * 64 + lrow); const bf16* r = base + ro_ * NIN + lc; const bf16* kr = kib + ro_ * 512 + lc; \
      pg[0] = *(const v4u*)(r + 1536); pg[1] = *(const v4u*)(r + 1544);   \
      pq[0] = *(const v4u*)r; pq[1] = *(const v4u*)(r + 8); pd[0] = *(const v4u*)(r + 512); pd[1] = *(const v4u*)(r + 520); pk[0] = *(const v4u*)kr; pk[1] = *(const v4u*)(kr + 8); \
      pv[0] = *(const v4u*)(r + 1024); pv[1] = *(const v4u*)(r + 1032); } while (0)
    HG_LOAD(0);
    v4u yh0 = {0u, 0u, 0u, 0u}, yh1 = {0u, 0u, 0u, 0u};
    const int tro = (4 * hh + ((lane & 15) >> 2)) * TR_P + (16 * ((lane >> 4) & 1) + 4 * (lane & 3)) * 2;
#pragma unroll 1
    for (int n = 0; n < SEQ / 64; ++n) {
        { const unsigned qw[8] = {pq[0].x, pq[0].y, pq[0].z, pq[0].w, pq[1].x, pq[1].y, pq[1].z, pq[1].w}, dw[8] = {pd[0].x, pd[0].y, pd[0].z, pd[0].w, pd[1].x, pd[1].y, pd[1].z, pd[1].w};
          unsigned w[8];
#pragma unroll
          for (int e = 0; e < 8; ++e) w[e] = pk2(pg8::bflo(qw[e]) * pg8::bflo(dw[e]), pg8::bfhi(qw[e]) * pg8::bfhi(dw[e]));
          v4u a0, a1; a0.x = w[0]; a0.y = w[1]; a0.z = w[2]; a0.w = w[3]; a1.x = w[4]; a1.y = w[5]; a1.z = w[6]; a1.w = w[7];
          *(LAS v4u*)(lds + L_QD + lrow * QD_P + lc * 2) = a0; *(LAS v4u*)(lds + L_QD + lrow * QD_P + lc * 2 + 16) = a1;
          if (lrow == 63) {
#pragma unroll
              for (int e4 = 0; e4 < 4; ++e4) *(LAS f32x4*)(lds + L_DEC + (lc + 4 * e4) * 4) = (f32x4){pg8::bflo(dw[2 * e4]), pg8::bfhi(dw[2 * e4]), pg8::bflo(dw[2 * e4 + 1]), pg8::bfhi(dw[2 * e4 + 1])}; } }
        *(LAS v4u*)(lds + L_KI + lrow * QD_P + lc * 2) = pk[0]; *(LAS v4u*)(lds + L_KI + lrow * QD_P + lc * 2 + 16) = pk[1];
        *(LAS v4u*)(lds + L_KT + lrow * TR_P + lc * 2) = pk[0]; *(LAS v4u*)(lds + L_KT + lrow * TR_P + lc * 2 + 16) = pk[1];
        *(LAS v4u*)(lds + L_V + lrow * TR_P + lc * 2) = pv[0]; *(LAS v4u*)(lds + L_V + lrow * TR_P + lc * 2 + 16) = pv[1];
        const v4u og0 = pg[0], og1 = pg[1];
        if (n > 0) { bf16* yp = YA + (size_t)((n - 1) * 64 + lrow) * 512 + lc; *(v4u*)yp = yh0; *(v4u*)(yp + 8) = yh1; }
        HG_LOAD(n + 1 < SEQ / 64 ? n + 1 : n);
        __syncthreads();
        if (wave < 3) {
            const int st = wave >> 1, ct = (wave + 1) >> 1;
            f32x16 a_ = f32x16{};
#pragma unroll
            for (int ks = 0; ks < 8; ++ks) { const bf16x8 af = *(const LAS bf16x8*)(lds + L_KI + (32 * st + l31) * QD_P + (16 * ks + 8 * hh) * 2), bfr = *(const LAS bf16x8*)(lds + L_QD + (32 * ct + l31) * QD_P + (16 * ks + 8 * hh) * 2);
                a_ = __builtin_amdgcn_mfma_f32_32x32x16_bf16(af, bfr, a_, 0, 0, 0); }
            if (st == ct) {
#pragma unroll
                for (int r = 0; r < 16; ++r) if ((r & 3) + 8 * (r >> 2) + 4 * hh > l31) a_[r] = 0.f; }
            v4u a0, a1;
            a0.x = cvtpk(a_[0], a_[1]); a0.y = cvtpk(a_[2], a_[3]); a0.z = cvtpk(a_[4], a_[5]); a0.w = cvtpk(a_[6], a_[7]);
            a1.x = cvtpk(a_[8], a_[9]); a1.y = cvtpk(a_[10], a_[11]); a1.z = cvtpk(a_[12], a_[13]); a1.w = cvtpk(a_[14], a_[15]);
            *(LAS v4u*)(lds + L_AP + wave * 2048 + lane * 16) = a0; *(LAS v4u*)(lds + L_AP + wave * 2048 + 1024 + lane * 16) = a1;
        }
        f32x16 oacc[2]; oacc[0] = f32x16{}; oacc[1] = f32x16{};
#pragma unroll
        for (int kl = 0; kl < 2; ++kl)
#pragma unroll
            for (int st = 0; st < 2; ++st) {
                v4u sb; sb.x = cvtpk(S[kl][8 * st + 0], S[kl][8 * st + 1]); sb.y = cvtpk(S[kl][8 * st + 2], S[kl][8 * st + 3]); sb.z = cvtpk(S[kl][8 * st + 4], S[kl][8 * st + 5]); sb.w = cvtpk(S[kl][8 * st + 6], S[kl][8 * st + 7]);
                typedef unsigned u2v __attribute__((ext_vector_type(2)));
#pragma unroll
                for (int rt = 0; rt < 2; ++rt) {
                    const LAS unsigned char* qp = lds + L_QD + (32 * rt + l31) * QD_P + (32 * (2 * kh + kl) + 16 * st + 4 * hh) * 2;
                    const u2v lo = *(const LAS u2v*)qp, hi = *(const LAS u2v*)(qp + 16);
                    v4u av; av.x = lo.x; av.y = lo.y; av.z = hi.x; av.w = hi.y;
                    oacc[rt] = __builtin_amdgcn_mfma_f32_32x32x16_bf16(__builtin_bit_cast(bf16x8, av), __builtin_bit_cast(bf16x8, sb), oacc[rt], 0, 0, 0); } }
        bf16x8 vf[4];
#pragma unroll
        for (int ks = 0; ks < 4; ++ks) { const LAS unsigned char* a1 = lds + L_V + tro + (16 * ks) * TR_P + (32 * jv) * 2; const s16x4 lo = ds_tr16(a1), hi = ds_tr16(a1 + 8 * TR_P);
            vf[ks] = (bf16x8){lo[0], lo[1], lo[2], lo[3], hi[0], hi[1], hi[2], hi[3]}; }
#pragma unroll
        for (int kl = 0; kl < 2; ++kl) {
            const int kt = 2 * kh + kl;
#pragma unroll
            for (int ks = 0; ks < 4; ++ks) { const LAS unsigned char* a1 = lds + L_KT + tro + (16 * ks) * TR_P + (32 * kt) * 2; const s16x4 lo = ds_tr16(a1), hi = ds_tr16(a1 + 8 * TR_P);
                const bf16x8 kf = {lo[0], lo[1], lo[2], lo[3], hi[0], hi[1], hi[2], hi[3]};
                S[kl] = __builtin_amdgcn_mfma_f32_32x32x16_bf16(kf, vf[ks], S[kl], 0, 0, 0); }
#pragma unroll
            for (int r4 = 0; r4 < 4; ++r4) { const f32x4 d = *(const LAS f32x4*)(lds + L_DEC + (32 * kt + 8 * r4 + 4 * hh) * 4);
                S[kl][4 * r4 + 0] *= d.x; S[kl][4 * r4 + 1] *= d.y; S[kl][4 * r4 + 2] *= d.z; S[kl][4 * r4 + 3] *= d.w; }
        }
        __syncthreads();
        if (kh == 0) {
            const v4u a0 = *(const LAS v4u*)(lds + L_AP + lane * 16), a1 = *(const LAS v4u*)(lds + L_AP + 1024 + lane * 16);
            oacc[0] = __builtin_amdgcn_mfma_f32_32x32x16_bf16(__builtin_bit_cast(bf16x8, a0), vf[0], oacc[0], 0, 0, 0);
            oacc[0] = __builtin_amdgcn_mfma_f32_32x32x16_bf16(__builtin_bit_cast(bf16x8, a1), vf[1], oacc[0], 0, 0, 0);
        } else {
#pragma unroll
            for (int st = 0; st < 2; ++st) { const v4u a0 = *(const LAS v4u*)(lds + L_AP + (1 + st) * 2048 + lane * 16), a1 = *(const LAS v4u*)(lds + L_AP + (1 + st) * 2048 + 1024 + lane * 16);
                oacc[1] = __builtin_amdgcn_mfma_f32_32x32x16_bf16(__builtin_bit_cast(bf16x8, a0), vf[2 * st], oacc[1], 0, 0, 0);
                oacc[1] = __builtin_amdgcn_mfma_f32_32x32x16_bf16(__builtin_bit_cast(bf16x8, a1), vf[2 * st + 1], oacc[1], 0, 0, 0); }
        }
#pragma unroll
        for (int rt = 0; rt < 2; ++rt)
#pragma unroll
            for (int r = 0; r < 16; ++r) ((LAS float*)(lds + L_OB + kh * 32768))[(32 * rt + (r & 3) + 8 * (r >> 2) + 4 * hh) * 128 + 32 * jv + l31] = oacc[rt][r];
        __syncthreads();
        {
            float o[16]; float ss = 0.f;
#pragma unroll
            for (int e4 = 0; e4 < 4; ++e4) { const f32x4 t = *(const LAS f32x4*)(lds + L_OB + (lrow * 128 + lc + 4 * e4) * 4) + *(const LAS f32x4*)(lds + L_OB + 32768 + (lrow * 128 + lc + 4 * e4) * 4);
                o[4 * e4] = t.x; o[4 * e4 + 1] = t.y; o[4 * e4 + 2] = t.z; o[4 * e4 + 3] = t.w; ss += (t.x * t.x + t.y * t.y) + (t.z * t.z + t.w * t.w); }
            ss += __shfl_xor(ss, 1); ss += __shfl_xor(ss, 2); ss += __shfl_xor(ss, 4);
            const float rs = rsqrtf(ss * (1.0f / 128.0f) + EPS);
            const unsigned gw[8] = {og0.x, og0.y, og0.z, og0.w, og1.x, og1.y, og1.z, og1.w};
            unsigned yw[8];
#pragma unroll
            for (int e = 0; e < 8; ++e) yw[e] = pk2(o[2 * e] * rs * gn[2 * e] * pg8::bflo(gw[e]), o[2 * e + 1] * rs * gn[2 * e + 1] * pg8::bfhi(gw[e]));
            yh0.x = yw[0]; yh0.y = yw[1]; yh0.z = yw[2]; yh0.w = yw[3]; yh1.x = yw[4]; yh1.y = yw[5]; yh1.z = yw[6]; yh1.w = yw[7];
        }
    }
    { bf16* yp = YA + (size_t)((SEQ / 64 - 1) * 64 + lrow) * 512 + lc; *(v4u*)yp = yh0; *(v4u*)(yp + 8) = yh1; }
#undef HG_LOAD
    __syncthreads();
}

constexpr int KB_P = 144;
constexpr int VB_P = 192;
template <int CG> __device__ __forceinline__ void attn_group(const bf16* base, LAS unsigned char* vbuf, int h, int r, int p0, int lane, float Mfix, f32x16 (&oT)[2], float& lsum) {
    constexpr int dil = (CG == 0) ? 1 : (CG == 1) ? 4 : 16, Lg = SEQ / dil, NT = 5;
    const int l31 = lane & 31, hh = lane >> 5;
    const int qcol = 2048 + (CG * 4 + h) * 64, kcol = qcol + 768, vcol = qcol + 1536;
    bf16x8 qf[4];
    { const bf16* qr = base + (size_t)(dil * (p0 + l31) + r) * NIN + qcol + 8 * hh;
#pragma unroll
      for (int ks = 0; ks < 4; ++ks) qf[ks] = *(const bf16x8*)(qr + 16 * ks); }
    const int Pq = p0 + l31, lim = Pq < 128 ? Pq : 128;
    const int kp0 = p0 - 128;
    const bool full = p0 >= 128;
    const int r8 = lane >> 3, ch = lane & 7;
    LAS unsigned char* kbuf = vbuf + 32 * VB_P;
    v4u k0[4], v0[4], k1[4], v1[4], k2[4], v2[4];
#define ATT_LOAD(KR, VR, t_) do { _Pragma("unroll") for (int c = 0; c < 4; ++c) { int pa = kp0 + 32 * (t_) + r8 + 8 * c; pa = pa < 0 ? 0 : (pa > Lg - 1 ? Lg - 1 : pa); \
        const bf16* rr = base + (size_t)(pa * dil + r) * NIN + 8 * ch; KR[c] = *(const v4u*)(rr + kcol); VR[c] = *(const v4u*)(rr + vcol); } } while (0)
    const LAS unsigned char* trp = vbuf + (4 * hh + ((lane & 15) >> 2)) * VB_P + (16 * ((lane >> 4) & 1) + 4 * (lane & 3)) * 2;
    const LAS unsigned char* kfp = kbuf + l31 * KB_P + 16 * hh;
#define ATT_TILE(KR, VR, t_, EDGE) do { const int kp = kp0 + 32 * (t_); \
        _Pragma("unroll") for (int c = 0; c < 4; ++c) { *(LAS v4u*)(kbuf + (r8 + 8 * c) * KB_P + 16 * ch) = KR[c]; *(LAS v4u*)(vbuf + (r8 + 8 * c) * VB_P + 16 * ch) = VR[c]; } \
        f32x16 sc = f32x16{}; \
        _Pragma("unroll") for (int ks = 0; ks < 4; ++ks) sc = __builtin_amdgcn_mfma_f32_32x32x16_bf16(*(const LAS bf16x8*)(kfp + 32 * ks), qf[ks], sc, 0, 0, 0); \
        float p[16]; \
        if ((EDGE) || !full) { const int dl = Pq - kp - 4 * hh; \
            _Pragma("unroll") for (int q = 0; q < 16; ++q) { const int d = dl - ((q & 3) + 8 * (q >> 2)); const float e = __builtin_amdgcn_exp2f(sc[q] - Mfix); p[q] = ((unsigned)d <= (unsigned)lim) ? e : 0.f; lsum += p[q]; } } \
        else { _Pragma("unroll") for (int q = 0; q < 16; ++q) { p[q] = __builtin_amdgcn_exp2f(sc[q] - Mfix); lsum += p[q]; } } \
        v4u pk0, pk1; \
        pk0.x = cvtpk(p[0], p[1]); pk0.y = cvtpk(p[2], p[3]); pk0.z = cvtpk(p[4], p[5]); pk0.w = cvtpk(p[6], p[7]); \
        pk1.x = cvtpk(p[8], p[9]); pk1.y = cvtpk(p[10], p[11]); pk1.z = cvtpk(p[12], p[13]); pk1.w = cvtpk(p[14], p[15]); \
        _Pragma("unroll") for (int dt = 0; dt < 2; ++dt) _Pragma("unroll") for (int ss = 0; ss < 2; ++ss) { const LAS unsigned char* a1 = trp + (16 * ss) * VB_P + (32 * dt) * 2; \
                const s16x4 lo = ds_tr16(a1), hi = ds_tr16(a1 + 8 * VB_P); \
                const bf16x8 vf = {lo[0], lo[1], lo[2], lo[3], hi[0], hi[1], hi[2], hi[3]}; \
                oT[dt] = __builtin_amdgcn_mfma_f32_32x32x16_bf16(vf, __builtin_bit_cast(bf16x8, ss == 0 ? pk0 : pk1), oT[dt], 0, 0, 0); } } while (0)
    ATT_LOAD(k0, v0, 0); ATT_LOAD(k1, v1, 1);
#pragma unroll 1
    for (int tile = 0; tile < NT; tile += 3) {
        ATT_LOAD(k2, v2, (tile + 2 < NT ? tile + 2 : NT - 1)); ATT_TILE(k0, v0, tile, tile == 0);
        ATT_LOAD(k0, v0, (tile + 3 < NT ? tile + 3 : NT - 1)); ATT_TILE(k1, v1, tile + 1, tile + 1 == NT - 1);
        ATT_LOAD(k1, v1, (tile + 4 < NT ? tile + 4 : NT - 1)); if (tile + 2 < NT) ATT_TILE(k2, v2, tile + 2, false);
    }
#undef ATT_TILE
#undef ATT_LOAD
}
constexpr int AT_O0 = 86016, AT_L0 = AT_O0 + 65536, AT_TSK = AT_L0 + 2048;
__device__ __forceinline__ void attn_wg_task(const Params& P, LAS unsigned char* lds, int task, int wave, int lane, float Mfix) {
    const int pt = task & 3, h = (task >> 2) & 3, b = task >> 4;
    const bf16* base = (const bf16*)(P.ws + WS_PROJ) + (size_t)b * SEQ * NIN;
    LAS unsigned char* vbuf = lds + wave * 10752;
    typedef unsigned u2v __attribute__((ext_vector_type(2)));
    const int l31 = lane & 31, hh = lane >> 5;
#define AT_CHUNK(p_, dt_, r4_) (lds + AT_O0 + (p_) * 128 + ((8 * (dt_) + 2 * (r4_) + hh + ((p_) >> 4) + (p_)) & 15) * 8)
#pragma unroll 1
    for (int i = 0; i < 2; ++i) {
        f32x16 oT[2]; oT[0] = f32x16{}; oT[1] = f32x16{}; float lsum = 0.f;
        const int pl = 64 * wave + 32 * i;
        attn_group<0>(base, vbuf, h, 0, 512 * pt + pl, lane, Mfix, oT, lsum);
        lsum += __shfl_xor(lsum, 32);
        const int p = pl + l31;
        if (hh == 0) ((LAS float*)(lds + AT_L0))[p] = lsum;
#pragma unroll
        for (int dt = 0; dt < 2; ++dt)
#pragma unroll
            for (int r4 = 0; r4 < 4; ++r4) { u2v w; w.x = cvtpk(oT[dt][4 * r4], oT[dt][4 * r4 + 1]); w.y = cvtpk(oT[dt][4 * r4 + 2], oT[dt][4 * r4 + 3]); *(LAS u2v*)AT_CHUNK(p, dt, r4) = w; }
    }
    __syncthreads();
#pragma unroll 1
    for (int i = 0; i < 2; ++i) {
        f32x16 oT[2]; oT[0] = f32x16{}; oT[1] = f32x16{}; float lsum = 0.f;
        const int pair = 2 * wave + i, c4 = pair & 3, tq = pair >> 2;
        attn_group<1>(base, vbuf, h, c4, 128 * pt + 32 * tq, lane, Mfix, oT, lsum);
        lsum += __shfl_xor(lsum, 32);
        const int p = 4 * (32 * tq + l31) + c4;
        if (hh == 0) ((LAS float*)(lds + AT_L0))[p] += lsum;
#pragma unroll
        for (int dt = 0; dt < 2; ++dt)
#pragma unroll
            for (int r4 = 0; r4 < 4; ++r4) { LAS u2v* cp = (LAS u2v*)AT_CHUNK(p, dt, r4); const u2v o0 = *cp;
                u2v w; w.x = cvtpk(oT[dt][4 * r4] + pg8::bflo(o0.x), oT[dt][4 * r4 + 1] + pg8::bfhi(o0.x)); w.y = cvtpk(oT[dt][4 * r4 + 2] + pg8::bflo(o0.y), oT[dt][4 * r4 + 3] + pg8::bfhi(o0.y)); *cp = w; }
    }
    __syncthreads();
#pragma unroll 1
    for (int i = 0; i < 2; ++i) {
        const int r16 = 2 * wave + i;
        f32x16 oT[2]; oT[0] = f32x16{}; oT[1] = f32x16{}; float lsum = 0.f;
        attn_group<2>(base, vbuf, h, r16, 32 * pt, lane, Mfix, oT, lsum);
        lsum += __shfl_xor(lsum, 32);
        const int p = 16 * l31 + r16;
        lsum += ((const LAS float*)(lds + AT_L0))[p];
        const float rl = 1.0f / lsum;
        bf16* yb = (bf16*)((unsigned char*)P.out + OUT_YB) + (size_t)(b * SEQ + 512 * pt + p) * 256 + h * 64;
#pragma unroll
        for (int dt = 0; dt < 2; ++dt)
#pragma unroll
            for (int r4 = 0; r4 < 4; ++r4) { const u2v o0 = *(const LAS u2v*)AT_CHUNK(p, dt, r4);
                u2v w; w.x = cvtpk((oT[dt][4 * r4] + pg8::bflo(o0.x)) * rl, (oT[dt][4 * r4 + 1] + pg8::bfhi(o0.x)) * rl); w.y = cvtpk((oT[dt][4 * r4 + 2] + pg8::bflo(o0.y)) * rl, (oT[dt][4 * r4 + 3] + pg8::bfhi(o0.y)) * rl);
                *(u2v*)(yb + 32 * dt + 8 * r4 + 4 * hh) = w; }
    }
#undef AT_CHUNK
    __syncthreads();
}

__host__ __device__ __forceinline__ unsigned f2key(float f) { const unsigned u = __builtin_bit_cast(unsigned, f); return (u & 0x80000000u) ? ~u : (u | 0x80000000u); }
__host__ __device__ __forceinline__ float key2f(unsigned k) { const unsigned u = (k & 0x80000000u) ? (k & 0x7fffffffu) : ~k; return __builtin_bit_cast(float, u); }
__device__ __forceinline__ unsigned fkmax(unsigned a, unsigned b) { unsigned r; asm("v_max_f32 %0, %1, %2" : "=v"(r) : "v"(a), "v"(b)); return r; }
__device__ __forceinline__ unsigned fkmin(unsigned a, unsigned b) { unsigned r; asm("v_min_f32 %0, %1, %2" : "=v"(r) : "v"(a), "v"(b)); return r; }
__device__ __forceinline__ unsigned fkmed3(unsigned a, unsigned b, unsigned c) { unsigned r; asm("v_med3_f32 %0, %1, %2, %3" : "=v"(r) : "v"(a), "v"(b), "v"(c)); return r; }
#define CE(K, a, b) do { const unsigned x_ = K[a], y_ = K[b]; K[a] = fkmax(x_, y_); K[b] = fkmin(x_, y_); } while (0)
#define BSORT16(K) do { CE(K,0,1); CE(K,2,3); CE(K,0,2); CE(K,1,3); CE(K,1,2); CE(K,4,5); CE(K,6,7); CE(K,4,6); CE(K,5,7); CE(K,5,6); CE(K,0,4); CE(K,2,6); CE(K,2,4); CE(K,1,5); CE(K,3,7); CE(K,3,5); CE(K,1,2); CE(K,3,4); CE(K,5,6); CE(K,8,9); CE(K,10,11); CE(K,8,10); CE(K,9,11); CE(K,9,10); CE(K,12,13); CE(K,14,15); CE(K,12,14); CE(K,13,15); CE(K,13,14); CE(K,8,12); CE(K,10,14); CE(K,10,12); CE(K,9,13); CE(K,11,15); CE(K,11,13); CE(K,9,10); CE(K,11,12); CE(K,13,14); CE(K,0,8); CE(K,4,12); CE(K,4,8); CE(K,2,10); CE(K,6,14); CE(K,6,10); CE(K,2,4); CE(K,6,8); CE(K,10,12); CE(K,1,9); CE(K,5,13); CE(K,5,9); CE(K,3,11); CE(K,7,15); CE(K,7,11); CE(K,3,5); CE(K,7,9); CE(K,11,13); CE(K,1,2); CE(K,3,4); CE(K,5,6); CE(K,7,8); CE(K,9,10); CE(K,11,12); CE(K,13,14); } while (0)
#define BMERGE16(K) do { CE(K,0,8); CE(K,1,9); CE(K,2,10); CE(K,3,11); CE(K,4,12); CE(K,5,13); CE(K,6,14); CE(K,7,15); CE(K,0,4); CE(K,1,5); CE(K,2,6); CE(K,3,7); CE(K,8,12); CE(K,9,13); CE(K,10,14); CE(K,11,15); CE(K,0,2); CE(K,1,3); CE(K,4,6); CE(K,5,7); CE(K,8,10); CE(K,9,11); CE(K,12,14); CE(K,13,15); CE(K,0,1); CE(K,2,3); CE(K,4,5); CE(K,6,7); CE(K,8,9); CE(K,10,11); CE(K,12,13); CE(K,14,15); } while (0)
#define TOPMERGE16(A, B) do { _Pragma("unroll") for (int i_ = 0; i_ < 16; ++i_) A[i_] = fkmax(A[i_], B[15 - i_]); BMERGE16(A); } while (0)
template <int A, int B> struct PairIns {
    static __device__ __forceinline__ void run(const float (&s1)[16], const float (&s2)[16], unsigned (&K)[16]) {
        if constexpr ((A + 1) * (B + 1) <= 16) {
            unsigned x = (__builtin_bit_cast(unsigned, s1[A] + s2[B]) & ~255u) | (unsigned)(((15 - A) << 4) | (15 - B));
#pragma unroll
            for (int i = 15; i > (A + 1) * (B + 1) - 1; --i) K[i] = fkmed3(K[i - 1], K[i], x);
            K[(A + 1) * (B + 1) - 1] = fkmax(K[(A + 1) * (B + 1) - 1], x);
            PairIns<A, B + 1>::run(s1, s2, K);
        } else if constexpr (B != 0) { PairIns<A + 1, 0>::run(s1, s2, K); }
    }
};
template <> struct PairIns<16, 0> { static __device__ __forceinline__ void run(const float (&)[16], const float (&)[16], unsigned (&)[16]) {} };

__device__ __forceinline__ float gelu_erf(float v) { return 0.5f * v * (1.0f + erff(v * 0.70710678118654752f)); }


typedef __bf16 bf16x2_t __attribute__((ext_vector_type(2)));
typedef float f32x2 __attribute__((ext_vector_type(2)));
constexpr int RSHIFT = 10, NR = NEXP >> RSHIFT;
constexpr int PL_BUF = 16384, PL_GATE = 8192, PL_WS = 32768, PL_WSB = 12288;

__device__ __forceinline__ float dot2u(unsigned x, unsigned w, float acc) {
    return __builtin_amdgcn_fdot2_f32_bf16(__builtin_bit_cast(bf16x2_t, x), __builtin_bit_cast(bf16x2_t, w), acc, false);
}
__device__ __forceinline__ float dot16_bf16(const unsigned (&x)[8], const v4u a, const v4u b) {
    float p = 0.f;
    p = dot2u(x[0], a.x, p); p = dot2u(x[1], a.y, p); p = dot2u(x[2], a.z, p); p = dot2u(x[3], a.w, p);
    p = dot2u(x[4], b.x, p); p = dot2u(x[5], b.y, p); p = dot2u(x[6], b.z, p); p = dot2u(x[7], b.w, p);
    return p;
}
__device__ __forceinline__ void rows_axpy2(float (&acc)[16], float& corr, float a0, float a1, const v4u w0, const v4u w1) {
    typedef _Float16 h2_ __attribute__((ext_vector_type(2)));
    const h2_ c = {(_Float16)__builtin_amdgcn_fmed3f(a0 * 4096.0f, -60000.0f, 60000.0f), (_Float16)__builtin_amdgcn_fmed3f(a1 * 4096.0f, -60000.0f, 60000.0f)};
    const h2_ one = {(_Float16)1.0f, (_Float16)1.0f};
    corr = __builtin_amdgcn_fdot2(c, one, corr, false);
    const unsigned x0[4] = {w0.x, w0.y, w0.z, w0.w}, x1[4] = {w1.x, w1.y, w1.z, w1.w};
#pragma unroll
    for (int j = 0; j < 4; ++j) {
        acc[4 * j + 0] = __builtin_amdgcn_fdot2(__builtin_bit_cast(h2_, __builtin_amdgcn_perm(x1[j], x0[j], 0x0c040c00u) | 0x64006400u), c, acc[4 * j + 0], false);
        acc[4 * j + 1] = __builtin_amdgcn_fdot2(__builtin_bit_cast(h2_, __builtin_amdgcn_perm(x1[j], x0[j], 0x0c050c01u) | 0x64006400u), c, acc[4 * j + 1], false);
        acc[4 * j + 2] = __builtin_amdgcn_fdot2(__builtin_bit_cast(h2_, __builtin_amdgcn_perm(x1[j], x0[j], 0x0c060c02u) | 0x64006400u), c, acc[4 * j + 2], false);
        acc[4 * j + 3] = __builtin_amdgcn_fdot2(__builtin_bit_cast(h2_, __builtin_amdgcn_perm(x1[j], x0[j], 0x0c070c03u) | 0x64006400u), c, acc[4 * j + 3], false); }
}
__device__ __forceinline__ void row_axpy1(f32x2 (&acc)[8], float a, const v4u w) {
    const unsigned ww[4] = {w.x, w.y, w.z, w.w};
#pragma unroll
    for (int j = 0; j < 4; ++j) { const f32x2 lo = {(float)(ww[j] & 0xffu), (float)((ww[j] >> 8) & 0xffu)}, hi = {(float)((ww[j] >> 16) & 0xffu), (float)(ww[j] >> 24)};
        acc[2 * j] = lo * a + acc[2 * j]; acc[2 * j + 1] = hi * a + acc[2 * j + 1]; }
}
typedef int i32x4 __attribute__((ext_vector_type(4)));

constexpr int GL_SHS = 0, GL_XQ = 2048, GL_CNT = 6144, GL_RM = 8192, GL_SA = 10240;
__device__ __forceinline__ void peer_gather_u(const Params& P, LAS unsigned char* lds, int tok0, int wave, int lane, int parity) {
    const LAS unsigned short* idxs = (const LAS unsigned short*)(lds + parity * PL_BUF); const LAS _Float16* gates = (const LAS _Float16*)(lds + parity * PL_BUF + PL_GATE);
    LAS unsigned char* wsb = lds + PL_WS + wave * PL_WSB;
    LAS int* srm = (LAS int*)(wsb + GL_RM); LAS float* shs = (LAS float*)(wsb + GL_SHS); LAS float* sa = (LAS float*)(wsb + GL_SA);
    LAS int* cnt = (LAS int*)(wsb + GL_CNT); LAS int* start = cnt + 64;
    const unsigned char* UQ = P.ws + WS_U; const f32x2* SUV = (const f32x2*)(P.ws + WS_SU);
    const bf16* X1B = (const bf16*)(P.ws + WS_X1B); const float* sumsq = (const float*)(P.ws + WS_SUMSQ);
    float sx[4];
    v4u xav[4], xbv[4]; float ssv[4];
#pragma unroll
    for (int tk = 0; tk < 4; ++tk) { const size_t t = (size_t)(tok0 + wave * 4 + tk); xav[tk] = *(const v4u*)(X1B + t * DM + lane * 16); xbv[tk] = *(const v4u*)(X1B + t * DM + lane * 16 + 8); ssv[tk] = sumsq[t]; }
#pragma unroll
    for (int tk = 0; tk < 4; ++tk) { const float r2 = rsqrtf(ssv[tk] * (1.0f / DM) + EPS);
        const v4u xa = xav[tk], xb = xbv[tk]; f32x4 x[4]; float m = 0.f;
        x[0] = (f32x4){pg8::bflo(xa.x), pg8::bfhi(xa.x), pg8::bflo(xa.y), pg8::bfhi(xa.y)} * r2; x[1] = (f32x4){pg8::bflo(xa.z), pg8::bfhi(xa.z), pg8::bflo(xa.w), pg8::bfhi(xa.w)} * r2;
        x[2] = (f32x4){pg8::bflo(xb.x), pg8::bfhi(xb.x), pg8::bflo(xb.y), pg8::bfhi(xb.y)} * r2; x[3] = (f32x4){pg8::bflo(xb.z), pg8::bfhi(xb.z), pg8::bflo(xb.w), pg8::bfhi(xb.w)} * r2;
#pragma unroll
        for (int j = 0; j < 4; ++j) m = fmaxf(m, fmaxf(fmaxf(fabsf(x[j].x), fabsf(x[j].y)), fmaxf(fabsf(x[j].z), fabsf(x[j].w))));
#pragma unroll
        for (int o = 1; o < 64; o <<= 1) m = fmaxf(m, __shfl_xor(m, o));
        const float inv = m > 0.f ? 127.0f / m : 0.f; sx[tk] = m * (1.0f / 127.0f); unsigned w[4];
#pragma unroll
        for (int j = 0; j < 4; ++j) { const int q0 = __float2int_rn(x[j].x * inv), q1 = __float2int_rn(x[j].y * inv), q2 = __float2int_rn(x[j].z * inv), q3 = __float2int_rn(x[j].w * inv);
            w[j] = (unsigned)(q0 & 255) | ((unsigned)(q1 & 255) << 8) | ((unsigned)(q2 & 255) << 16) | ((unsigned)(q3 & 255) << 24); }
        v4u xw_; xw_.x = w[0]; xw_.y = w[1]; xw_.z = w[2]; xw_.w = w[3]; *(LAS v4u*)(wsb + GL_XQ + tk * 1024 + lane * 16) = xw_; }
    { int ee[8], sl[8]; float gg[8];
#pragma unroll
      for (int tk = 0; tk < 4; ++tk) { const int tl = wave * 4 + tk;
          ee[2 * tk] = idxs[tl * 128 + lane]; ee[2 * tk + 1] = idxs[tl * 128 + 64 + lane]; gg[2 * tk] = (float)gates[tl * 128 + lane]; gg[2 * tk + 1] = (float)gates[tl * 128 + 64 + lane]; }
      f32x2 scv[8];
#pragma unroll
      for (int i = 0; i < 8; ++i) scv[i] = SUV[ee[i]];
      cnt[lane] = 0;
      LDS_WAIT(); asm volatile("" ::: "memory");
#pragma unroll
      for (int i = 0; i < 8; ++i) sl[i] = __hip_atomic_fetch_add(cnt + (ee[i] >> 8), 1, __ATOMIC_RELAXED, __HIP_MEMORY_SCOPE_WORKGROUP);
      LDS_WAIT(); asm volatile("" ::: "memory");
      { const int c = cnt[lane]; int inc = c;
#pragma unroll
        for (int o = 1; o < 64; o <<= 1) { const int t = __shfl_up(inc, o); if (lane >= o) inc += t; }
        start[lane] = inc - c; }
      LDS_WAIT(); asm volatile("" ::: "memory");
#pragma unroll
      for (int i = 0; i < 8; ++i) { const int pos = start[ee[i] >> 8] + sl[i]; const f32x2 sc2 = scv[i]; srm[pos] = ee[i] | ((i >> 1) << 14); sa[pos] = gg[i] * sc2.y; shs[pos] = sc2.x * sx[i >> 1]; }
      LDS_WAIT(); asm volatile("" ::: "memory"); }
    {
        const int lu = fresh_lane(); const unsigned ulo = (unsigned)lu * 16u;
        const LAS unsigned char* xql = wsb + GL_XQ + lu * 16;
        const bool hh = (lu & 32) != 0, b4 = (lu & 16) != 0, b3 = (lu & 8) != 0;
        v4u rA[8], rB[8];
#define U_LOAD(R, pos_) do { const i32x4 e0_ = *(const LAS i32x4*)(srm + (pos_)) & 0x3fff, e1_ = *(const LAS i32x4*)(srm + (pos_) + 4) & 0x3fff; \
        R[0] = *(const v4u*)(UQ + (((unsigned)e0_[0] << 10) + ulo)); R[1] = *(const v4u*)(UQ + (((unsigned)e0_[1] << 10) + ulo)); R[2] = *(const v4u*)(UQ + (((unsigned)e0_[2] << 10) + ulo)); R[3] = *(const v4u*)(UQ + (((unsigned)e0_[3] << 10) + ulo)); \
        R[4] = *(const v4u*)(UQ + (((unsigned)e1_[0] << 10) + ulo)); R[5] = *(const v4u*)(UQ + (((unsigned)e1_[1] << 10) + ulo)); R[6] = *(const v4u*)(UQ + (((unsigned)e1_[2] << 10) + ulo)); R[7] = *(const v4u*)(UQ + (((unsigned)e1_[3] << 10) + ulo)); } while (0)
#define U_DOT1(R, k_, ev_) do { const v4u xs_ = *(const LAS v4u*)(xql + (((ev_) >> 4) & 0xc00)); \
        const int p0_ = __builtin_amdgcn_sdot4((int)R[k_].x, (int)xs_.x, 0, false), p1_ = __builtin_amdgcn_sdot4((int)R[k_].y, (int)xs_.y, 0, false); \
        pd_[k_] = __builtin_amdgcn_sdot4((int)R[k_].z, (int)xs_.z, p0_, false) + __builtin_amdgcn_sdot4((int)R[k_].w, (int)xs_.w, p1_, false); } while (0)
#define U_COMP(R, pos_) do { int pd_[8]; \
        { const i32x4 t0v_ = *(const LAS i32x4*)(srm + (pos_)), t1v_ = *(const LAS i32x4*)(srm + (pos_) + 4); \
          U_DOT1(R, 0, t0v_[0]); U_DOT1(R, 1, t0v_[1]); U_DOT1(R, 2, t0v_[2]); U_DOT1(R, 3, t0v_[3]); U_DOT1(R, 4, t1v_[0]); U_DOT1(R, 5, t1v_[1]); U_DOT1(R, 6, t1v_[2]); U_DOT1(R, 7, t1v_[3]); } \
        typedef unsigned u2s_ __attribute__((ext_vector_type(2))); \
        const u2s_ w0_ = __builtin_amdgcn_permlane32_swap((unsigned)pd_[0], (unsigned)pd_[4], false, false), w1_ = __builtin_amdgcn_permlane32_swap((unsigned)pd_[1], (unsigned)pd_[5], false, false); \
        const u2s_ w2_ = __builtin_amdgcn_permlane32_swap((unsigned)pd_[2], (unsigned)pd_[6], false, false), w3_ = __builtin_amdgcn_permlane32_swap((unsigned)pd_[3], (unsigned)pd_[7], false, false); \
        const int k0_ = (int)(w0_.x + w0_.y), k1_ = (int)(w1_.x + w1_.y), k2_ = (int)(w2_.x + w2_.y), k3_ = (int)(w3_.x + w3_.y);     \
        const u2s_ y0_ = __builtin_amdgcn_permlane16_swap((unsigned)k0_, (unsigned)k2_, false, false), y1_ = __builtin_amdgcn_permlane16_swap((unsigned)k1_, (unsigned)k3_, false, false); \
        const int m0_ = (int)(y0_.x + y0_.y), m1_ = (int)(y1_.x + y1_.y);                  \
        int kk_ = b3 ? m1_ : m0_; const int tt_ = b3 ? m0_ : m1_; \
        kk_ += __builtin_amdgcn_update_dpp(0, tt_, 0x128, 0xf, 0xf, false);            \
        kk_ += __builtin_amdgcn_update_dpp(0, kk_, 0x141, 0xf, 0xf, false);            \
        kk_ += __builtin_amdgcn_update_dpp(0, kk_, 0xB1, 0xf, 0xf, false);             \
        kk_ += __builtin_amdgcn_update_dpp(0, kk_, 0x4E, 0xf, 0xf, false);             \
        if ((lu & 7) == 0) { const int p_ = (pos_) + (lu >> 3); shs[p_] = (float)kk_ * shs[p_]; } } while (0)
        U_LOAD(rA, 0);
#pragma unroll 1
        for (int m = 0; m < 64; m += 2) {
            U_LOAD(rB, 8 * m + 8);  U_COMP(rA, 8 * m);
            U_LOAD(rA, (m + 2 < 64 ? 8 * m + 16 : 0));  U_COMP(rB, 8 * m + 8);
        }
#undef U_LOAD
#undef U_DOT1
#undef U_COMP
    }
    LDS_WAIT(); asm volatile("" ::: "memory");
    { const int lg = fresh_lane();
#pragma unroll
      for (int i = 0; i < 8; ++i) { const int p = lg + 64 * i; sa[p] = gelu_erf(shs[p]) * sa[p]; } }
    LDS_WAIT(); asm volatile("" ::: "memory");
}
__device__ __forceinline__ void peer_gather_v(const Params& P, LAS unsigned char* lds, int tok0, int wave) {
    typedef int i32x4_ __attribute__((ext_vector_type(4)));
    LAS unsigned char* wsb = lds + PL_WS + wave * PL_WSB;
    LAS int* srm = (LAS int*)(wsb + GL_RM); LAS float* sa = (LAS float*)(wsb + GL_SA);
    const unsigned char* VQ = P.ws + WS_V; const bf16* X1B = (const bf16*)(P.ws + WS_X1B);
    const int lv = fresh_lane(); const unsigned vlo = (unsigned)lv * 16u;
    v4u rA[8], rB[8], rC[8];
#define V_LOAD(R, pos_) do { const i32x4 e0_ = *(const LAS i32x4*)(srm + (pos_)) & 0x3fff, e1_ = *(const LAS i32x4*)(srm + (pos_) + 4) & 0x3fff; \
        R[0] = *(const v4u*)(VQ + (((unsigned)e0_[0] << 10) + vlo)); R[1] = *(const v4u*)(VQ + (((unsigned)e0_[1] << 10) + vlo)); R[2] = *(const v4u*)(VQ + (((unsigned)e0_[2] << 10) + vlo)); R[3] = *(const v4u*)(VQ + (((unsigned)e0_[3] << 10) + vlo)); \
        R[4] = *(const v4u*)(VQ + (((unsigned)e1_[0] << 10) + vlo)); R[5] = *(const v4u*)(VQ + (((unsigned)e1_[1] << 10) + vlo)); R[6] = *(const v4u*)(VQ + (((unsigned)e1_[2] << 10) + vlo)); R[7] = *(const v4u*)(VQ + (((unsigned)e1_[3] << 10) + vlo)); } while (0)
    V_LOAD(rA, 0); V_LOAD(rB, 8);
    float amax[4] = {0.f, 0.f, 0.f, 0.f};
#pragma unroll
    for (int i = 0; i < 8; ++i) { const int p = lv + 64 * i; const float av = fabsf(sa[p]); const int tk = (srm[p] >> 14) & 3;
        amax[0] = fmaxf(amax[0], tk == 0 ? av : 0.f); amax[1] = fmaxf(amax[1], tk == 1 ? av : 0.f); amax[2] = fmaxf(amax[2], tk == 2 ? av : 0.f); amax[3] = fmaxf(amax[3], tk == 3 ? av : 0.f); }
#pragma unroll
    for (int o = 1; o < 64; o <<= 1) { amax[0] = fmaxf(amax[0], __shfl_xor(amax[0], o)); amax[1] = fmaxf(amax[1], __shfl_xor(amax[1], o)); amax[2] = fmaxf(amax[2], __shfl_xor(amax[2], o)); amax[3] = fmaxf(amax[3], __shfl_xor(amax[3], o)); }
    { float inv[4];
#pragma unroll
      for (int t = 0; t < 4; ++t) inv[t] = amax[t] > 0.f ? 127.0f / amax[t] : 0.f;
#pragma unroll
      for (int i = 0; i < 8; ++i) { const int p = lv + 64 * i; const int tk = (srm[p] >> 14) & 3; const float iv = tk == 0 ? inv[0] : tk == 1 ? inv[1] : tk == 2 ? inv[2] : inv[3];
          const int q = __float2int_rn(sa[p] * iv); ((LAS int*)sa)[p] = (q & 255) << (8 * tk); } }
    LDS_WAIT(); asm volatile("" ::: "memory");
    i32x4_ acc[16];
#pragma unroll
    for (int j = 0; j < 16; ++j) acc[j] = (i32x4_){0, 0, 0, 0};
    {
        const unsigned asel = 0x0c0c0000u | ((4u + (unsigned)(lv & 3)) << 8) | (unsigned)(lv & 3);
#define V_QUAD(r0_, r1_, r2_, r3_, aop_, j_) do { \
        const unsigned l01_ = __builtin_amdgcn_perm(r1_, r0_, 0x05010400u), h01_ = __builtin_amdgcn_perm(r1_, r0_, 0x07030602u); \
        const unsigned l23_ = __builtin_amdgcn_perm(r3_, r2_, 0x05010400u), h23_ = __builtin_amdgcn_perm(r3_, r2_, 0x07030602u); \
        acc[4 * (j_) + 0] = __builtin_amdgcn_mfma_i32_4x4x4i8((int)(aop_), (int)__builtin_amdgcn_perm(l23_, l01_, 0x05040100u), acc[4 * (j_) + 0], 0, 0, 0); \
        acc[4 * (j_) + 1] = __builtin_amdgcn_mfma_i32_4x4x4i8((int)(aop_), (int)__builtin_amdgcn_perm(l23_, l01_, 0x07060302u), acc[4 * (j_) + 1], 0, 0, 0); \
        acc[4 * (j_) + 2] = __builtin_amdgcn_mfma_i32_4x4x4i8((int)(aop_), (int)__builtin_amdgcn_perm(h23_, h01_, 0x05040100u), acc[4 * (j_) + 2], 0, 0, 0); \
        acc[4 * (j_) + 3] = __builtin_amdgcn_mfma_i32_4x4x4i8((int)(aop_), (int)__builtin_amdgcn_perm(h23_, h01_, 0x07060302u), acc[4 * (j_) + 3], 0, 0, 0); } while (0)
#define V_AOP(c0_, c1_, c2_, c3_) (__builtin_amdgcn_perm((unsigned)(c1_), (unsigned)(c0_), asel) | (__builtin_amdgcn_perm((unsigned)(c3_), (unsigned)(c2_), asel) << 16))
#define V_COMP(R, pos_) do { const i32x4 c0_ = *(const LAS i32x4*)((const LAS int*)sa + (pos_)), c1_ = *(const LAS i32x4*)((const LAS int*)sa + (pos_) + 4); \
        const unsigned a0_ = V_AOP(c0_[0], c0_[1], c0_[2], c0_[3]), a1_ = V_AOP(c1_[0], c1_[1], c1_[2], c1_[3]); \
        V_QUAD(R[0].x, R[1].x, R[2].x, R[3].x, a0_, 0); V_QUAD(R[0].y, R[1].y, R[2].y, R[3].y, a0_, 1); V_QUAD(R[0].z, R[1].z, R[2].z, R[3].z, a0_, 2); V_QUAD(R[0].w, R[1].w, R[2].w, R[3].w, a0_, 3); \
        V_QUAD(R[4].x, R[5].x, R[6].x, R[7].x, a1_, 0); V_QUAD(R[4].y, R[5].y, R[6].y, R[7].y, a1_, 1); V_QUAD(R[4].z, R[5].z, R[6].z, R[7].z, a1_, 2); V_QUAD(R[4].w, R[5].w, R[6].w, R[7].w, a1_, 3); } while (0)
#pragma unroll 1
        for (int m = 0; m < 63; m += 3) {
            V_LOAD(rC, 8 * m + 16);  V_COMP(rA, 8 * m);
            V_LOAD(rA, 8 * m + 24);  V_COMP(rB, 8 * m + 8);
            V_LOAD(rB, (m + 4 < 64 ? 8 * m + 32 : 0));  V_COMP(rC, 8 * m + 16);
        }
        V_COMP(rA, 8 * 63);
#undef V_LOAD
#undef V_QUAD
#undef V_AOP
#undef V_COMP
    }
    const int le = fresh_lane();
#pragma unroll
    for (int tk = 0; tk < 4; ++tk) { const size_t t = (size_t)(tok0 + wave * 4 + tk); const float sc = amax[tk] * (1.0f / 127.0f);
        const v4u xa = *(const v4u*)(X1B + t * DM + le * 16), xb = *(const v4u*)(X1B + t * DM + le * 16 + 8); float* orow = P.out + t * DM + le * 16;
        const unsigned xw[8] = {xa.x, xa.y, xa.z, xa.w, xb.x, xb.y, xb.z, xb.w};
#pragma unroll
        for (int j = 0; j < 4; ++j) *(LAS f32x4*)(wsb + le * 64 + 16 * j) = (f32x4){pg8::bflo(xw[2 * j]) + sc * (float)acc[4 * j][tk], pg8::bfhi(xw[2 * j]) + sc * (float)acc[4 * j + 1][tk], pg8::bflo(xw[2 * j + 1]) + sc * (float)acc[4 * j + 2][tk], pg8::bfhi(xw[2 * j + 1]) + sc * (float)acc[4 * j + 3][tk]};
        (void)orow; float* ob = P.out + t * DM + le * 4;
#pragma unroll
        for (int j = 0; j < 4; ++j) { const f32x4 ov = *(const LAS f32x4*)(wsb + j * 1024 + le * 16); __builtin_nontemporal_store(ov, (f32x4*)(ob + 256 * j)); } }
}

__device__ __forceinline__ void topk_part(const Params& P, LAS unsigned char* lds, int item, int wave, int parity) {
    const int lane = fresh_lane();
    const int tok0 = item * 32, hh = lane >> 5, l31 = lane & 31;
    LAS unsigned short* idxs = (LAS unsigned short*)(lds + parity * PL_BUF);
    LAS _Float16* gates = (LAS _Float16*)(lds + parity * PL_BUF + PL_GATE);
    const bf16* Q = (const bf16*)(P.ws + WS_Q); const bf16* SK = (const bf16*)(P.ws + WS_SK);
    unsigned L0[16], L1[16];
#pragma unroll
    for (int p = 0; p < 2; ++p) {
        f32x16 acc[4];
        { LAS unsigned char* tb = lds + PL_WS + wave * PL_WSB;
          const int r8 = lane >> 3, ch = lane & 7;
          v4u tq[4], tk[4][4];
#pragma unroll
          for (int c = 0; c < 4; ++c) tq[c] = *(const v4u*)(Q + (size_t)(tok0 + r8 + 8 * c) * DM + wave * 128 + p * 64 + 8 * ch);
          const bf16* skp = SK + (size_t)((wave * 2 + p) * 128 + r8) * 64 + 8 * ch;
#pragma unroll
          for (int nt = 0; nt < 4; ++nt)
#pragma unroll
              for (int c = 0; c < 4; ++c) tk[nt][c] = *(const v4u*)(skp + (size_t)(32 * nt + 8 * c) * 64);
#pragma unroll
          for (int c = 0; c < 4; ++c) *(LAS v4u*)(tb + (r8 + 8 * c) * 144 + 16 * ch) = tq[c];
          bf16x8 bq[4];
#pragma unroll
          for (int ks = 0; ks < 4; ++ks) bq[ks] = *(const LAS bf16x8*)(tb + l31 * 144 + 32 * ks + 16 * hh);
#define TK_TILE(nt_) do { \
          _Pragma("unroll") for (int c = 0; c < 4; ++c) *(LAS v4u*)(tb + (r8 + 8 * c) * 144 + 16 * ch) = tk[nt_][c]; \
          acc[nt_] = f32x16{}; \
          _Pragma("unroll") for (int ks = 0; ks < 4; ++ks) acc[nt_] = __builtin_amdgcn_mfma_f32_32x32x16_bf16(*(const LAS bf16x8*)(tb + l31 * 144 + 32 * ks + 16 * hh), bq[ks], acc[nt_], 0, 0, 0); } while (0)
          TK_TILE(0); TK_TILE(1); TK_TILE(2); TK_TILE(3);
#undef TK_TILE
        }
        unsigned G0[16], G1[16], G2[16], G3[16];
#pragma unroll
        for (int r = 0; r < 16; ++r) { const unsigned n = (unsigned)((r & 3) + 8 * (r >> 2)) + 4u * (unsigned)hh;
            const float a0_ = acc[0][r], a1_ = acc[1][r], a2_ = acc[2][r], a3_ = acc[3][r];
            G0[r] = (__builtin_bit_cast(unsigned, a0_) & ~127u) | n; G1[r] = (__builtin_bit_cast(unsigned, a1_) & ~127u) | (n + 32u); G2[r] = (__builtin_bit_cast(unsigned, a2_) & ~127u) | (n + 64u); G3[r] = (__builtin_bit_cast(unsigned, a3_) & ~127u) | (n + 96u); }
        BSORT16(G0); BSORT16(G1); BSORT16(G2); BSORT16(G3);
        TOPMERGE16(G0, G1); TOPMERGE16(G2, G3); TOPMERGE16(G0, G2);
#pragma unroll
        for (int i = 0; i < 16; ++i) { if (p == 0) L0[i] = G0[i]; else L1[i] = G0[i]; }
        __builtin_amdgcn_sched_barrier(0);
    }
    {
        unsigned O0[16], O1[16];
#pragma unroll
        for (int i = 0; i < 16; ++i) { O0[i] = (unsigned)__shfl_xor((int)L0[i], 32); O1[i] = (unsigned)__shfl_xor((int)L1[i], 32); }
        TOPMERGE16(L0, O0); TOPMERGE16(L1, O1);
    }
    {
        float s1[16], s2[16]; unsigned K[16];
        LAS int* tab = (LAS int*)(lds + PL_WS + wave * PL_WSB);
#pragma unroll
        for (int i = 0; i < 16; ++i) { s1[i] = __builtin_bit_cast(float, L0[i] & ~127u); s2[i] = __builtin_bit_cast(float, L1[i] & ~127u); tab[i * 64 + lane] = (int)(L0[i] & 127u); tab[1024 + i * 64 + lane] = (int)(L1[i] & 127u); K[i] = 0xff800000u; }
        PairIns<0, 0>::run(s1, s2, K);
        float e[16], sum = 0.f; const float v0 = __builtin_bit_cast(float, K[0] & ~255u);
#pragma unroll
        for (int i = 0; i < 16; ++i) { e[i] = __expf(__builtin_bit_cast(float, K[i] & ~255u) - v0); sum += e[i]; }
        const float rs = 1.0f / sum;
        LDS_WAIT();
        if (hh == 0) {
#pragma unroll
            for (int i = 0; i < 16; ++i) { const int a_ = 15 - (int)((K[i] >> 4) & 15u), b_ = 15 - (int)(K[i] & 15u);
                idxs[l31 * 128 + wave * 16 + i] = (unsigned short)(tab[a_ * 64 + lane] * 128 + tab[1024 + b_ * 64 + lane]); gates[l31 * 128 + wave * 16 + i] = (_Float16)(e[i] * rs); }
        }
    }
}

constexpr int NPHASE = 8;
__global__ void __launch_bounds__(NWAVES * 64, 2) mk_fwd(Params P) {
    extern __shared__ __attribute__((aligned(16))) unsigned char lds_raw[];
    LAS unsigned char* lds = (LAS unsigned char*)lds_raw;
    const int wave = __builtin_amdgcn_readfirstlane((int)threadIdx.x >> 6);
    const int G = gridDim.x;
    unsigned char* ws = P.ws;
#if MK_FUSED
    { const int l0 = fresh_lane(); for (int u = wave * 64 + l0; u < (LDS_BYTES - LDS_CTL) / 4; u += NWAVES * 64) ((LAS unsigned*)(lds + LDS_CTL))[u] = 0u; }
    __syncthreads();
    const XcdBarrier xbar = xcd_barrier_post((unsigned*)(ws + WS_CTL) + 4096, (volatile LAS unsigned*)(lds + LDS_CTL + 320) + 8, wave * 64 + fresh_lane());
#define SEAM0() cg::this_grid().sync()
#define SEAM() xcd_barrier(xbar, wave * 64 + fresh_lane())
#else
#define SEAM0() do {} while (0)
#define SEAM() do {} while (0)
#endif
#ifndef PHASE_MASK
#define PHASE_MASK 0xff
#endif
#define IN(k) (((PHASE_MASK >> (k)) & 1) && P.ph_lo <= (k) && (k) < P.ph_hi)
    bf16* XN = (bf16*)((unsigned char*)P.out + OUT_XN); bf16* MERGED = (bf16*)((unsigned char*)P.out + OUT_MERGED);
    bf16* YA = (bf16*)((unsigned char*)P.out + OUT_YA); bf16* YB = (bf16*)((unsigned char*)P.out + OUT_YB);
    bf16* PROJ = (bf16*)(ws + WS_PROJ);
    float* sumsq = (float*)(ws + WS_SUMSQ);

    if (IN(0)) {
        unsigned* sb = (unsigned*)(ws + WS_CTL) + 12000;
        p0_prologue_a(P, lds, wave, fresh_lane(), 0);
#if MK_FUSED
        asm volatile("s_waitcnt vmcnt(0)" ::: "memory"); __syncthreads();
        if (wave == 0 && fresh_lane() == 0) { __builtin_amdgcn_fence(__ATOMIC_RELEASE, "agent"); asm volatile("s_waitcnt vmcnt(0)" ::: "memory"); (void)__hip_atomic_fetch_add(sb, 1u, __ATOMIC_RELAXED, __HIP_MEMORY_SCOPE_AGENT); }
#endif
        p0_prologue_a(P, lds, wave, fresh_lane(), 1);
#if MK_FUSED
        if (wave == 0 && fresh_lane() == 0) { unsigned sp = 0; while (__hip_atomic_load(sb, __ATOMIC_RELAXED, __HIP_MEMORY_SCOPE_AGENT) < (unsigned)G) { __builtin_amdgcn_s_sleep(2); if (++sp > (1u << 22)) break; }
            __builtin_amdgcn_fence(__ATOMIC_ACQUIRE, "agent"); asm volatile("s_waitcnt vmcnt(0)" ::: "memory"); }
        __syncthreads();
#endif
        p0_prologue_b(P, lds, wave, fresh_lane()); SEAM0(); }
    if (IN(1)) {
        pg8::Gemm g{XN, (const bf16*)(ws + WS_WIN), MTOK, NIN, DM / 2};
        pg8::StaticOrder S; S.init(MTOK, NIN, G, (int)blockIdx.x);
        const int nfull = ((MTOK / 256) * (NIN / 256)) / G;
        if (G == 256) { S.ilim = nfull; S.swap02 = true; }
        pg8::EpiProj E{PROJ, P.hg_lb, P.q_norm_g, P.k_norm_g, (const float*)(ws + WS_SXN), (const float*)(ws + WS_SW), (bf16*)((unsigned char*)P.out + OUT_KI)};
        pg8::gemm_phase<pg8::EpiProj, pg8::StaticOrder, true, true, true>(lds, g, S, E, wave);
        SEAM();
    }
    if (IN(2)) {
        const int lane2 = fresh_lane();
        const int nh = (G >= 128) ? 64 : 0;
        if (G == 256 && (int)blockIdx.x >= 128) {
            pg8::Gemm g{XN, (const bf16*)(ws + WS_WIN), MTOK, NIN, DM / 2};
            pg8::StaticOrder S; S.init(MTOK, NIN, G, (int)blockIdx.x - 128); S.ibase = ((MTOK / 256) * (NIN / 256)) / G; S.ilim = S.ibase + 1; S.swap02 = true;
            pg8::EpiProj E{PROJ, P.hg_lb, P.q_norm_g, P.k_norm_g, (const float*)(ws + WS_SXN), (const float*)(ws + WS_SW), (bf16*)((unsigned char*)P.out + OUT_KI)};
            pg8::gemm_phase<pg8::EpiProj, pg8::StaticOrder, true, true, true>(lds, g, S, E, wave);
            VM_WAIT(); __syncthreads();
        }
        if (nh) { if ((int)blockIdx.x < nh) hgrn_chunked_item(P, lds, (int)blockIdx.x, wave, lane2); }
        else { for (int it = (int)blockIdx.x; it < BATCH * 4; it += G) hgrn_chunked_item(P, lds, it, wave, lane2); }
        {
            float mq = fabsf(P.q_norm_g[lane2]), mk = fabsf(P.k_norm_g[lane2]);
#pragma unroll
            for (int o = 1; o < 64; o <<= 1) { mq = fmaxf(mq, __shfl_xor(mq, o)); mk = fmaxf(mk, __shfl_xor(mk, o)); }
            const float Mfix = 8.0f * 1.4426950408889634f * 1.02f * mq * mk;
            unsigned* ctr = (unsigned*)(ws + WS_CTL) + 8192;
            for (;;) { if (wave == 0 && lane2 == 0) *(volatile LAS unsigned*)(lds + AT_TSK) = __hip_atomic_fetch_add(ctr, 1u, __ATOMIC_RELAXED, __HIP_MEMORY_SCOPE_AGENT);
                __syncthreads();
                const int task = __builtin_amdgcn_readfirstlane((int)*(volatile LAS unsigned*)(lds + AT_TSK)); if (task >= BATCH * 4 * 4) break;
                attn_wg_task(P, lds, task, wave, lane2, Mfix); }
            unsigned* qctr = (unsigned*)(ws + WS_CTL) + 8200;
            for (;;) { __syncthreads();
                if (wave == 0 && lane2 == 0) *(volatile LAS unsigned*)(lds + AT_TSK) = __hip_atomic_fetch_add(qctr, 1u, __ATOMIC_RELAXED, __HIP_MEMORY_SCOPE_AGENT);
                __syncthreads();
                const int unit = __builtin_amdgcn_readfirstlane((int)*(volatile LAS unsigned*)(lds + AT_TSK)); if (unit >= NEXP / 16) break;
                quant_tables(P, unit, NEXP / 16, wave, fresh_lane()); }
        }
        SEAM();
    }
    if (IN(3)) {
        { pg8::Gemm g{YA, (const bf16*)(ws + WS_WA), MTOK, DM, 512}; pg8::StaticOrder S; S.init(MTOK, DM, G, (int)blockIdx.x);
          pg8::EpiGate<0> E{MERGED, PROJ + 4352};
          pg8::gemm_phase<pg8::EpiGate<0>, pg8::StaticOrder, true, true>(lds, g, S, E, wave); }
        VM_WAIT(); __syncthreads();
        { pg8::Gemm g{YB, (const bf16*)(ws + WS_WB), MTOK, DM, 256}; pg8::StaticOrder S; S.init(MTOK, DM, G, (int)blockIdx.x);
          pg8::EpiGate<1> E{MERGED, PROJ + 5376};
          pg8::gemm_phase<pg8::EpiGate<1>, pg8::StaticOrder, true, true>(lds, g, S, E, wave); }
        SEAM();
    }
    if (IN(4)) {
        pg8::Gemm g{MERGED, (const bf16*)(ws + WS_WOUT), MTOK, DM, DM}; pg8::StaticOrder S; S.init(MTOK, DM, G, (int)blockIdx.x);
        pg8::EpiResid E{P.x, (bf16*)(ws + WS_X1B), sumsq};
        pg8::gemm_phase<pg8::EpiResid, pg8::StaticOrder, true, true>(lds, g, S, E, wave);
        SEAM();
    }
    if (IN(5)) {
        pg8::Gemm g{(const bf16*)(ws + WS_X1B), (const bf16*)(ws + WS_WQ), MTOK, DM, DM}; pg8::StaticOrder S; S.init(MTOK, DM, G, (int)blockIdx.x);
        pg8::EpiRowScale E{(bf16*)(ws + WS_Q), sumsq};
        pg8::gemm_phase<pg8::EpiRowScale, pg8::StaticOrder, true, true>(lds, g, S, E, wave);
        SEAM();
    }
    if (IN(6)) {
        const int nit = (MTOK / 32 - (int)blockIdx.x + G - 1) / G;
        if (nit > 0) topk_part(P, lds, (int)blockIdx.x, wave, 0);
        __syncthreads();
#pragma unroll 1
        for (int k = 0; k < nit; ++k) {
            const int item = (int)blockIdx.x + k * G;
            peer_gather_u(P, lds, item * 32, wave, fresh_lane(), k & 1);
            if (wave < 4) { __builtin_amdgcn_s_setprio(2); peer_gather_v(P, lds, item * 32, wave); __builtin_amdgcn_s_setprio(0); if (k + 1 < nit) topk_part(P, lds, item + G, wave, (k + 1) & 1); }
            else { if (k + 1 < nit) topk_part(P, lds, item + G, wave, (k + 1) & 1); __builtin_amdgcn_s_setprio(2); peer_gather_v(P, lds, item * 32, wave); __builtin_amdgcn_s_setprio(0); }
            __syncthreads();
        }
    }
#undef IN
#undef SEAM
#undef SEAM0
}

extern "C" void kernel_launch(void* const* d_in, const int* in_sizes, int n_in, void* d_out, int out_size, void* d_ws, size_t ws_size, hipStream_t stream) {
    static int grid = 0;
    if (grid == 0) {
        if (n_in != 15 || in_sizes[0] != MTOK * DM || out_size != MTOK * DM || ws_size < WS_END) {
            fprintf(stderr, "kernel_launch: unexpected shapes (n_in %d, in0 %d, out %d, ws %zu); nothing launched\n", n_in, n_in > 0 ? in_sizes[0] : -1, out_size, ws_size); grid = -1; return; }
        int dev = 0, cus = 0, per_cu = 0;
        if (hipGetDevice(&dev) != hipSuccess || hipDeviceGetAttribute(&cus, hipDeviceAttributeMultiprocessorCount, dev) != hipSuccess) { fprintf(stderr, "kernel_launch: device query failed\n"); grid = -1; return; }
        if (hipFuncSetAttribute((const void*)mk_fwd, hipFuncAttributeMaxDynamicSharedMemorySize, LDS_BYTES) != hipSuccess) { fprintf(stderr, "kernel_launch: hipFuncSetAttribute failed\n"); grid = -1; return; }
        if (hipOccupancyMaxActiveBlocksPerMultiprocessor(&per_cu, (const void*)mk_fwd, NWAVES * 64, LDS_BYTES) != hipSuccess || per_cu < 1) { fprintf(stderr, "kernel_launch: occupancy query says %d blocks per CU\n", per_cu); per_cu = 1; }
        (void)hipGetLastError();
        grid = cus;
        fprintf(stderr, "kernel_launch: %d CUs, occupancy query %d per CU, grid %d\n", cus, per_cu, grid);
    }
    if (grid < 0) return;
    (void)hipMemsetAsync((char*)d_ws + WS_CTL, 0, CTL_ZERO_BYTES, stream);
    Params p{};
    p.x = (const float*)d_in[0]; p.norm1_g = (const float*)d_in[1]; p.w_in = (const float*)d_in[2]; p.hg_norm_g = (const float*)d_in[3]; p.hg_lb = (const float*)d_in[4];
    p.q_norm_g = (const float*)d_in[5]; p.k_norm_g = (const float*)d_in[6]; p.w_a = (const float*)d_in[7]; p.w_b = (const float*)d_in[8]; p.w_out = (const float*)d_in[9];
    p.norm2_g = (const float*)d_in[10]; p.peer_wq = (const float*)d_in[11]; p.peer_sk = (const float*)d_in[12]; p.peer_u = (const float*)d_in[13]; p.peer_v = (const float*)d_in[14];
    p.out = (float*)d_out; p.ws = (unsigned char*)d_ws;
#if MK_FUSED
    p.ph_lo = 0; p.ph_hi = NPHASE;
    void* args[] = {&p};
    hipError_t e = hipLaunchCooperativeKernel((const void*)mk_fwd, dim3(grid), dim3(NWAVES * 64), args, LDS_BYTES, stream);
    if (e != hipSuccess) fprintf(stderr, "kernel_launch: cooperative launch failed: %s (grid %d)\n", hipGetErrorString(e), grid);
#else
    for (int ph = 0; ph < 7; ++ph) { p.ph_lo = ph; p.ph_hi = ph + 1; hipLaunchKernelGGL(mk_fwd, dim3(grid), dim3(NWAVES * 64), LDS_BYTES, stream, p); }
#endif
}
```
